# Optimizing an MI355X kernel written in HIP

```python
import math
import jax
import jax.numpy as jnp
from jax import lax
import numpy as np

D_MODEL = 1024
BATCH = 32
SEQ = 256
DEPTH = 2
DEC_BATCH = 4
DEC_SEQ = 4096
PAST_LEN = 256

GRID_W = 64
HEAD_DIM = 64
N_MIXERS = 4
GROUP_W = D_MODEL // N_MIXERS
MIX_W = N_MIXERS * GROUP_W
CONV_K = 3
EPS = 1e-6
ROPE_THETA = 10000.0
Q_BLOCK = 128
NEG_INF = -1e30

DN_HEADS = GROUP_W // HEAD_DIM
DN_DK = HEAD_DIM
DN_DV = HEAD_DIM
DN_CHUNK = 64

MLA_HEADS = GROUP_W // HEAD_DIM
MLA_NOPE = 64
MLA_ROPE = 32
MLA_VHD = GROUP_W // MLA_HEADS
MLA_Q_LORA = D_MODEL // 4
MLA_KV_LORA = D_MODEL // 8
MLA_SCALE = (MLA_NOPE + MLA_ROPE) ** -0.5

SSM_HEADS = GROUP_W // 64
SSM_P = GROUP_W // SSM_HEADS
SSM_N = 64
SSM_GROUPS = 2
SSM_CHUNK = 64

SWA_HEADS = GROUP_W // HEAD_DIM
SWA_KV_HEADS = 2
SWA_GQA = SWA_HEADS // SWA_KV_HEADS
SWA_WINDOW = 128
SWA_BLOCK = 128
SWA_SCALE = HEAD_DIM ** -0.5

FF_DIM = -(-(8 * D_MODEL) // (3 * 256)) * 256

DN_IN = 4 * GROUP_W + 4 * DN_HEADS
MLA_IN = MLA_Q_LORA + MLA_KV_LORA + MLA_ROPE
SSM_IN = 2 * GROUP_W + 2 * SSM_GROUPS * SSM_N + 2 * SSM_HEADS
SWA_IN = (SWA_HEADS + 2 * SWA_KV_HEADS) * HEAD_DIM
IN_DIM = DN_IN + MLA_IN + SSM_IN + SWA_IN

kernel_name = 'hybrid_flow_backbone_step'


def split_cols(x, sizes):
    idx = [int(s) for s in np.cumsum(sizes)[:-1]]
    return jnp.split(x, idx, axis=-1)


def rms_norm(x, w):
    xf = x.astype(jnp.float32)
    y = xf * lax.rsqrt(jnp.mean(xf * xf, axis=-1, keepdims=True) + EPS)
    return (y * w.astype(jnp.float32)).astype(x.dtype)


def l2_normalize(x):
    xf = x.astype(jnp.float32)
    return (xf * lax.rsqrt(jnp.sum(xf * xf, axis=-1, keepdims=True) + EPS)).astype(x.dtype)


def modulated_norm(x, w, shift, scale):
    return rms_norm(x, w) * (1 + scale) + shift


def swiglu(h, w_gate_up, w_down):
    gu = h @ w_gate_up
    return (jax.nn.silu(gu[..., :FF_DIM]) * gu[..., FF_DIM:]) @ w_down


def centred_depthwise_conv(u, w):
    pad = (w.shape[0] - 1) // 2
    return lax.conv_general_dilated(u, w[:, None, :].astype(u.dtype), window_strides=(1,),
                                    padding=[(pad, pad)], dimension_numbers=('NWC', 'WIO', 'NWC'),
                                    feature_group_count=u.shape[-1])


def axial_rope(rows, rot_dim):
    row_ids = jnp.broadcast_to(jnp.arange(rows)[:, None], (rows, GRID_W)).reshape(-1).astype(jnp.float32)
    col_ids = jnp.broadcast_to(jnp.arange(GRID_W)[None, :], (rows, GRID_W)).reshape(-1).astype(jnp.float32)
    n_freq = rot_dim // 4
    inv_freq = ROPE_THETA ** (-jnp.arange(n_freq, dtype=jnp.float32) / n_freq)
    ang = jnp.concatenate([row_ids[:, None] * inv_freq, col_ids[:, None] * inv_freq], axis=-1)
    return jnp.cos(ang), jnp.sin(ang)


def apply_rope(x, cos, sin):
    half = x.shape[-1] // 2
    x1, x2 = x[..., :half], x[..., half:]
    c = cos[None, :, None, :].astype(x.dtype)
    s = sin[None, :, None, :].astype(x.dtype)
    return jnp.concatenate([x1 * c - x2 * s, x1 * s + x2 * c], axis=-1)


def gated_delta_chunked(q, k, v, g, beta, s0):
    f32 = jnp.float32
    b, t, h, dk = q.shape
    dv = v.shape[-1]
    n = t // DN_CHUNK

    def chunks(a):
        a = a.astype(f32).reshape((b, n, DN_CHUNK, h) + a.shape[3:])
        return jnp.moveaxis(a, 2, 3).swapaxes(0, 1)

    qc, kc, vc, gc, bc = chunks(q), chunks(k), chunks(v), chunks(g), chunks(beta)
    gcum = jnp.cumsum(gc, axis=-1)
    causal = jnp.tril(jnp.ones((DN_CHUNK, DN_CHUNK), bool))
    strict = jnp.tril(jnp.ones((DN_CHUNK, DN_CHUNK), bool), -1)
    diff = gcum[..., :, None] - gcum[..., None, :]
    decay = jnp.where(causal, jnp.exp(jnp.where(causal, diff, 0.0)), 0.0)
    kb = kc * bc[..., None]
    a_mat = jnp.where(strict, jnp.einsum('nbhid,nbhjd->nbhij', kb, kc) * decay, 0.0)
    tmat = jnp.eye(DN_CHUNK, dtype=f32) + a_mat
    u = lax.linalg.triangular_solve(tmat, vc * bc[..., None], left_side=True, lower=True, unit_diagonal=True)
    w = lax.linalg.triangular_solve(tmat, kb * jnp.exp(gcum)[..., None], left_side=True, lower=True,
                                    unit_diagonal=True)
    qk = jnp.where(causal, jnp.einsum('nbhid,nbhjd->nbhij', qc, kc) * decay, 0.0)

    def step(state, xs):
        q_i, k_i, u_i, w_i, qk_i, g_i = xs
        v_new = u_i - jnp.einsum('bhcd,bhde->bhce', w_i, state)
        o = (jnp.einsum('bhcd,bhde->bhce', q_i * jnp.exp(g_i)[..., None], state)
             + jnp.einsum('bhij,bhje->bhie', qk_i, v_new))
        g_last = g_i[..., -1]
        state = (state * jnp.exp(g_last)[..., None, None]
                 + jnp.einsum('bhcd,bhce->bhde', k_i * jnp.exp(g_last[..., None] - g_i)[..., None], v_new))
        return state, o

    s_fin, o = lax.scan(step, s0.astype(f32), (qc, kc, u, w, qk, gcum))
    o = jnp.moveaxis(o.swapaxes(0, 1), 3, 2).reshape(b, t, h, dv)
    return o, s_fin


def ssd_chunked(x, a, bm, cm, s0):
    f32 = jnp.float32
    b, t, h, pdim = x.shape
    n = t // SSM_CHUNK

    def chunks(arr):
        return arr.astype(f32).reshape((b, n, SSM_CHUNK) + arr.shape[2:]).swapaxes(0, 1)

    xc, bc, cc = chunks(x), chunks(bm), chunks(cm)
    ac = jnp.moveaxis(chunks(a), 2, 3)
    acum = jnp.cumsum(ac, axis=-1)
    causal = jnp.tril(jnp.ones((SSM_CHUNK, SSM_CHUNK), bool))
    diff = acum[..., :, None] - acum[..., None, :]
    lmat = jnp.where(causal, jnp.exp(jnp.where(causal, diff, 0.0)), 0.0)
    scores = jnp.einsum('nbihs,nbjhs->nbhij', cc, bc) * lmat
    y_diag = jnp.einsum('nbhij,nbjhp->nbihp', scores, xc)
    decay_to_end = jnp.exp(acum[..., -1:] - acum)
    chunk_states = jnp.einsum('nbjhs,nbhj,nbjhp->nbhps', bc, decay_to_end, xc)
    chunk_decay = jnp.exp(acum[..., -1])

    def step(state, xs):
        st, dec = xs
        return state * dec[..., None, None] + st, state

    s_fin, s_in = lax.scan(step, s0.astype(f32), (chunk_states, chunk_decay))
    y_off = jnp.einsum('nbihs,nbhps,nbhi->nbihp', cc, s_in, jnp.exp(acum))
    y = (y_diag + y_off).swapaxes(0, 1).reshape(b, t, h, pdim)
    return y, s_fin


def deltanet_mixer(p, lp, s0):
    f32 = jnp.float32
    b, t, _ = p.shape
    qkv, z, beta_raw, alpha_raw = split_cols(p, [3 * GROUP_W, GROUP_W, 2 * DN_HEADS, 2 * DN_HEADS])
    qkv = jax.nn.silu(centred_depthwise_conv(qkv, lp['dn_conv_w']))
    q, k, v = [a.reshape(b, t, DN_HEADS, HEAD_DIM) for a in jnp.split(qkv, 3, axis=-1)]
    q = l2_normalize(q) * (DN_DK ** -0.5)
    k = l2_normalize(k)
    beta = jax.nn.sigmoid(beta_raw.astype(f32)).reshape(b, t, 2, DN_HEADS)
    g = -jnp.exp(lp['dn_a_log'].astype(f32)) * jax.nn.softplus(
        alpha_raw.astype(f32).reshape(b, t, 2, DN_HEADS) + lp['dn_dt_bias'].astype(f32))
    o_f, s_f = gated_delta_chunked(q, k, v, g[:, :, 0], beta[:, :, 0], s0[:, 0])
    o_b, s_b = gated_delta_chunked(jnp.flip(q, 1), jnp.flip(k, 1), jnp.flip(v, 1),
                                   jnp.flip(g[:, :, 1], 1), jnp.flip(beta[:, :, 1], 1), s0[:, 1])
    o = (o_f + jnp.flip(o_b, 1)).astype(p.dtype)
    o = rms_norm(o, lp['dn_norm_w']) * jax.nn.silu(z.reshape(b, t, DN_HEADS, DN_DV))
    return o.reshape(b, t, GROUP_W), jnp.stack([s_f, s_b], axis=1).astype(p.dtype)


def ssd_mixer(p, lp, s0):
    f32 = jnp.float32
    b, t, _ = p.shape
    z, xbc, dt_raw = split_cols(p, [GROUP_W, GROUP_W + 2 * SSM_GROUPS * SSM_N, 2 * SSM_HEADS])
    xbc = jax.nn.silu(centred_depthwise_conv(xbc, lp['ssm_conv_w']) + lp['ssm_conv_b'])
    xs, bm, cm = split_cols(xbc, [GROUP_W, SSM_GROUPS * SSM_N, SSM_GROUPS * SSM_N])
    xs = xs.reshape(b, t, SSM_HEADS, SSM_P)
    rep = SSM_HEADS // SSM_GROUPS
    bm = jnp.repeat(bm.reshape(b, t, SSM_GROUPS, SSM_N), rep, axis=2)
    cm = jnp.repeat(cm.reshape(b, t, SSM_GROUPS, SSM_N), rep, axis=2)
    dt = jax.nn.softplus(dt_raw.astype(f32).reshape(b, t, 2, SSM_HEADS) + lp['ssm_dt_bias'].astype(f32))
    a = -jnp.exp(lp['ssm_a_log'].astype(f32)) * dt
    xdt = xs.astype(f32)[:, :, None] * dt[..., None]
    y_f, s_f = ssd_chunked(xdt[:, :, 0], a[:, :, 0], bm, cm, s0[:, 0])
    y_b, s_b = ssd_chunked(jnp.flip(xdt[:, :, 1], 1), jnp.flip(a[:, :, 1], 1),
                           jnp.flip(bm, 1), jnp.flip(cm, 1), s0[:, 1])
    y = y_f + jnp.flip(y_b, 1) + lp['ssm_d'].astype(f32)[:, None] * xs.astype(f32)
    y = (y.reshape(b, t, GROUP_W) * jax.nn.silu(z.astype(f32))).astype(p.dtype)
    y = rms_norm(y.reshape(b, t, SSM_GROUPS, GROUP_W // SSM_GROUPS),
                 lp['ssm_norm_w'].reshape(SSM_GROUPS, GROUP_W // SSM_GROUPS))
    return y.reshape(b, t, GROUP_W), jnp.stack([s_f, s_b], axis=1).astype(p.dtype)


def mla_project(p, lp):
    b, t, _ = p.shape
    q_lat, kv_lat, k_pe = split_cols(p, [MLA_Q_LORA, MLA_KV_LORA, MLA_ROPE])
    q = (rms_norm(q_lat, lp['mla_q_norm_w']) @ lp['mla_w_uq']).reshape(b, t, MLA_HEADS, MLA_NOPE + MLA_ROPE)
    c_kv = rms_norm(kv_lat, lp['mla_kv_norm_w'])
    return q[..., :MLA_NOPE], q[..., MLA_NOPE:], c_kv, k_pe


def mla_expand(c_kv, k_pe, w_ukv):
    b, t, _ = c_kv.shape
    kv = (c_kv @ w_ukv).reshape(b, t, MLA_HEADS, MLA_NOPE + MLA_VHD)
    k = jnp.concatenate([kv[..., :MLA_NOPE],
                         jnp.broadcast_to(k_pe[:, :, None, :], (b, t, MLA_HEADS, MLA_ROPE))], axis=-1)
    return k, kv[..., MLA_NOPE:]


def swa_project(p):
    b, t, _ = p.shape
    q, k, v = split_cols(p, [SWA_HEADS * HEAD_DIM, SWA_KV_HEADS * HEAD_DIM, SWA_KV_HEADS * HEAD_DIM])
    return (q.reshape(b, t, SWA_KV_HEADS, SWA_GQA, HEAD_DIM),
            k.reshape(b, t, SWA_KV_HEADS, HEAD_DIM), v.reshape(b, t, SWA_KV_HEADS, HEAD_DIM))


def dense_attention(q, k, v, scale, sink=None):
    b, tq, kvh, g, _ = q.shape

    def one_block(i):
        qi = lax.dynamic_slice_in_dim(q, i * Q_BLOCK, Q_BLOCK, axis=1)
        s = jnp.einsum('bqhgd,bkhd->bhgqk', qi, k, preferred_element_type=jnp.float32) * scale
        if sink is not None:
            sk = jnp.broadcast_to(sink.astype(jnp.float32).reshape(1, kvh, g, 1, 1), s.shape[:-1] + (1,))
            prob = jax.nn.softmax(jnp.concatenate([s, sk], axis=-1), axis=-1)[..., :-1]
        else:
            prob = jax.nn.softmax(s, axis=-1)
        return jnp.einsum('bhgqk,bkhd->bqhgd', prob.astype(v.dtype), v)

    o = lax.map(one_block, jnp.arange(tq // Q_BLOCK))
    return jnp.moveaxis(o, 0, 1).reshape(b, tq, kvh, g, v.shape[-1])


def banded_window_attention(q, k, v, k_ctx, v_ctx, sink, scale):
    b, t, kvh, g, _ = q.shape
    n_ctx = k_ctx.shape[1]
    pad = ((0, 0), (SWA_BLOCK, SWA_BLOCK), (0, 0), (0, 0))
    k_pad, v_pad = jnp.pad(k, pad), jnp.pad(v, pad)
    qpos_local = jnp.arange(SWA_BLOCK)
    kpos_local = jnp.arange(3 * SWA_BLOCK)
    in_window = jnp.abs((kpos_local[None, :] - SWA_BLOCK) - qpos_local[:, None]) <= SWA_WINDOW

    def one_block(i):
        start = i * SWA_BLOCK
        qi = lax.dynamic_slice_in_dim(q, start, SWA_BLOCK, axis=1)
        ki = lax.dynamic_slice_in_dim(k_pad, start, 3 * SWA_BLOCK, axis=1)
        vi = lax.dynamic_slice_in_dim(v_pad, start, 3 * SWA_BLOCK, axis=1)
        kpos = start - SWA_BLOCK + kpos_local
        valid = in_window & ((kpos >= 0) & (kpos < t))[None, :]
        s_loc = jnp.einsum('bqhgd,bchd->bhgqc', qi, ki, preferred_element_type=jnp.float32) * scale
        s_loc = jnp.where(valid, s_loc, NEG_INF)
        s_ctx = jnp.einsum('bqhgd,blhd->bhgql', qi, k_ctx, preferred_element_type=jnp.float32) * scale
        sk = jnp.broadcast_to(sink.astype(jnp.float32).reshape(1, kvh, g, 1, 1), s_loc.shape[:-1] + (1,))
        prob = jax.nn.softmax(jnp.concatenate([s_loc, s_ctx, sk], axis=-1), axis=-1)
        p_loc = prob[..., :3 * SWA_BLOCK].astype(v.dtype)
        p_ctx = prob[..., 3 * SWA_BLOCK:3 * SWA_BLOCK + n_ctx].astype(v.dtype)
        return (jnp.einsum('bhgqc,bchd->bqhgd', p_loc, vi)
                + jnp.einsum('bhgql,blhd->bqhgd', p_ctx, v_ctx))

    o = lax.map(one_block, jnp.arange(t // SWA_BLOCK))
    return jnp.moveaxis(o, 0, 1).reshape(b, t, kvh, g, v.shape[-1])


def context_mixers(p, lp):
    b, n_ctx, _ = p.shape
    p_dn, p_mla, p_ssm, p_swa = split_cols(p, [DN_IN, MLA_IN, SSM_IN, SWA_IN])
    o_dn, s_dn = deltanet_mixer(p_dn, lp, jnp.zeros((b, 2, DN_HEADS, DN_DK, DN_DV), p.dtype))
    q_nope, q_pe, c_kv, k_pe = mla_project(p_mla, lp)
    k_m, v_m = mla_expand(c_kv, k_pe, lp['mla_w_ukv'])
    q_m = jnp.concatenate([q_nope, q_pe], axis=-1)[:, :, :, None, :]
    o_mla = dense_attention(q_m, k_m, v_m, MLA_SCALE).reshape(b, n_ctx, GROUP_W)
    o_ssm, s_ssm = ssd_mixer(p_ssm, lp, jnp.zeros((b, 2, SSM_HEADS, SSM_P, SSM_N), p.dtype))
    q_s, k_s, v_s = swa_project(p_swa)
    o_swa = dense_attention(q_s, k_s, v_s, SWA_SCALE, lp['swa_sinks']).reshape(b, n_ctx, GROUP_W)
    mix = jnp.concatenate([o_dn, o_mla, o_ssm, o_swa], axis=-1)
    return mix, (s_dn, c_kv, k_pe, s_ssm, k_s, v_s)


def latent_mixers(p, lp, cache, rope):
    b, t, _ = p.shape
    s0_dn, ckv_ctx, kpe_ctx, s0_ssm, k_ctx, v_ctx = cache
    cos_m, sin_m, cos_s, sin_s = rope
    p_dn, p_mla, p_ssm, p_swa = split_cols(p, [DN_IN, MLA_IN, SSM_IN, SWA_IN])
    o_dn, _ = deltanet_mixer(p_dn, lp, s0_dn)
    q_nope, q_pe, c_kv, k_pe = mla_project(p_mla, lp)
    q_pe = apply_rope(q_pe, cos_m, sin_m)
    k_pe = apply_rope(k_pe[:, :, None, :], cos_m, sin_m)[:, :, 0]
    k_lat, v_lat = mla_expand(c_kv, k_pe, lp['mla_w_ukv'])
    k_c, v_c = mla_expand(ckv_ctx, kpe_ctx, lp['mla_w_ukv'])
    q_m = jnp.concatenate([q_nope, q_pe], axis=-1)[:, :, :, None, :]
    o_mla = dense_attention(q_m, jnp.concatenate([k_c, k_lat], axis=1),
                            jnp.concatenate([v_c, v_lat], axis=1), MLA_SCALE).reshape(b, t, GROUP_W)
    o_ssm, _ = ssd_mixer(p_ssm, lp, s0_ssm)
    q_s, k_s, v_s = swa_project(p_swa)
    q_s = apply_rope(q_s.reshape(b, t, SWA_HEADS, HEAD_DIM), cos_s, sin_s).reshape(
        b, t, SWA_KV_HEADS, SWA_GQA, HEAD_DIM)
    k_s = apply_rope(k_s, cos_s, sin_s)
    o_swa = banded_window_attention(q_s, k_s, v_s, k_ctx, v_ctx, lp['swa_sinks'], SWA_SCALE).reshape(
        b, t, GROUP_W)
    mix = jnp.concatenate([o_dn, o_mla, o_ssm, o_swa], axis=-1)
    return mix, None


def trunk_layer(x, ada, lp, mixer, *mixer_args):
    sh1, sc1, g1, sh2, sc2, g2 = jnp.split(ada, 6, axis=-1)
    p = modulated_norm(x, lp['norm1_w'], sh1, sc1) @ lp['w_in']
    mix, aux = mixer(p, lp, *mixer_args)
    x = x + g1 * (mix @ lp['w_out'])
    x = x + g2 * swiglu(modulated_norm(x, lp['norm2_w'], sh2, sc2), lp['w_gate_up'], lp['w_down'])
    return x, aux


def setup_inputs(seed: int = 0) -> dict:
    key = jax.random.key(seed)
    ks = iter(jax.random.split(key, 40))
    f32 = jnp.float32

    def nrm(shape, scale):
        return jax.random.normal(next(ks), shape, f32) * scale

    def gain(shape):
        return 1.0 + nrm(shape, 0.1)

    def a_log(shape):
        return jnp.log(jax.random.uniform(next(ks), shape, f32, 1.0, 16.0))

    def dt_bias(shape):
        dt = jnp.exp(jax.random.uniform(next(ks), shape, f32, math.log(1e-3), math.log(1e-1)))
        return dt + jnp.log(-jnp.expm1(-dt))

    return {
        'x_prompt': nrm((BATCH, SEQ, D_MODEL), 1.0),
        'x_sample': nrm((DEC_BATCH, DEC_SEQ, D_MODEL), 1.0),
        'c': nrm((DEC_BATCH, D_MODEL), 1.0),
        'state_dn': nrm((DEC_BATCH, DEPTH, 2, DN_HEADS, DN_DK, DN_DV), 0.2),
        'cache_mla_ckv': nrm((DEC_BATCH, DEPTH, PAST_LEN, MLA_KV_LORA), 1.0),
        'cache_mla_kpe': nrm((DEC_BATCH, DEPTH, PAST_LEN, MLA_ROPE), 1.0),
        'state_ssm': nrm((DEC_BATCH, DEPTH, 2, SSM_HEADS, SSM_P, SSM_N), 0.2),
        'cache_swa_k': nrm((DEC_BATCH, DEPTH, PAST_LEN, SWA_KV_HEADS, HEAD_DIM), 1.0),
        'cache_swa_v': nrm((DEC_BATCH, DEPTH, PAST_LEN, SWA_KV_HEADS, HEAD_DIM), 1.0),
        'c_ctx': nrm((D_MODEL,), 1.0),
        'norm1_w': gain((DEPTH, D_MODEL)),
        'norm2_w': gain((DEPTH, D_MODEL)),
        'w_ada': nrm((DEPTH, D_MODEL, 6 * D_MODEL), 0.5 * D_MODEL ** -0.5),
        'b_ada': nrm((DEPTH, 6 * D_MODEL), 0.02),
        'w_in': nrm((DEPTH, D_MODEL, IN_DIM), D_MODEL ** -0.5),
        'w_out': nrm((DEPTH, MIX_W, D_MODEL), MIX_W ** -0.5),
        'dn_conv_w': nrm((DEPTH, CONV_K, 3 * GROUP_W), CONV_K ** -0.5),
        'dn_a_log': a_log((DEPTH, 2, DN_HEADS)),
        'dn_dt_bias': dt_bias((DEPTH, 2, DN_HEADS)),
        'dn_norm_w': gain((DEPTH, DN_DV)),
        'mla_q_norm_w': gain((DEPTH, MLA_Q_LORA)),
        'mla_w_uq': nrm((DEPTH, MLA_Q_LORA, MLA_HEADS * (MLA_NOPE + MLA_ROPE)), MLA_Q_LORA ** -0.5),
        'mla_kv_norm_w': gain((DEPTH, MLA_KV_LORA)),
        'mla_w_ukv': nrm((DEPTH, MLA_KV_LORA, MLA_HEADS * (MLA_NOPE + MLA_VHD)), MLA_KV_LORA ** -0.5),
        'ssm_conv_w': nrm((DEPTH, CONV_K, GROUP_W + 2 * SSM_GROUPS * SSM_N), CONV_K ** -0.5),
        'ssm_conv_b': nrm((DEPTH, GROUP_W + 2 * SSM_GROUPS * SSM_N), 0.02),
        'ssm_a_log': a_log((DEPTH, 2, SSM_HEADS)),
        'ssm_dt_bias': dt_bias((DEPTH, 2, SSM_HEADS)),
        'ssm_d': gain((DEPTH, SSM_HEADS)),
        'ssm_norm_w': gain((DEPTH, GROUP_W)),
        'swa_sinks': nrm((DEPTH, SWA_HEADS), 0.5),
        'w_gate_up': nrm((DEPTH, D_MODEL, 2 * FF_DIM), D_MODEL ** -0.5),
        'w_down': nrm((DEPTH, FF_DIM, D_MODEL), FF_DIM ** -0.5),
        'final_norm_w': gain((D_MODEL,)),
    }


def reference(x_prompt, x_sample, c, state_dn, cache_mla_ckv, cache_mla_kpe, state_ssm, cache_swa_k,
              cache_swa_v, c_ctx, norm1_w, norm2_w, w_ada, b_ada, w_in, w_out, dn_conv_w, dn_a_log,
              dn_dt_bias, dn_norm_w, mla_q_norm_w, mla_w_uq, mla_kv_norm_w, mla_w_ukv, ssm_conv_w,
              ssm_conv_b, ssm_a_log, ssm_dt_bias, ssm_d, ssm_norm_w, swa_sinks, w_gate_up, w_down,
              final_norm_w):
    rows = x_sample.shape[1] // GRID_W
    cos_m, sin_m = axial_rope(rows, MLA_ROPE)
    cos_s, sin_s = axial_rope(rows, HEAD_DIM)
    rope = (cos_m, sin_m, cos_s, sin_s)
    x_ctx, x_lat = x_prompt, x_sample
    st_dn, st_ckv, st_kpe, st_ssm, st_k, st_v = [], [], [], [], [], []
    for l in range(DEPTH):
        lp = {
            'norm1_w': norm1_w[l], 'norm2_w': norm2_w[l], 'w_in': w_in[l], 'w_out': w_out[l],
            'dn_conv_w': dn_conv_w[l], 'dn_a_log': dn_a_log[l], 'dn_dt_bias': dn_dt_bias[l],
            'dn_norm_w': dn_norm_w[l], 'mla_q_norm_w': mla_q_norm_w[l], 'mla_w_uq': mla_w_uq[l],
            'mla_kv_norm_w': mla_kv_norm_w[l], 'mla_w_ukv': mla_w_ukv[l], 'ssm_conv_w': ssm_conv_w[l],
            'ssm_conv_b': ssm_conv_b[l], 'ssm_a_log': ssm_a_log[l], 'ssm_dt_bias': ssm_dt_bias[l],
            'ssm_d': ssm_d[l], 'ssm_norm_w': ssm_norm_w[l], 'swa_sinks': swa_sinks[l],
            'w_gate_up': w_gate_up[l], 'w_down': w_down[l],
        }
        ada_ctx = jax.nn.silu(c_ctx) @ w_ada[l] + b_ada[l]
        x_ctx, (s_dn, ckv, kpe, s_ssm, k_s, v_s) = trunk_layer(x_ctx, ada_ctx, lp, context_mixers)
        st_dn.append(s_dn)
        st_ckv.append(ckv)
        st_kpe.append(kpe)
        st_ssm.append(s_ssm)
        st_k.append(k_s)
        st_v.append(v_s)
        ada_lat = (jax.nn.silu(c) @ w_ada[l] + b_ada[l])[:, None, :]
        cache_l = (state_dn[:, l], cache_mla_ckv[:, l], cache_mla_kpe[:, l], state_ssm[:, l],
                   cache_swa_k[:, l], cache_swa_v[:, l])
        x_lat, _ = trunk_layer(x_lat, ada_lat, lp, latent_mixers, cache_l, rope)
    y_prompt = rms_norm(x_ctx, final_norm_w)
    y_sample = rms_norm(x_lat, final_norm_w)
    new_state_dn = jnp.stack(st_dn, axis=1)
    new_mla_ckv = jnp.stack(st_ckv, axis=1)
    new_mla_kpe = jnp.stack(st_kpe, axis=1)
    new_state_ssm = jnp.stack(st_ssm, axis=1)
    new_swa_k = jnp.stack(st_k, axis=1)
    new_swa_v = jnp.stack(st_v, axis=1)
    return (y_prompt, y_sample, new_state_dn, new_mla_ckv, new_mla_kpe, new_state_ssm, new_swa_k, new_swa_v)
```

```cpp
#include <hip/hip_runtime.h>
#include <hip/hip_cooperative_groups.h>
#include <cstdio>
#include <cstdint>
namespace cg = cooperative_groups;
namespace pg8 {
#define PG8_LAS __attribute__((address_space(3)))
typedef unsigned short bf16_t;
typedef short bf16x8 __attribute__((ext_vector_type(8)));
typedef float f32x4 __attribute__((ext_vector_type(4)));
typedef unsigned u32x4 __attribute__((ext_vector_type(4)));
constexpr int BM = 256, BK = 64, HALF = 128, HTB = HALF * BK * 2  , STAGE_BYTES = 8 * HTB, NXCD = 8, WGM = 8;

__host__ __device__ __forceinline__ int lds_byte(int r, int c) { const int st = (r >> 4) * 2 + (c >> 5), rr = r & 15, cc = c & 31, ob = rr * 64 + cc * 2; return st * 1024 + (ob ^ (((ob >> 9) & 1) << 5)); }
__host__ __device__ __forceinline__ void stage_rc(int b, int& R, int& C) { const int st = b / 1024, sb = b % 1024, swz = sb ^ (((sb >> 9) & 1) << 5); R = (st >> 1) * 16 + swz / 64; C = (st & 1) * 32 + (swz % 64) / 2; }
__host__ __device__ __forceinline__ int perm32(int rho) { const int n = rho >> 4, i = rho & 15; return 8 * (i >> 2) + 4 * n + (i & 3); }

struct Unit { int pm, pn; };
struct Gemm { const bf16_t* A; const bf16_t* Bt; int M, N, K, lda; int tid; };
struct StaticOrder {
    int nM, nN, nwg, G, c;
    __host__ __device__ void init(int M, int N, int G_, int c_) { nM = M / BM; nN = N / BM; nwg = nM * nN; G = G_; c = c_; }
    __host__ __device__ bool next(int i, Unit& u) const {
        const long L = (long)i * G + c; if (L >= nwg) return false;
        int wgid = (int)L; { const int q = nwg / NXCD, r = nwg % NXCD, xcd = wgid % NXCD, off = wgid / NXCD; wgid = (xcd < r ? xcd * (q + 1) : r * (q + 1) + (xcd - r) * q) + off; }
        const int nig = WGM * nN, gid = wgid / nig, fm = gid * WGM, gsz = (nM - fm) < WGM ? (nM - fm) : WGM;
        u.pm = fm + ((wgid % nig) % gsz); u.pn = (wgid % nig) / gsz; return true;
    }
    __device__ __forceinline__ void a_ready(const Unit&) const {}
    __device__ __forceinline__ void done(const Unit&) const {}
};
__device__ __forceinline__ unsigned cvt_pk_bf16(float lo, float hi) { unsigned r; asm volatile("v_cvt_pk_bf16_f32 %0, %1, %2" : "=v"(r) : "v"(lo), "v"(hi)); return r; }
template <class Epi, class Sched, bool ALIGN_EPI = false, bool SP2 = false>
__device__ __forceinline__ void gemm_phase(PG8_LAS unsigned char* lds, const Gemm g, const Sched& S, const Epi& E) {
    const int tid = g.tid, wid = __builtin_amdgcn_readfirstlane(tid >> 6), lane = tid & 63, wr = wid >> 2, wc = wid & 3, fr = lane & 15, fq = lane >> 4;
    const int K = g.K, nt = K / BK;
    unsigned voffA[2], voffB[2];
#pragma unroll
    for (int i = 0; i < 2; ++i) { int R, C; stage_rc(tid * 16 + i * 8192, R, C); const int Rb = Epi::PERM ? ((R & ~31) + perm32(R & 31)) : R;
        voffA[i] = (unsigned)(R * g.lda + C) * 2u; voffB[i] = (unsigned)(Rb * K + C) * 2u; }
    const size_t kstep = (size_t)(BK * 2);
    const size_t hstep = (size_t)HALF * K * 2;
    const size_t tstep = 2 * hstep; const size_t hstepA = (size_t)HALF * g.lda * 2, tstepA = 2 * hstepA;
    const unsigned ldsw = (unsigned)wid * 1024u;
    const int aoff = lds_byte(wr * 64 + fr, fq * 8), boff = lds_byte(wc * 32 + fr, fq * 8);
#define PG8_SA(b, h) (((b) * 2 + (h)) * HTB)
#define PG8_SB(b, h) ((4 + (b) * 2 + (h)) * HTB)
#define PG8_STAGE(bufoff, gbase, voff) do { _Pragma("unroll") for (int _i = 0; _i < 2; ++_i) \
        __builtin_amdgcn_global_load_lds((const unsigned*)((const char*)(gbase) + (voff)[_i]), (PG8_LAS unsigned*)(lds + (bufoff) + ldsw + _i * 8192), 16, 0, 0); } while (0)
#define PG8_LDA(dst, b, h) do { _Pragma("unroll") for (int m = 0; m < 4; ++m) _Pragma("unroll") for (int k = 0; k < 2; ++k) dst[m][k] = *(const PG8_LAS bf16x8*)(lds + PG8_SA(b, h) + aoff + m * 2048 + k * 1024); } while (0)
#define PG8_LDB(dst, b, h) do { _Pragma("unroll") for (int n = 0; n < 2; ++n) _Pragma("unroll") for (int k = 0; k < 2; ++k) dst[n][k] = *(const PG8_LAS bf16x8*)(lds + PG8_SB(b, h) + boff + n * 2048 + k * 1024); } while (0)
#define PG8_MMA(ai, bj, At, Bt) do { __builtin_amdgcn_s_setprio(1); _Pragma("unroll") for (int m = 0; m < 4; ++m) _Pragma("unroll") for (int n = 0; n < 2; ++n) _Pragma("unroll") for (int k = 0; k < 2; ++k) \
        acc[ai][bj][m][n] = __builtin_amdgcn_mfma_f32_16x16x32_bf16(Bt[n][k], At[m][k], acc[ai][bj][m][n], 0, 0, 0); __builtin_amdgcn_s_setprio(0); } while (0)
#define PG8_WAIT_V(n) asm volatile("s_waitcnt vmcnt(" #n ")" ::: "memory")
#define PG8_WAIT_L(n) asm volatile("s_waitcnt lgkmcnt(" #n ")" ::: "memory")
#define PG8_BAR __builtin_amdgcn_s_barrier()
#define PG8_SCHED __builtin_amdgcn_sched_barrier(0)
    Unit cur, nxt; int ui = 0;
    if (!S.next(0, cur)) return;
    f32x4 acc[2][2][4][2];
#pragma unroll
    for (int a = 0; a < 2; ++a)
#pragma unroll
        for (int b = 0; b < 2; ++b)
#pragma unroll
            for (int m = 0; m < 4; ++m)
#pragma unroll
                for (int n = 0; n < 2; ++n) acc[a][b][m][n] = (f32x4){0.f, 0.f, 0.f, 0.f};
    bf16x8 At[4][2], B0[2][2], B1[2][2];
    const char* cA = (const char*)g.A + (size_t)cur.pm * tstepA; const char* cB = (const char*)g.Bt + (size_t)cur.pn * tstep;
    S.a_ready(cur);
    if constexpr (SP2) {
        PG8_STAGE(PG8_SB(0, 0), cB, voffB); PG8_STAGE(PG8_SB(0, 1), cB + hstep, voffB); PG8_STAGE(PG8_SA(0, 0), cA, voffA); PG8_STAGE(PG8_SA(0, 1), cA + hstepA, voffA);
        if (wr == 1) PG8_BAR;
        PG8_WAIT_V(2); PG8_BAR;
        PG8_STAGE(PG8_SB(1, 0), cB + kstep, voffB); PG8_STAGE(PG8_SA(1, 0), cA + kstep, voffA); PG8_STAGE(PG8_SB(1, 1), cB + hstep + kstep, voffB);
        PG8_WAIT_V(6); PG8_BAR;
    } else {
        PG8_STAGE(PG8_SB(0, 0), cB, voffB); PG8_STAGE(PG8_SA(0, 0), cA, voffA); PG8_STAGE(PG8_SB(0, 1), cB + hstep, voffB); PG8_STAGE(PG8_SA(0, 1), cA + hstepA, voffA);
        if (wr == 1) PG8_BAR;
        PG8_WAIT_V(4); PG8_BAR;
        PG8_STAGE(PG8_SB(1, 0), cB + kstep, voffB); PG8_STAGE(PG8_SA(1, 0), cA + kstep, voffA); PG8_STAGE(PG8_SB(1, 1), cB + hstep + kstep, voffB);
        PG8_WAIT_V(6); PG8_BAR;
    }
    for (;;) {
        const bool has_next = S.next(ui + 1, nxt);
        const char* nA = has_next ? (const char*)g.A + (size_t)nxt.pm * tstepA : cA; const char* nB = has_next ? (const char*)g.Bt + (size_t)nxt.pn * tstep : cB;
        for (int t = 0; t < nt; t += 2) {
            const bool last = (t == nt - 2);
            const char* a1 = cA + (size_t)(t + 1) * kstep;
            const char* a2 = last ? nA : cA + (size_t)(t + 2) * kstep; const char* b2 = last ? nB : cB + (size_t)(t + 2) * kstep;
            const char* a3 = a2 + kstep; const char* b3 = b2 + kstep;
            if (last && has_next) S.a_ready(nxt);
            if constexpr (SP2) {
            PG8_LDB(B0, 0, 0); PG8_LDB(B1, 0, 1); PG8_SCHED; PG8_LDA(At, 0, 0); PG8_STAGE(PG8_SA(1, 1), a1 + hstepA, voffA);
            PG8_WAIT_V(8); PG8_WAIT_L(0); PG8_BAR; PG8_MMA(0, 0, At, B0); PG8_MMA(0, 1, At, B1); PG8_BAR; PG8_SCHED;
            PG8_LDA(At, 0, 1); PG8_STAGE(PG8_SB(0, 0), b2, voffB); PG8_STAGE(PG8_SB(0, 1), b2 + hstep, voffB); PG8_STAGE(PG8_SA(0, 0), a2, voffA);
            PG8_WAIT_V(8); PG8_WAIT_L(0); PG8_BAR; PG8_MMA(1, 0, At, B0); PG8_MMA(1, 1, At, B1); PG8_BAR; PG8_SCHED;
            PG8_LDB(B0, 1, 0); PG8_LDB(B1, 1, 1); PG8_SCHED; PG8_LDA(At, 1, 0); PG8_STAGE(PG8_SA(0, 1), a2 + hstepA, voffA);
            PG8_WAIT_V(8); PG8_WAIT_L(0); PG8_BAR; PG8_MMA(0, 0, At, B0); PG8_MMA(0, 1, At, B1); PG8_BAR; PG8_SCHED;
            PG8_LDA(At, 1, 1); PG8_STAGE(PG8_SB(1, 0), b3, voffB); PG8_STAGE(PG8_SB(1, 1), b3 + hstep, voffB); PG8_STAGE(PG8_SA(1, 0), a3, voffA);
            PG8_WAIT_V(8); PG8_WAIT_L(0); PG8_BAR; PG8_MMA(1, 0, At, B0); PG8_MMA(1, 1, At, B1); PG8_BAR; PG8_SCHED;
            } else {
            PG8_LDB(B0, 0, 0); PG8_SCHED; PG8_LDA(At, 0, 0); PG8_STAGE(PG8_SA(1, 1), a1 + hstepA, voffA);
            PG8_WAIT_L(8); PG8_BAR; PG8_WAIT_L(0); PG8_MMA(0, 0, At, B0); PG8_BAR; PG8_SCHED;
            PG8_LDB(B1, 0, 1); PG8_STAGE(PG8_SB(0, 0), b2, voffB);
            PG8_BAR; PG8_WAIT_L(0); PG8_MMA(0, 1, At, B1); PG8_BAR;
            PG8_LDA(At, 0, 1); PG8_STAGE(PG8_SA(0, 0), a2, voffA);
            PG8_BAR; PG8_WAIT_L(0); PG8_MMA(1, 0, At, B0); PG8_BAR; PG8_SCHED;
            PG8_STAGE(PG8_SB(0, 1), b2 + hstep, voffB);
            PG8_WAIT_V(6); PG8_BAR; PG8_MMA(1, 1, At, B1); PG8_BAR;
            PG8_LDB(B0, 1, 0); PG8_SCHED; PG8_LDA(At, 1, 0); PG8_STAGE(PG8_SA(0, 1), a2 + hstepA, voffA);
            PG8_WAIT_L(8); PG8_BAR; PG8_WAIT_L(0); PG8_MMA(0, 0, At, B0); PG8_BAR; PG8_SCHED;
            PG8_LDB(B1, 1, 1); PG8_STAGE(PG8_SB(1, 0), b3, voffB);
            PG8_BAR; PG8_WAIT_L(0); PG8_MMA(0, 1, At, B1); PG8_BAR;
            PG8_LDA(At, 1, 1); PG8_STAGE(PG8_SA(1, 0), a3, voffA);
            PG8_BAR; PG8_WAIT_L(0); PG8_MMA(1, 0, At, B0); PG8_BAR; PG8_SCHED;
            PG8_STAGE(PG8_SB(1, 1), b3 + hstep, voffB);
            PG8_WAIT_V(6); PG8_BAR; PG8_MMA(1, 1, At, B1); PG8_BAR;
            }
        }
        if constexpr (ALIGN_EPI) { if (wr == 0) PG8_BAR; }
        if constexpr (!Epi::AFTER_DRAIN) { E(acc, cur, wr, wc, fr, fq); S.done(cur); }
        if (!has_next) break;
#pragma unroll
        for (int a = 0; a < 2; ++a)
#pragma unroll
            for (int b = 0; b < 2; ++b)
#pragma unroll
                for (int m = 0; m < 4; ++m)
#pragma unroll
                    for (int n = 0; n < 2; ++n) acc[a][b][m][n] = (f32x4){0.f, 0.f, 0.f, 0.f};
        cur = nxt; cA = nA; cB = nB; ++ui;
        if constexpr (ALIGN_EPI) { if (wr == 1) PG8_BAR; }
    }
    PG8_WAIT_V(0);
    if constexpr (!ALIGN_EPI) { if (wr == 0) PG8_BAR; }
    PG8_BAR;
    if constexpr (Epi::AFTER_DRAIN) { E.fused(acc, cur, wr, wc, fr, fq, lds, wid, lane); S.done(cur); }
#undef PG8_SA
#undef PG8_SB
#undef PG8_STAGE
#undef PG8_LDA
#undef PG8_LDB
#undef PG8_MMA
#undef PG8_WAIT_V
#undef PG8_WAIT_L
#undef PG8_BAR
#undef PG8_SCHED
}
}
#ifndef MK_SINGLE
#define MK_SINGLE 1
#endif
#define DI __device__ __forceinline__
#define LAS __attribute__((address_space(3)))
typedef unsigned short bf16;
typedef float f32x4 __attribute__((ext_vector_type(4)));
typedef short bf16x8 __attribute__((ext_vector_type(8)));
typedef unsigned u32x4 __attribute__((ext_vector_type(4)));
typedef unsigned u32x2 __attribute__((ext_vector_type(2)));

constexpr int T = 24576, TC = 8192, D = 1024, FF = 2816, NA = 928, NB = 1816, NKV = 25600;
constexpr int NWAVES = 8, NTHR = 512;
constexpr float EPS = 1e-6f;
constexpr float LOG2E = 1.4426950408889634f;
constexpr size_t O_Y = 0, O_SDN = 25165824, O_CKV = 27262976, O_KPE = 29360128, O_SSM = 29884416, O_SK = 31981568, O_SV = 34078720;
constexpr size_t MiB = 1u << 20, KiB = 1024;
constexpr size_t WS_ADA = 64 * KiB;
constexpr size_t WS_ROPE = 1 * MiB;
constexpr size_t WS_RS = 3 * MiB;
constexpr size_t WS_SSQ = 3 * MiB + 256 * KiB;
constexpr size_t WS_CKVC = 4 * MiB;
constexpr size_t WS_KPEC = 4 * MiB + 512 * KiB;
constexpr size_t WS_SWAKC = WS_KPEC + 64 * KiB;
constexpr size_t WS_SWAVC = WS_SWAKC + 256 * KiB;
constexpr size_t WS_WUQ = 5 * MiB + 256 * KiB;
constexpr size_t WS_WUKV = WS_WUQ + 256 * KiB;
constexpr size_t WS_WUKVC = WS_WUKV + 256 * KiB;
constexpr size_t WS_WIN = 6 * MiB;
constexpr size_t WS_WOUT = 12 * MiB;
constexpr size_t WS_WGU = 14 * MiB;
constexpr size_t WS_WDN = 25 * MiB;
constexpr size_t WS_XN = 31 * MiB;
constexpr size_t WS_MIX = 79 * MiB;
constexpr size_t WS_PA = 127 * MiB;
constexpr size_t WS_KV16 = 171 * MiB;
constexpr size_t WS_QRAW = 196 * MiB;
constexpr size_t WS_PB = 127 * MiB;
constexpr size_t WS_MN = 213 * MiB;
constexpr size_t WS_CS = 229 * MiB;
constexpr size_t WS_CD = 237 * MiB;
constexpr size_t WS_SIDE = 238 * MiB;
constexpr size_t WS_CKV16 = 214 * MiB;
constexpr size_t WS_QN16 = 227 * MiB;
constexpr size_t WS_ACT = 79 * MiB;
constexpr size_t WS_KPER = 239 * MiB;
constexpr size_t WS_KSR = 240 * MiB;
constexpr size_t WS_END = 244 * MiB;
constexpr int LDS_BYTES = 147456;

typedef float f32x2_t __attribute__((ext_vector_type(2)));
typedef __bf16 bf16x2_t __attribute__((ext_vector_type(2)));
DI unsigned pk2(float lo, float hi) { const f32x2_t v = {lo, hi}; const bf16x2_t b = __builtin_convertvector(v, bf16x2_t); return __builtin_bit_cast(unsigned, b); }
DI unsigned f2bf(float f) { return pk2(f, 0.f) & 0xffffu; }
DI float bflo(unsigned v) { return __builtin_bit_cast(float, v << 16); }
DI float bfhi(unsigned v) { return __builtin_bit_cast(float, v & 0xffff0000u); }
DI void unpack8(u32x4 v, float* f) { f[0] = bflo(v.x); f[1] = bfhi(v.x); f[2] = bflo(v.y); f[3] = bfhi(v.y); f[4] = bflo(v.z); f[5] = bfhi(v.z); f[6] = bflo(v.w); f[7] = bfhi(v.w); }
DI void ld8(const bf16* p, float* f) { unpack8(*(const u32x4*)p, f); }
DI u32x4 pack8(const float* f) { u32x4 o; o.x = pk2(f[0], f[1]); o.y = pk2(f[2], f[3]); o.z = pk2(f[4], f[5]); o.w = pk2(f[6], f[7]); return o; }
DI float wave_sum(float v) {
#pragma unroll
    for (int o = 32; o; o >>= 1) v += __shfl_xor(v, o);
    return v; }
DI float siluf(float x) { return x / (1.f + expf(-x)); }
DI float fsilu(float x) { return x * __builtin_amdgcn_rcpf(1.f + __expf(-x)); }
DI float softplusf(float x) { return x > 20.f ? x : log1pf(expf(x)); }
DI float fsoftplus(float x) { const float y = __expf(x); return x > 20.f ? x : (y < 1e-3f ? y * (1.f - 0.5f * y) : __logf(1.f + y)); }

struct EpiP {
    static constexpr bool PERM = true, AFTER_DRAIN = false;
    bf16* P; int ldc, ncols, mode, layer; float* out; float* side;
    DI void operator()(const pg8::f32x4 (&acc)[2][2][4][2], const pg8::Unit& u, int wr, int wc, int fr, int fq) const {
        const int row0 = u.pm * 256 + wr * 64 + fr, col0 = u.pn * 256 + wc * 32 + 8 * fq;
#pragma unroll
        for (int ai = 0; ai < 2; ++ai)
#pragma unroll
            for (int m = 0; m < 4; ++m) { const int row = row0 + ai * 128 + m * 16;
#pragma unroll
                for (int bj = 0; bj < 2; ++bj) { const int c = col0 + bj * 128; const pg8::f32x4 v0 = acc[ai][bj][m][0], v1 = acc[ai][bj][m][1];
                    if (c < ncols) { u32x4 w; w.x = pk2(v0[0], v0[1]); w.y = pk2(v0[2], v0[3]); w.z = pk2(v1[0], v1[1]); w.w = pk2(v1[2], v1[3]); *(u32x4*)(P + (size_t)row * ldc + c) = w; }
                    float* dst = nullptr;
                    if (mode == 0) { if (row < TC) { const size_t rb = (size_t)((row >> 8) * 2 + layer) * 256 + (row & 255);
                            if (c >= 256 && c < 384) dst = out + O_CKV + rb * 128 + (c - 256);
                            else if (c >= 384 && c < 416) dst = out + O_KPE + rb * 32 + (c - 384);
                            else if (c >= 672 && c < 800) dst = out + O_SK + rb * 128 + (c - 672);
                            else if (c >= 800 && c < 928) dst = out + O_SV + rb * 128 + (c - 800); } }
                    else { if (c >= 1024 && c < 1040) dst = side + (size_t)row * 24 + (c - 1024); else if (c >= 1808 && c < 1816) dst = side + (size_t)row * 24 + 16 + (c - 1808); }
                    if (dst) { *(pg8::f32x4*)dst = v0; *(pg8::f32x4*)(dst + 4) = v1; } } }
    }
};
struct EpiRS {
    static constexpr bool PERM = true, AFTER_DRAIN = false;
    bf16* O; int ldc, ncols;
    DI void operator()(const pg8::f32x4 (&acc)[2][2][4][2], const pg8::Unit& u, int wr, int wc, int fr, int fq) const {
        const int row0 = u.pm * 256 + wr * 64 + fr, col0 = u.pn * 256 + wc * 32 + 8 * fq;
#pragma unroll
        for (int ai = 0; ai < 2; ++ai)
#pragma unroll
            for (int m = 0; m < 4; ++m) { const int row = row0 + ai * 128 + m * 16;
#pragma unroll
                for (int bj = 0; bj < 2; ++bj) { const int c = col0 + bj * 128; const pg8::f32x4 v0 = acc[ai][bj][m][0], v1 = acc[ai][bj][m][1];
                    if (c < ncols) { u32x4 w; w.x = pk2(v0[0], v0[1]); w.y = pk2(v0[2], v0[3]); w.z = pk2(v1[0], v1[1]); w.w = pk2(v1[2], v1[3]); *(u32x4*)(O + (size_t)row * ldc + c) = w; } } }
    }
};
struct EpiRes {
    static constexpr bool PERM = false, AFTER_DRAIN = false;
    const float* src_c; const float* src_l; float* dst; const float* ada; int goff;
    DI void operator()(const pg8::f32x4 (&acc)[2][2][4][2], const pg8::Unit& u, int wr, int wc, int fr, int fq) const {
        const int row0 = u.pm * 256 + wr * 64 + fr, col0 = u.pn * 256 + wc * 32 + 4 * fq;
        const int rt = u.pm * 256; const int r = rt < TC ? 0 : 1 + ((rt - TC) >> 12);
        const float* g = ada + (size_t)r * 6144 + goff;
        pg8::f32x4 gv[2][2];
#pragma unroll
        for (int bj = 0; bj < 2; ++bj)
#pragma unroll
            for (int n = 0; n < 2; ++n) gv[bj][n] = *(const pg8::f32x4*)(g + col0 + bj * 128 + n * 16);
#pragma unroll
        for (int ai = 0; ai < 2; ++ai)
#pragma unroll
            for (int m = 0; m < 4; ++m) { const int row = row0 + ai * 128 + m * 16;
                const float* sp = (row < TC ? src_c + (size_t)row * D : src_l + (size_t)(row - TC) * D) + col0; float* dp = dst + (size_t)row * D + col0;
#pragma unroll
                for (int bj = 0; bj < 2; ++bj)
#pragma unroll
                    for (int n = 0; n < 2; ++n) { const pg8::f32x4 xo = *(const pg8::f32x4*)(sp + bj * 128 + n * 16); *(pg8::f32x4*)(dp + bj * 128 + n * 16) = xo + gv[bj][n] * acc[ai][bj][m][n]; } }
    }
};
struct EpiSwiglu {
    static constexpr bool PERM = true, AFTER_DRAIN = false;
    bf16* O;
    DI void operator()(const pg8::f32x4 (&acc)[2][2][4][2], const pg8::Unit& u, int wr, int wc, int fr, int fq) const {
        const int row0 = u.pm * 256 + wr * 64 + fr, col0 = u.pn * 128 + wc * 32 + 8 * fq;
#pragma unroll
        for (int ai = 0; ai < 2; ++ai)
#pragma unroll
            for (int m = 0; m < 4; ++m) { const int row = row0 + ai * 128 + m * 16; float o[8];
#pragma unroll
                for (int n = 0; n < 2; ++n)
#pragma unroll
                    for (int i = 0; i < 4; ++i) { const float gt = acc[ai][0][m][n][i], up = acc[ai][1][m][n][i]; o[n * 4 + i] = fsilu(gt) * up; }
                *(u32x4*)(O + (size_t)row * FF + col0) = pack8(o); }
    }
};
#define RLX_AGENT __ATOMIC_RELAXED, __HIP_MEMORY_SCOPE_AGENT
#define XB_TMO      128
#define XB_XCNT(j)  (256  + 64 * (j))
#define XB_XSUB(j)  (1280 + 64 * (j))
#define XB_XGEN(j)  (2304 + 64 * (j))
#define XB_TOP      3328
#define XB_TOPGEN   3392
#define XCD_BAR_WORDS 3456
#define XB_SPIN_CAP (1u << 18)

__device__ __forceinline__ unsigned xb_ld(unsigned* p)              { return __hip_atomic_load(p, __ATOMIC_RELAXED, __HIP_MEMORY_SCOPE_AGENT); }
__device__ __forceinline__ unsigned xb_add(unsigned* p, unsigned v) { return __hip_atomic_fetch_add(p, v, __ATOMIC_RELAXED, __HIP_MEMORY_SCOPE_AGENT); }
__device__ __forceinline__ unsigned xb_xcc_id() { return (unsigned)__builtin_amdgcn_s_getreg((3 << 11) | 20) & 0xFu; }
#define XB_SPIN(cond, bar) do { unsigned _sp = 0; while (cond) { __builtin_amdgcn_s_sleep(1); \
    if ((++_sp & 255u) == 0u) { if (xb_ld(&(bar)[XB_TMO])) break; if (_sp > XB_SPIN_CAP) { atomicAdd(&(bar)[XB_TMO], 1u); break; } } } } while (0)

struct XcdBarrier {
    unsigned* bar; unsigned x;
    volatile LAS unsigned* st;
};

__device__ __forceinline__ XcdBarrier xcd_barrier_post(unsigned* bar, volatile LAS unsigned* st) {
    XcdBarrier b; b.bar = bar; b.x = xb_xcc_id(); b.st = st;
    if (threadIdx.x == 0) (void)xb_add(&bar[XB_XCNT(b.x)], 1u);
    return b;
}
__device__ __forceinline__ void xcd_barrier_complete(unsigned* bar, unsigned x, unsigned& nloc, unsigned& nx) {
    const unsigned G = gridDim.x * gridDim.y * gridDim.z;
    unsigned sum, cnt, mine, sp = 0u;
    for (;;) {
        sum = 0u; cnt = 0u; mine = 0u;
#pragma unroll
        for (unsigned j = 0; j < 16; ++j) { const unsigned c = xb_ld(&bar[XB_XCNT(j)]); sum += c; cnt += (c > 0u) ? 1u : 0u; mine = (j == x) ? c : mine; }
        if (sum == G) break;
        __builtin_amdgcn_s_sleep(1);
        if ((++sp & 255u) == 0u) { if (xb_ld(&bar[XB_TMO])) break; if (sp > XB_SPIN_CAP) { atomicAdd(&bar[XB_TMO], 1u); break; } }
    }
    nloc = mine > 0u ? mine : 1u; nx = cnt > 0u ? cnt : 1u;
}

__device__ __forceinline__ void xcd_barrier(const XcdBarrier& b) {
    asm volatile("s_waitcnt vmcnt(0)" ::: "memory");
    __syncthreads();
    if (threadIdx.x == 0) {
        unsigned* bar = b.bar;
        __builtin_amdgcn_s_waitcnt(0);
        unsigned nloc = b.st[0], nx = b.st[1];
        if (nloc == 0u) { xcd_barrier_complete(bar, b.x, nloc, nx); b.st[0] = nloc; b.st[1] = nx; }
        const unsigned old = xb_add(&bar[XB_XSUB(b.x)], 1u);
        const unsigned gen = old / nloc;
        if (old + 1u == (gen + 1u) * nloc) {
            __builtin_amdgcn_fence(__ATOMIC_RELEASE, "agent");
            asm volatile("s_waitcnt vmcnt(0)" ::: "memory");
            const unsigned og = xb_add(&bar[XB_TOP], 1u);
            const unsigned tg = og / nx;
            if (og + 1u == (tg + 1u) * nx) xb_add(&bar[XB_TOPGEN], 1u);
            else XB_SPIN(xb_ld(&bar[XB_TOPGEN]) == tg, bar);
            __builtin_amdgcn_fence(__ATOMIC_ACQUIRE, "agent");
            xb_add(&bar[XB_XGEN(b.x)], 1u);
            asm volatile("s_waitcnt vmcnt(0)" ::: "memory");
        } else {
            XB_SPIN(xb_ld(&bar[XB_XGEN(b.x)]) == gen, bar);
            __builtin_amdgcn_fence(__ATOMIC_ACQUIRE, "agent");
            asm volatile("s_waitcnt vmcnt(0)" ::: "memory");
        }
    }
    __syncthreads();
}
DI int map_col(int id, int n, int nvalid) {
    if (id == 0) return n;
    if (id == 1) { if (n < 1024) { if (n < 416) return 1040 + n; if (n < 928) return 2232 + (n - 416); return -1; }
        const int b = n - 1024; if (b < 1040) return b; if (b < 1816) return 1456 + (b - 1040); return -1; }
    if (id == 2) { const int pn = n >> 8, bj = (n >> 7) & 1, cc = n & 127; return bj * FF + pn * 128 + cc; }
    return n < nvalid ? n : -1;
}
DI void transpose_item(const float* W, int ldw, int Ksrc, int mapid, int nvalid, const float* kscale, bf16* WT, int Kd, int nblk, LAS float* scr, int item, int lane) {
    const int kb = item / nblk, nb = item % nblk, k0 = 64 * kb, n0 = 32 * nb;
    const int n4 = (lane & 7) * 4; const int sc = map_col(mapid, n0 + n4, nvalid);
    (void)kscale;
#pragma unroll
    for (int i = 0; i < 8; ++i) { const int kk = 8 * i + (lane >> 3), k = k0 + kk; f32x4 v = {0.f, 0.f, 0.f, 0.f};
        if (sc >= 0 && k < Ksrc) v = *(const f32x4*)(W + (size_t)k * ldw + sc);
        LAS float* d = scr + kk * 33 + n4; d[0] = v.x; d[1] = v.y; d[2] = v.z; d[3] = v.w; }
    asm volatile("s_waitcnt lgkmcnt(0)" ::: "memory");
    const int c = lane & 7;
#pragma unroll
    for (int j = 0; j < 4; ++j) { const int n = (lane >> 3) + 8 * j; const LAS float* s = scr + (8 * c) * 33 + n;
        u32x4 o; o.x = pk2(s[0 * 33], s[1 * 33]); o.y = pk2(s[2 * 33], s[3 * 33]); o.z = pk2(s[4 * 33], s[5 * 33]); o.w = pk2(s[6 * 33], s[7 * 33]);
        *(u32x4*)(WT + (size_t)(n0 + n) * Kd + k0 + 8 * c) = o; }
    asm volatile("s_waitcnt lgkmcnt(0)" ::: "memory");
}

struct Ctx {
    const float* const* in; float* out; unsigned char* ws; LAS unsigned char* lds; int tid, lane, wave, bid, G;
};

DI void phase_weights(const Ctx& C, int l, int mask, int bid, int G) {
    LAS float* scr = (LAS float*)(C.lds + C.wave * 16384);
    const int gw = bid * NWAVES + C.wave, NGW = G * NWAVES;
    constexpr int I_IN = 16 * 96, I_OUT = 16 * 32, I_GU = 16 * 176, I_DN = 44 * 32, I_Q = 4 * 16, I_KV = 4 * 16;
    constexpr int NIT = I_IN + I_OUT + I_GU + I_DN + I_Q + I_KV;
    unsigned char* ws = C.ws;
    for (int it = gw; it < NIT; it += NGW) { int r = it;
        { const int cls = it < I_IN ? 0 : (it < I_IN + I_OUT ? 2 : (it < I_IN + I_OUT + I_GU ? 3 : (it < I_IN + I_OUT + I_GU + I_DN ? 1 : 0))); if (!((mask >> cls) & 1)) continue; }
        if (r < I_IN) { transpose_item(C.in[14] + (size_t)l * 1024 * 2744, 2744, 1024, 1, 0, nullptr, (bf16*)(ws + WS_WIN), 1024, 96, scr, r, C.lane); continue; } r -= I_IN;
        if (r < I_OUT) { transpose_item(C.in[15] + (size_t)l * 1024 * 1024, 1024, 1024, 0, 0, nullptr, (bf16*)(ws + WS_WOUT), 1024, 32, scr, r, C.lane); continue; } r -= I_OUT;
        if (r < I_GU) { transpose_item(C.in[31] + (size_t)l * 1024 * 5632, 5632, 1024, 2, 0, nullptr, (bf16*)(ws + WS_WGU), 1024, 176, scr, r, C.lane); continue; } r -= I_GU;
        if (r < I_DN) { transpose_item(C.in[32] + (size_t)l * 2816 * 1024, 1024, 2816, 0, 0, nullptr, (bf16*)(ws + WS_WDN), 2816, 32, scr, r, C.lane); continue; } r -= I_DN;
        if (r < I_Q) { transpose_item(C.in[21] + (size_t)l * 256 * 384, 384, 256, 3, 384, nullptr, (bf16*)(ws + WS_WUQ), 256, 16, scr, r, C.lane); continue; } r -= I_Q;
        transpose_item(C.in[23] + (size_t)l * 128 * 512, 512, 128, 3, 512, nullptr, (bf16*)(ws + WS_WUKV), 256, 16, scr, r, C.lane);
    }
    if (!(mask & 1)) return;
    const int gt = bid * NTHR + C.tid, NGT = G * NTHR;
    bf16* ckvc = (bf16*)(ws + WS_CKV16) + (size_t)T * 256; bf16* kpec = (bf16*)(ws + WS_KPEC); bf16* skc = (bf16*)(ws + WS_SWAKC); bf16* svc = (bf16*)(ws + WS_SWAVC);
    for (int i = gt; i < 1024 * 256; i += NGT) { const int row = i >> 8, c = i & 255, b = row >> 8, t = row & 255;
        ckvc[i] = c < 128 ? (bf16)f2bf(C.in[4][((size_t)(b * 2 + l) * 256 + t) * 128 + c]) : (bf16)0; }
    for (int i = gt; i < 1024 * 32; i += NGT) { const int row = i >> 5, c = i & 31, b = row >> 8, t = row & 255; kpec[i] = (bf16)f2bf(C.in[5][((size_t)(b * 2 + l) * 256 + t) * 32 + c]); }
    for (int i = gt; i < 1024 * 128; i += NGT) { const int row = i >> 7, c = i & 127, b = row >> 8, t = row & 255; const size_t s = ((size_t)(b * 2 + l) * 256 + t) * 128 + c;
        skc[i] = (bf16)f2bf(C.in[7][s]); svc[i] = (bf16)f2bf(C.in[8][s]); }
}

DI void phase_ada_rope(const Ctx& C) {
    LAS float* sc = (LAS float*)C.lds;
    LAS float* red = sc + 5 * 1024;
    for (int i = C.tid; i < 5 * 1024; i += NTHR) { const int r = i >> 10, k = i & 1023; const float v = r == 0 ? C.in[9][k] : C.in[2][(r - 1) * 1024 + k]; sc[i] = siluf(v); }
    __syncthreads();
    float* ada = (float*)(C.ws + WS_ADA);
    for (int it = C.bid; it < 192; it += C.G) { const int l = it / 96, n = (it % 96) * 64 + C.lane;
        const float* w = C.in[12] + (size_t)l * 1024 * 6144 + n; float a[5] = {0.f, 0.f, 0.f, 0.f, 0.f};
#pragma unroll 4
        for (int kk = 0; kk < 128; ++kk) { const int k = C.wave * 128 + kk; const float wv = w[(size_t)k * 6144];
#pragma unroll
            for (int r = 0; r < 5; ++r) a[r] += sc[r * 1024 + k] * wv; }
#pragma unroll
        for (int r = 0; r < 5; ++r) red[(C.wave * 5 + r) * 64 + C.lane] = a[r];
        __syncthreads();
        if (C.tid < 320) { const int r = C.tid >> 6, ln = C.tid & 63; float s = 0.f;
#pragma unroll
            for (int w8 = 0; w8 < 8; ++w8) s += red[(w8 * 5 + r) * 64 + ln];
            const int nn = (it % 96) * 64 + ln; ada[((size_t)l * 5 + r) * 6144 + nn] = s + C.in[13][l * 6144 + nn]; }
        __syncthreads();
    }
    float* rt = (float*)(C.ws + WS_ROPE);
    const int gt = C.bid * NTHR + C.tid, NGT = C.G * NTHR;
    for (int i = gt; i < 4096 * 16; i += NGT) { const int t = i >> 4, j = i & 15; const float pos = (float)(j < 8 ? (t >> 6) : (t & 63)); const int f = j & 7;
        const float inv = powf(10000.f, -(float)f / 8.f); const float ang = pos * inv; rt[i] = cosf(ang); rt[65536 + i] = sinf(ang); }
    for (int i = gt; i < 4096 * 32; i += NGT) { const int t = i >> 5, j = i & 31; const float pos = (float)(j < 16 ? (t >> 6) : (t & 63)); const int f = j & 15;
        const float inv = powf(10000.f, -(float)f / 16.f); const float ang = pos * inv; rt[131072 + i] = cosf(ang); rt[262144 + i] = sinf(ang); }
}

DI void phase_norm(const Ctx& C, const float* src_c, const float* src_l, const float* nw, const float* ada, int which, bf16* dst) {
    const int gw = C.bid * NWAVES + C.wave, NGW = C.G * NWAVES;
    for (int row0 = gw; row0 < T; row0 += 4 * NGW) {
        f32x4 v[4][4]; float s[4]; const float* shp[4]; int rows[4]; bool ok[4];
#pragma unroll
        for (int u = 0; u < 4; ++u) { const int row = row0 + u * NGW; rows[u] = row; ok[u] = row < T; const int rr = ok[u] ? row : row0;
            const float* x = rr < TC ? src_c + (size_t)rr * D : src_l + (size_t)(rr - TC) * D;
            const int r = rr < TC ? 0 : 1 + ((rr - TC) >> 12); shp[u] = ada + (size_t)r * 6144 + which * 3072; s[u] = 0.f;
#pragma unroll
            for (int j = 0; j < 4; ++j) { v[u][j] = *(const f32x4*)(x + 256 * j + 4 * C.lane); s[u] += v[u][j].x * v[u][j].x + v[u][j].y * v[u][j].y + v[u][j].z * v[u][j].z + v[u][j].w * v[u][j].w; } }
#pragma unroll
        for (int u = 0; u < 4; ++u) { const float rstd = rsqrtf(wave_sum(s[u]) * (1.f / D) + EPS); const float* sh = shp[u]; const float* scl = sh + 1024;
            if (ok[u]) {
#pragma unroll
                for (int j = 0; j < 4; ++j) { const int c = 256 * j + 4 * C.lane; const f32x4 w = *(const f32x4*)(nw + c), a = *(const f32x4*)(scl + c), b = *(const f32x4*)(sh + c);
                    const f32x4 y = v[u][j] * rstd * w * (a + 1.f) + b; u32x2 o; o.x = pk2(y.x, y.y); o.y = pk2(y.z, y.w); *(u32x2*)(dst + (size_t)rows[u] * D + c) = o; } } }
    }
}
DI void phase_final_norm(const Ctx& C, const float* nw) {
    const int gw = C.bid * NWAVES + C.wave, NGW = C.G * NWAVES;
    for (int row0 = gw; row0 < T; row0 += 4 * NGW) {
        f32x4 v[4][4]; float s[4];
#pragma unroll
        for (int u = 0; u < 4; ++u) { const int row = row0 + u * NGW; const float* x = C.out + (size_t)(row < T ? row : row0) * D; s[u] = 0.f;
#pragma unroll
            for (int j = 0; j < 4; ++j) { v[u][j] = *(const f32x4*)(x + 256 * j + 4 * C.lane); s[u] += v[u][j].x * v[u][j].x + v[u][j].y * v[u][j].y + v[u][j].z * v[u][j].z + v[u][j].w * v[u][j].w; } }
#pragma unroll
        for (int u = 0; u < 4; ++u) { const int row = row0 + u * NGW; const float rstd = rsqrtf(wave_sum(s[u]) * (1.f / D) + EPS);
            if (row < T) { float* x = C.out + (size_t)row * D;
#pragma unroll
                for (int j = 0; j < 4; ++j) { const int c = 256 * j + 4 * C.lane; *(f32x4*)(x + c) = v[u][j] * rstd * *(const f32x4*)(nw + c); } } }
    }
}
DI void phase_mla_prep(const Ctx& C, int l) {
    const int gw = C.bid * NWAVES + C.wave, NGW = C.G * NWAVES;
    const bf16* pA = (const bf16*)(C.ws + WS_PA); bf16* qn = (bf16*)(C.ws + WS_QN16); bf16* ckv = (bf16*)(C.ws + WS_CKV16);
    const float* wq = C.in[20] + l * 256; const float* wkv = C.in[22] + l * 128; const float* rt = (const float*)(C.ws + WS_ROPE);
    for (int row0 = gw; row0 < T; row0 += 2 * NGW) {
        unsigned qa[2], qb[2]; float ka[2], kb[2]; float* op[2]; unsigned kpe1[2], kpe2[2], sk1[2], sk2[2];
#pragma unroll
        for (int u = 0; u < 2; ++u) { const int row = row0 + u * NGW; const bf16* p = pA + (size_t)row * NA;
            const unsigned* pq = (const unsigned*)p + 2 * C.lane; qa[u] = pq[0]; qb[u] = pq[1]; op[u] = nullptr; kpe1[u] = kpe2[u] = sk1[u] = sk2[u] = 0u;
            if (row < TC) { float* o = C.out + O_CKV + ((size_t)((row >> 8) * 2 + l) * 256 + (row & 255)) * 128; op[u] = o; ka[u] = o[2 * C.lane]; kb[u] = o[2 * C.lane + 1]; }
            else { const unsigned vv = ((const unsigned*)(p + 256))[C.lane]; ka[u] = bflo(vv); kb[u] = bfhi(vv);
                const int i16 = C.lane & 15, kvh = C.lane >> 5, i32 = C.lane & 31;
                kpe1[u] = p[384 + i16]; kpe2[u] = p[400 + i16]; sk1[u] = p[672 + kvh * 64 + i32]; sk2[u] = p[672 + kvh * 64 + 32 + i32]; } }
#pragma unroll
        for (int u = 0; u < 2; ++u) { const int row = row0 + u * NGW;
            { const float x0 = bflo(qa[u]), x1 = bfhi(qa[u]), x2 = bflo(qb[u]), x3 = bfhi(qb[u]);
              const float r = rsqrtf(wave_sum(x0 * x0 + x1 * x1 + x2 * x2 + x3 * x3) * (1.f / 256) + EPS); const f32x4 w = *(const f32x4*)(wq + 4 * C.lane);
              u32x2 o; o.x = pk2(x0 * r * w.x, x1 * r * w.y); o.y = pk2(x2 * r * w.z, x3 * r * w.w); *(u32x2*)(qn + (size_t)row * 256 + 4 * C.lane) = o; }
            const float r = rsqrtf(wave_sum(ka[u] * ka[u] + kb[u] * kb[u]) * (1.f / 128) + EPS); const float a = ka[u] * r * wkv[2 * C.lane], b = kb[u] * r * wkv[2 * C.lane + 1];
            if (op[u]) { op[u][2 * C.lane] = a; op[u][2 * C.lane + 1] = b; }
            unsigned* co = (unsigned*)(ckv + (size_t)row * 256); co[C.lane] = pk2(a, b); co[64 + C.lane] = 0u;
            if (row >= TC) { const int lr = row - TC, t = lr & 4095;
                bf16* kper = (bf16*)(C.ws + WS_KPER) + (size_t)lr * 32; bf16* ksr = (bf16*)(C.ws + WS_KSR) + (size_t)lr * 128;
                if (C.lane < 16) { const int i = C.lane; const float x1 = bflo(kpe1[u]), x2 = bflo(kpe2[u]), c = rt[t * 16 + i], s = rt[65536 + t * 16 + i];
                    kper[i] = (bf16)f2bf(x1 * c - x2 * s); kper[16 + i] = (bf16)f2bf(x1 * s + x2 * c); }
                { const int kvh = C.lane >> 5, i = C.lane & 31; const float x1 = bflo(sk1[u]), x2 = bflo(sk2[u]), c = rt[131072 + t * 32 + i], s = rt[262144 + t * 32 + i];
                    ksr[kvh * 64 + i] = (bf16)f2bf(x1 * c - x2 * s); ksr[kvh * 64 + 32 + i] = (bf16)f2bf(x1 * s + x2 * c); } }
        }
    }
}
DI void mm64(f32x4& c0, f32x4& c1, const LAS float* A, int sai, int sak, const LAS float* B, int sbk, int sbj, int wave, int lane) {
    const int r = lane & 15, q = lane >> 4, tr = wave >> 1, tc = (wave & 1) * 2;
    const LAS float* ap = A + (tr * 16 + r) * sai + q * sak;
    const LAS float* bp = B + q * sbk + (tc * 16 + r) * sbj;
#pragma unroll
    for (int s0 = 0; s0 < 16; s0 += 8) { float av[8], b0v[8], b1v[8];
#pragma unroll
        for (int s = 0; s < 8; ++s) { av[s] = ap[4 * (s0 + s) * sak]; b0v[s] = bp[4 * (s0 + s) * sbk]; b1v[s] = bp[4 * (s0 + s) * sbk + 16 * sbj]; }
        __builtin_amdgcn_sched_barrier(0);
#pragma unroll
        for (int s = 0; s < 8; ++s) { c0 = __builtin_amdgcn_mfma_f32_16x16x4f32(av[s], b0v[s], c0, 0, 0, 0); c1 = __builtin_amdgcn_mfma_f32_16x16x4f32(av[s], b1v[s], c1, 0, 0, 0); } }
}
DI void lds_sync() { asm volatile("s_waitcnt lgkmcnt(0)" ::: "memory"); __builtin_amdgcn_s_barrier(); asm volatile("" ::: "memory"); }
constexpr int BS = 72;
constexpr int BTB = 64 * BS * 2;
DI void mmb(f32x4& c0, f32x4& c1, const LAS bf16* A, const LAS bf16* B, int wave, int lane) {
    const int r = lane & 15, q = lane >> 4, tr = wave >> 1, tc = (wave & 1) * 2;
    const LAS bf16* ap = A + (tr * 16 + r) * BS + q * 8; const LAS bf16* bp = B + (tc * 16 + r) * BS + q * 8;
#pragma unroll
    for (int ks = 0; ks < 2; ++ks) {
        const bf16x8 a = *(const LAS bf16x8*)(ap + ks * 32), b0 = *(const LAS bf16x8*)(bp + ks * 32), b1 = *(const LAS bf16x8*)(bp + 16 * BS + ks * 32);
        c0 = __builtin_amdgcn_mfma_f32_16x16x32_bf16(a, b0, c0, 0, 0, 0);
        c1 = __builtin_amdgcn_mfma_f32_16x16x32_bf16(a, b1, c1, 0, 0, 0);
    }
}
#define MM_EPI(c0, c1, body) do { const int r_ = C.lane & 15, q_ = C.lane >> 4, tr_ = C.wave >> 1, tc_ = (C.wave & 1) * 2; \
    _Pragma("unroll") for (int j_ = 0; j_ < 4; ++j_) { const int row = tr_ * 16 + q_ * 4 + j_; { const int col = tc_ * 16 + r_; const float val = c0[j_]; body } { const int col = tc_ * 16 + 16 + r_; const float val = c1[j_]; body } } } while (0)
constexpr int FS = 68;
constexpr int FTB = 18432;
constexpr int LS = 68;
constexpr f32x4 Z4 = {0.f, 0.f, 0.f, 0.f};
DI bf16 tobf(float x) { return (bf16)f2bf(x); }

DI void tri_solve_blocked(const Ctx& C, const LAS float* As, LAS float* Us, LAS float* Ws, LAS float* Dv, LAS bf16* Wb) {
    if (C.wave == 0) { const int b = C.lane >> 4, c = C.lane & 15; float x[16];
#pragma unroll
        for (int i = 0; i < 16; ++i) { float v = (i == c) ? 1.f : 0.f;
#pragma unroll
            for (int j4 = 0; j4 < (i + 3) / 4; ++j4) { const f32x4 a = *(const LAS f32x4*)(As + (16 * b + i) * FS + 16 * b + 4 * j4);
                if (4 * j4 + 0 < i) v -= a.x * x[4 * j4 + 0];
                if (4 * j4 + 1 < i) v -= a.y * x[4 * j4 + 1];
                if (4 * j4 + 2 < i) v -= a.z * x[4 * j4 + 2];
                if (4 * j4 + 3 < i) v -= a.w * x[4 * j4 + 3]; }
            x[i] = v; Dv[(b * 16 + i) * 16 + c] = v; } }
    lds_sync();
    { LAS float* X = (C.wave < 4 ? Us : Ws) + (C.wave & 3) * 16; const int r = C.lane & 15, q = C.lane >> 4;
#pragma unroll
      for (int bi = 0; bi < 4; ++bi) {
          f32x4 c, c2 = Z4;
#pragma unroll
          for (int j = 0; j < 4; ++j) c[j] = X[(16 * bi + 4 * q + j) * FS + r];
          if (bi > 0) { float av[12], bv[12];
#pragma unroll
              for (int s = 0; s < 4 * bi; ++s) { av[s] = -As[(16 * bi + r) * FS + 4 * s + q]; bv[s] = X[(4 * s + q) * FS + r]; }
              __builtin_amdgcn_sched_barrier(0);
#pragma unroll
              for (int s = 0; s < 4 * bi; s += 2) { c = __builtin_amdgcn_mfma_f32_16x16x4f32(av[s], bv[s], c, 0, 0, 0); c2 = __builtin_amdgcn_mfma_f32_16x16x4f32(av[s + 1], bv[s + 1], c2, 0, 0, 0); }
              c += c2;
#pragma unroll
              for (int j = 0; j < 4; ++j) X[(16 * bi + 4 * q + j) * FS + r] = c[j]; }
          f32x4 dd = Z4, d2 = Z4; float dv[4], xv[4];
#pragma unroll
          for (int s = 0; s < 4; ++s) { dv[s] = Dv[(bi * 16 + r) * 16 + 4 * s + q]; xv[s] = X[(16 * bi + 4 * s + q) * FS + r]; }
          __builtin_amdgcn_sched_barrier(0);
          dd = __builtin_amdgcn_mfma_f32_16x16x4f32(dv[0], xv[0], dd, 0, 0, 0); d2 = __builtin_amdgcn_mfma_f32_16x16x4f32(dv[1], xv[1], d2, 0, 0, 0);
          dd = __builtin_amdgcn_mfma_f32_16x16x4f32(dv[2], xv[2], dd, 0, 0, 0); d2 = __builtin_amdgcn_mfma_f32_16x16x4f32(dv[3], xv[3], d2, 0, 0, 0);
          dd += d2;
#pragma unroll
          for (int j = 0; j < 4; ++j) X[(16 * bi + 4 * q + j) * FS + r] = dd[j];
          if (Wb && C.wave >= 4) {
#pragma unroll
              for (int j = 0; j < 4; ++j) Wb[(16 * bi + 4 * q + j) * BS + (C.wave & 3) * 16 + r] = tobf(dd[j]); }
      } }
    lds_sync();
}
DI void wave_cumsum(const LAS float* src, LAS float* dst, int lane) {
    float v = src[lane];
#pragma unroll
    for (int o = 1; o < 64; o <<= 1) { const float t = __shfl_up(v, o); if (lane >= o) v += t; }
    dst[lane] = v;
}

DI void store_T8(LAS bf16* T, int c8, int i, int j, u32x4 w) {
    unsigned a0 = w.x, a1 = w.y, a2 = w.z, a3 = w.w;
    { const bool on = (j & 1) != 0; const unsigned b0 = __builtin_amdgcn_alignbit(a1, a0, 16), b1 = __builtin_amdgcn_alignbit(a2, a1, 16), b2 = __builtin_amdgcn_alignbit(a3, a2, 16), b3 = __builtin_amdgcn_alignbit(a0, a3, 16);
      a0 = on ? b0 : a0; a1 = on ? b1 : a1; a2 = on ? b2 : a2; a3 = on ? b3 : a3; }
    { const bool on = (j & 2) != 0; const unsigned b0 = a1, b1 = a2, b2 = a3, b3 = a0; a0 = on ? b0 : a0; a1 = on ? b1 : a1; a2 = on ? b2 : a2; a3 = on ? b3 : a3; }
    { const bool on = (j & 4) != 0; const unsigned b0 = a2, b1 = a3, b2 = a0, b3 = a1; a0 = on ? b0 : a0; a1 = on ? b1 : a1; a2 = on ? b2 : a2; a3 = on ? b3 : a3; }
    LAS bf16* t = T + i;
    t[(c8 + ((0 + j) & 7)) * BS] = (bf16)(a0 & 0xffffu); t[(c8 + ((1 + j) & 7)) * BS] = (bf16)(a0 >> 16);
    t[(c8 + ((2 + j) & 7)) * BS] = (bf16)(a1 & 0xffffu); t[(c8 + ((3 + j) & 7)) * BS] = (bf16)(a1 >> 16);
    t[(c8 + ((4 + j) & 7)) * BS] = (bf16)(a2 & 0xffffu); t[(c8 + ((5 + j) & 7)) * BS] = (bf16)(a2 >> 16);
    t[(c8 + ((6 + j) & 7)) * BS] = (bf16)(a3 & 0xffffu); t[(c8 + ((7 + j) & 7)) * BS] = (bf16)(a3 >> 16);
}
struct DnLds { LAS float *As, *Us, *Ws, *Ss, *gc, *bt, *gr, *Dv; LAS bf16 *Kb, *KT, *Qb, *StT, *QKb, *Wb, *VnT, *VnsT, *oacc; LAS float *Mt, *Nt, *Mc, *Nc; LAS bf16 *WfT, *UfT; };
DI DnLds dn_lds3(LAS unsigned char* l) { DnLds L{};
    L.As = (LAS float*)l; L.Us = (LAS float*)(l + FTB); L.Ws = (LAS float*)(l + 2 * FTB); L.Ss = (LAS float*)(l + 3 * FTB);
    LAS unsigned char* b = l + 4 * FTB; L.Kb = (LAS bf16*)b; L.KT = (LAS bf16*)(b + BTB); L.Qb = (LAS bf16*)(b + 2 * BTB); L.StT = (LAS bf16*)(b + 3 * BTB); L.Wb = (LAS bf16*)(b + 4 * BTB);
    L.gc = (LAS float*)(b + 5 * BTB); L.bt = L.gc + 64; L.gr = L.bt + 64; L.Dv = (LAS float*)(b + 5 * BTB + 768);
    L.QKb = (LAS bf16*)l; L.VnT = (LAS bf16*)(l + 2 * FTB); L.VnsT = (LAS bf16*)(l + 2 * FTB + BTB); return L; }
DI DnLds dn_lds1(LAS unsigned char* l) { DnLds L{};
    L.As = (LAS float*)l; L.Us = (LAS float*)(l + FTB); L.Ws = (LAS float*)(l + 2 * FTB);
    LAS unsigned char* m = l + 3 * FTB; L.Mt = (LAS float*)m; L.Nt = (LAS float*)(m + 17408);
    LAS unsigned char* b = m + 2 * 17408; L.Kb = (LAS bf16*)b; L.KT = (LAS bf16*)(b + BTB); L.Wb = (LAS bf16*)(b + 2 * BTB); L.StT = (LAS bf16*)(b + 3 * BTB); L.Qb = (LAS bf16*)(b + 4 * BTB);
    L.gc = (LAS float*)(b + 5 * BTB); L.bt = L.gc + 64; L.gr = L.bt + 64; L.Dv = (LAS float*)(b + 5 * BTB + 768);
    L.VnT = (LAS bf16*)(l + 2 * FTB); L.VnsT = (LAS bf16*)(l + 2 * FTB + BTB); return L; }

struct DnRaw { u32x4 r[3][3]; float wa, wb, wc; float sb, sa; };
DI DnRaw dn_fetch(const Ctx& C, const bf16* pB, const float* side, int row0, int seq_len, int t0, int rev, int h, int d, bool wantq) {
    DnRaw R; const int i = C.tid >> 3, c8 = (C.tid & 7) * 8; const int t = rev ? (t0 + 63 - i) : (t0 + i);
#pragma unroll
    for (int dd = 0; dd < 3; ++dd) { const int tt = t + dd - 1; const int tc = tt < 0 ? 0 : (tt >= seq_len ? seq_len - 1 : tt); { const float wv_ = (tt == tc) ? 1.f : 0.f; if (dd == 0) R.wa = wv_; else if (dd == 1) R.wb = wv_; else R.wc = wv_; }
        const bf16* rp = pB + (size_t)(row0 + tc) * NB + h * 64 + c8;
        R.r[0][dd] = wantq ? *(const u32x4*)rp : (u32x4){0u, 0u, 0u, 0u}; R.r[1][dd] = *(const u32x4*)(rp + 256); R.r[2][dd] = *(const u32x4*)(rp + 512); }
    R.sb = 0.f; R.sa = 0.f;
    if (C.wave == 0) { const int tw = rev ? (t0 + 63 - C.lane) : (t0 + C.lane); const float* s = side + (size_t)(row0 + tw) * 24; R.sb = s[d * 4 + h]; R.sa = s[8 + d * 4 + h]; }
    return R;
}
constexpr int CW_OFF = 143360;
DI void dn_stage_cw(const Ctx& C, const float* convw, int h, const float* dnw = nullptr) { LAS float* cw = (LAS float*)(C.lds + CW_OFF);
    for (int i = C.tid; i < 576; i += NTHR) { const int dw = i >> 6, c = i & 63, dd = dw / 3, which = dw - dd * 3; cw[i] = convw[dd * 768 + which * 256 + h * 64 + c]; }
    if (dnw && C.tid < 64) cw[576 + C.tid] = dnw[C.tid]; }
DI void dn_consume(const Ctx& C, const DnLds& L, const DnRaw& R, float a_neg, float dtb, int h, bool wantq) {
    const LAS float* cw = (const LAS float*)(C.lds + CW_OFF);
    const int i = C.tid >> 3, c8 = (C.tid & 7) * 8;
#pragma unroll
    for (int which = 0; which < 3; ++which) {
        if (which == 0 && !wantq) continue;
        const int col = which * 256 + h * 64 + c8; float acc[8];
#pragma unroll
        for (int e = 0; e < 8; ++e) acc[e] = 0.f;
#pragma unroll
        for (int dd = 0; dd < 3; ++dd) { float x[8]; unpack8(R.r[which][dd], x); const LAS float* w = cw + (dd * 3 + which) * 64 + c8;
            const float wzd = dd == 0 ? R.wa : (dd == 1 ? R.wb : R.wc); const f32x4 w0 = *(const LAS f32x4*)w * wzd, w1 = *(const LAS f32x4*)(w + 4) * wzd;
            acc[0] += w0.x * x[0]; acc[1] += w0.y * x[1]; acc[2] += w0.z * x[2]; acc[3] += w0.w * x[3]; acc[4] += w1.x * x[4]; acc[5] += w1.y * x[5]; acc[6] += w1.z * x[6]; acc[7] += w1.w * x[7]; }
        float ss = 0.f;
#pragma unroll
        for (int e = 0; e < 8; ++e) { acc[e] = fsilu(acc[e]); ss += acc[e] * acc[e]; }
        if (which < 2) { ss += __shfl_xor(ss, 1); ss += __shfl_xor(ss, 2); ss += __shfl_xor(ss, 4); const float rr = __builtin_amdgcn_rsqf(ss + EPS) * (which == 0 ? 0.125f : 1.f);
#pragma unroll
            for (int e = 0; e < 8; ++e) acc[e] *= rr; }
        if (which == 0) *(LAS u32x4*)(L.Qb + i * BS + c8) = pack8(acc);
        else if (which == 1) { *(LAS u32x4*)(L.Kb + i * BS + c8) = pack8(acc);
            store_T8(L.KT, c8, i, C.tid & 7, pack8(acc));
            LAS float* dst = L.Ws + i * FS + c8; *(LAS f32x4*)dst = (f32x4){acc[0], acc[1], acc[2], acc[3]}; *(LAS f32x4*)(dst + 4) = (f32x4){acc[4], acc[5], acc[6], acc[7]}; }
        else { LAS float* dst = L.Us + i * FS + c8; *(LAS f32x4*)dst = (f32x4){acc[0], acc[1], acc[2], acc[3]}; *(LAS f32x4*)(dst + 4) = (f32x4){acc[4], acc[5], acc[6], acc[7]}; }
    }
    if (C.wave == 0) { L.bt[C.lane] = __builtin_amdgcn_rcpf(1.f + __expf(-R.sb));
        float v = a_neg * fsoftplus(R.sa + dtb);
#pragma unroll
        for (int o = 1; o < 64; o <<= 1) { const float tt = __shfl_up(v, o); if (C.lane >= o) v += tt; }
        L.gc[C.lane] = v; }
}
DI void dn_prepare(const Ctx& C, const DnLds& L, LAS bf16* Wb) {
    lds_sync();
    { const int i = C.tid >> 3, c8 = (C.tid & 7) * 8; const float b = L.bt[i], be = b * __expf(L.gc[i]);
#pragma unroll
        for (int e = 0; e < 8; ++e) { L.Us[i * FS + c8 + e] *= b; L.Ws[i * FS + c8 + e] *= be; } }
    { f32x4 c0 = Z4, c1 = Z4; mmb(c0, c1, L.Kb, L.Kb, C.wave, C.lane);
      MM_EPI(c0, c1, { L.As[row * FS + col] = col < row ? val * L.bt[row] * __expf(L.gc[row] - L.gc[col]) : 0.f; }); }
    lds_sync();
    tri_solve_blocked(C, L.As, L.Us, L.Ws, L.Dv, Wb);
}
DI void dn_phase1_item(const Ctx& C, int l, int item) {
    const DnLds L = dn_lds1(C.lds);
    const int v = item >> 3, h = (item >> 1) & 3, d = item & 1, b = v >> 4, tsc = v & 15;
    const bf16* pB = (const bf16*)(C.ws + WS_PB); const float* side = (const float*)(C.ws + WS_SIDE);
    const float* convw = C.in[16] + (size_t)l * 3 * 768; const float a_neg = -expf(C.in[17][l * 8 + d * 4 + h]), dtb = C.in[18][l * 8 + d * 4 + h];
    const int row0 = TC + b * 4096;
    LAS bf16* MtT = L.StT; LAS bf16* NtT = L.Qb;
    { const int i = C.tid >> 3, c8 = (C.tid & 7) * 8;
#pragma unroll
        for (int e = 0; e < 8; ++e) { const float mv = (i == c8 + e) ? 1.f : 0.f; L.Mt[i * LS + c8 + e] = mv; L.Nt[i * LS + c8 + e] = 0.f; MtT[(c8 + e) * BS + i] = tobf(mv); NtT[(c8 + e) * BS + i] = 0; } }
    dn_stage_cw(C, convw, h);
    DnRaw R = dn_fetch(C, pB, side, row0, 4096, tsc * 256 + 64 * (d ? 3 : 0), d, h, d, false);
    lds_sync();
#pragma unroll 1
    for (int cc = 0; cc < 4; ++cc) {
        dn_consume(C, L, R, a_neg, dtb, h, false);
        if (cc < 3) R = dn_fetch(C, pB, side, row0, 4096, tsc * 256 + 64 * (d ? 2 - cc : cc + 1), d, h, d, false);
        dn_prepare(C, L, L.Wb);
        const float glast = L.gc[63];
        { f32x4 c0 = Z4, c1 = Z4; mmb(c0, c1, L.Wb, MtT, C.wave, C.lane);
          MM_EPI(c0, c1, { L.VnT[col * BS + row] = tobf(-val * __expf(glast - L.gc[row])); }); }
        { f32x4 c0 = Z4, c1 = Z4; mmb(c0, c1, L.Wb, NtT, C.wave, C.lane);
          MM_EPI(c0, c1, { L.VnsT[col * BS + row] = tobf((L.Us[row * FS + col] - val) * __expf(glast - L.gc[row])); }); }
        lds_sync();
        const float eg = __expf(glast);
        { f32x4 c0 = Z4, c1 = Z4; mmb(c0, c1, L.KT, L.VnT, C.wave, C.lane);
          MM_EPI(c0, c1, { const float mn_ = L.Mt[row * LS + col] * eg + val; L.Mt[row * LS + col] = mn_; MtT[col * BS + row] = tobf(mn_); }); }
        { f32x4 c0 = Z4, c1 = Z4; mmb(c0, c1, L.KT, L.VnsT, C.wave, C.lane);
          MM_EPI(c0, c1, { const float nn_ = L.Nt[row * LS + col] * eg + val; L.Nt[row * LS + col] = nn_; NtT[col * BS + row] = tobf(nn_); }); }
        lds_sync();
    }
    float* mn = (float*)(C.ws + WS_MN) + (size_t)item * 8192;
    { const int i = C.tid >> 3, c8 = (C.tid & 7) * 8;
#pragma unroll
        for (int e = 0; e < 8; ++e) { mn[i * 64 + c8 + e] = L.Mt[i * LS + c8 + e]; mn[4096 + i * 64 + c8 + e] = L.Nt[i * LS + c8 + e]; } }
    __syncthreads();
}
DI void dn_scan_unit(const Ctx& C, int l, int unit) {
    LAS float* Ml = (LAS float*)C.lds; LAS float* Sl = Ml + 64 * LS;
    const int chain = unit >> 2, e0 = (unit & 3) * 16, b = chain >> 3, h = (chain >> 1) & 3, d = chain & 1;
    const float* s0 = C.in[3] + ((size_t)((b * 2 + l) * 2 + d) * 4 + h) * 4096;
    const int a = C.tid >> 3, e2 = (C.tid & 7) * 2, c8 = (C.tid & 7) * 8;
    float* base = (float*)(C.ws + WS_MN);
    Sl[a * 16 + e2] = s0[a * 64 + e0 + e2]; Sl[a * 16 + e2 + 1] = s0[a * 64 + e0 + e2 + 1];
    f32x4 m0, m1; float n0, n1;
    { const int tsc = d ? 15 : 0; const float* mg = base + (size_t)(((b * 16 + tsc) * 8) + h * 2 + d) * 8192;
      m0 = *(const f32x4*)(mg + a * 64 + c8); m1 = *(const f32x4*)(mg + a * 64 + c8 + 4); n0 = mg[4096 + a * 64 + e0 + e2]; n1 = mg[4096 + a * 64 + e0 + e2 + 1]; }
#pragma unroll 1
    for (int k = 0; k < 16; ++k) {
        const int tsc = d ? 15 - k : k; float* ng = base + (size_t)(((b * 16 + tsc) * 8) + h * 2 + d) * 8192 + 4096;
        *(LAS f32x4*)(Ml + a * LS + c8) = m0; *(LAS f32x4*)(Ml + a * LS + c8 + 4) = m1;
        float acc0 = n0, acc1 = n1;
        lds_sync();
        if (k < 15) { const int t2 = d ? 14 - k : k + 1; const float* mg = base + (size_t)(((b * 16 + t2) * 8) + h * 2 + d) * 8192;
            m0 = *(const f32x4*)(mg + a * 64 + c8); m1 = *(const f32x4*)(mg + a * 64 + c8 + 4); n0 = mg[4096 + a * 64 + e0 + e2]; n1 = mg[4096 + a * 64 + e0 + e2 + 1]; }
#pragma unroll 8
        for (int bb = 0; bb < 64; ++bb) { const float m = Ml[a * LS + bb]; acc0 += m * Sl[bb * 16 + e2]; acc1 += m * Sl[bb * 16 + e2 + 1]; }
        ng[a * 64 + e0 + e2] = Sl[a * 16 + e2]; ng[a * 64 + e0 + e2 + 1] = Sl[a * 16 + e2 + 1];
        lds_sync();
        Sl[a * 16 + e2] = acc0; Sl[a * 16 + e2 + 1] = acc1;
        lds_sync();
    }
    __syncthreads();
}
DI void dn_phase3_item(const Ctx& C, int l, int item) {
    const DnLds L = dn_lds3(C.lds);
    const int u = item >> 2, h = item & 3; const bool lat = u >= 32;
    const int v = u - 32, b = lat ? (v >> 4) : u, tsc = lat ? (v & 15) : 0;
    const int row0 = lat ? TC + b * 4096 : u * 256, seq_len = lat ? 4096 : 256, tbase = tsc * 256;
    const bf16* pB = (const bf16*)(C.ws + WS_PB); const float* side = (const float*)(C.ws + WS_SIDE); bf16* mix = (bf16*)(C.ws + WS_MIX); bf16* of = (bf16*)(C.ws + WS_XN);
    const float* convw = C.in[16] + (size_t)l * 3 * 768; const float* dnw = C.in[19] + l * 64;
    dn_stage_cw(C, convw, h, dnw);
    lds_sync();
#pragma unroll 1
    for (int d = 0; d < 2; ++d) {
        const float a_neg = -expf(C.in[17][l * 8 + d * 4 + h]), dtb = C.in[18][l * 8 + d * 4 + h];
        DnRaw R = dn_fetch(C, pB, side, row0, seq_len, tbase + 64 * (d ? 3 : 0), d, h, d, true);
        { const int i = C.tid >> 3, c8 = (C.tid & 7) * 8; const float* sin_ = lat ? (const float*)(C.ws + WS_MN) + (size_t)((v * 8) + h * 2 + d) * 8192 + 4096 : nullptr;
#pragma unroll
            for (int e = 0; e < 8; ++e) { const float sv = lat ? sin_[i * 64 + c8 + e] : 0.f; L.Ss[i * FS + c8 + e] = sv; L.StT[(c8 + e) * BS + i] = tobf(sv); } }
#pragma unroll 1
        for (int cc = 0; cc < 4; ++cc) {
            const int cloc = d ? 3 - cc : cc, t0 = tbase + 64 * cloc;
            u32x4 zr = {0u, 0u, 0u, 0u}, fv = {0u, 0u, 0u, 0u};
            if (d == 1) { const int i = C.tid >> 3, c8 = (C.tid & 7) * 8; const size_t grow = (size_t)row0 + t0 + 63 - i; zr = *(const u32x4*)(pB + grow * NB + 768 + h * 64 + c8);
                const unsigned* fp = (const unsigned*)(of + grow * 256 + h * 64 + c8);
                fv.x = __hip_atomic_load(fp, __ATOMIC_RELAXED, __HIP_MEMORY_SCOPE_AGENT); fv.y = __hip_atomic_load(fp + 1, __ATOMIC_RELAXED, __HIP_MEMORY_SCOPE_AGENT);
                fv.z = __hip_atomic_load(fp + 2, __ATOMIC_RELAXED, __HIP_MEMORY_SCOPE_AGENT); fv.w = __hip_atomic_load(fp + 3, __ATOMIC_RELAXED, __HIP_MEMORY_SCOPE_AGENT); }
            dn_consume(C, L, R, a_neg, dtb, h, true);
            if (cc < 3) R = dn_fetch(C, pB, side, row0, seq_len, tbase + 64 * (d ? 2 - cc : cc + 1), d, h, d, true);
            dn_prepare(C, L, L.Wb);
            const float glast = L.gc[63];
            f32x4 o0 = Z4, o1 = Z4;
            { f32x4 c0 = Z4, c1 = Z4; mmb(c0, c1, L.Wb, L.StT, C.wave, C.lane);
              MM_EPI(c0, c1, { const float vn = L.Us[row * FS + col] - val; L.VnT[col * BS + row] = tobf(vn); L.VnsT[col * BS + row] = tobf(vn * __expf(glast - L.gc[row])); }); }
            { f32x4 c0 = Z4, c1 = Z4; mmb(c0, c1, L.Qb, L.Kb, C.wave, C.lane);
              MM_EPI(c0, c1, { L.QKb[row * BS + col] = tobf(col <= row ? val * __expf(L.gc[row] - L.gc[col]) : 0.f); }); }
            { mmb(o0, o1, L.Qb, L.StT, C.wave, C.lane); const int q_ = C.lane >> 4, tr_ = C.wave >> 1;
#pragma unroll
              for (int j = 0; j < 4; ++j) { const float f = __expf(L.gc[tr_ * 16 + q_ * 4 + j]); o0[j] *= f; o1[j] *= f; } }
            lds_sync();
            { mmb(o0, o1, L.QKb, L.VnT, C.wave, C.lane);
              MM_EPI(o0, o1, { L.Us[row * FS + col] = val; }); }
            { f32x4 c0 = Z4, c1 = Z4; mmb(c0, c1, L.KT, L.VnsT, C.wave, C.lane); const float eg = __expf(glast);
              MM_EPI(c0, c1, { const float sn = L.Ss[row * FS + col] * eg + val; L.Ss[row * FS + col] = sn; L.StT[col * BS + row] = tobf(sn); }); }
            lds_sync();
            { const int i = C.tid >> 3, c8 = (C.tid & 7) * 8; float o[8];
#pragma unroll
              for (int e = 0; e < 8; ++e) o[e] = L.Us[i * FS + c8 + e];
              if (d == 0) { const size_t grow = (size_t)row0 + t0 + i; *(u32x4*)(of + grow * 256 + h * 64 + c8) = pack8(o); }
              else { const size_t grow = (size_t)row0 + t0 + 63 - i;
                  float f8[8]; unpack8(fv, f8); float ss = 0.f;
#pragma unroll
                  for (int e = 0; e < 8; ++e) { o[e] += f8[e]; ss += o[e] * o[e]; }
                  ss += __shfl_xor(ss, 1); ss += __shfl_xor(ss, 2); ss += __shfl_xor(ss, 4);
                  const float rstd = rsqrtf(ss * (1.f / 64) + EPS);
                  float z[8]; unpack8(zr, z);
#pragma unroll
                  for (int e = 0; e < 8; ++e) o[e] = o[e] * rstd * ((const LAS float*)(C.lds + CW_OFF))[576 + c8 + e] * fsilu(z[e]);
                  *(u32x4*)(mix + grow * D + h * 64 + c8) = pack8(o); } }
        }
        if (!lat) { float* o = C.out + O_SDN + ((size_t)((u * 2 + l) * 2 + d) * 4 + h) * 4096; const int i = C.tid >> 3, c8 = (C.tid & 7) * 8;
#pragma unroll
            for (int e = 0; e < 8; ++e) o[i * 64 + c8 + e] = L.Ss[i * FS + c8 + e]; }
        __syncthreads();
    }
}
struct SsLds { LAS float *Xs, *Hs, *ac, *dts, *gr; LAS bf16 *Cb, *Bb, *BT, *XT, *XfT, *Hb, *Scb, *Hb2; };
DI SsLds ss_lds(LAS unsigned char* l) { SsLds L; L.Xs = (LAS float*)l; L.Hs = (LAS float*)(l + FTB); LAS unsigned char* b = l + 2 * FTB;
    L.Cb = (LAS bf16*)b; L.Bb = (LAS bf16*)(b + BTB); L.BT = (LAS bf16*)(b + 2 * BTB); L.XT = (LAS bf16*)(b + 3 * BTB); L.XfT = (LAS bf16*)(b + 4 * BTB); L.Hb = (LAS bf16*)(b + 5 * BTB); L.Scb = (LAS bf16*)(b + 6 * BTB);
    L.Hb2 = (LAS bf16*)(b + 7 * BTB); L.ac = (LAS float*)(b + 8 * BTB); L.dts = L.ac + 64; L.gr = L.dts + 64; return L; }
struct SsRaw { u32x4 r[3][3]; float wa, wb, wc; float sd; };
DI SsRaw ss_fetch(const Ctx& C, const bf16* pB, const float* side, int row0, int seq_len, int t0, int rev, int h, int d, bool wantc) {
    SsRaw R; const int i = C.tid >> 3, c8 = (C.tid & 7) * 8; const int t = rev ? (t0 + 63 - i) : (t0 + i); const int g = h >> 1;
#pragma unroll
    for (int dd = 0; dd < 3; ++dd) { const int tt = t + dd - 1; const int tc = tt < 0 ? 0 : (tt >= seq_len ? seq_len - 1 : tt); { const float wv_ = (tt == tc) ? 1.f : 0.f; if (dd == 0) R.wa = wv_; else if (dd == 1) R.wb = wv_; else R.wc = wv_; }
        const bf16* rp = pB + (size_t)(row0 + tc) * NB + 1296 + c8;
        R.r[0][dd] = *(const u32x4*)(rp + h * 64); R.r[1][dd] = *(const u32x4*)(rp + 256 + g * 64); R.r[2][dd] = wantc ? *(const u32x4*)(rp + 384 + g * 64) : (u32x4){0u, 0u, 0u, 0u}; }
    R.sd = 0.f;
    if (C.wave == 0) { const int tw = rev ? (t0 + 63 - C.lane) : (t0 + C.lane); R.sd = side[(size_t)(row0 + tw) * 24 + 16 + d * 4 + h]; }
    return R;
}
DI void ss_stage_cw(const Ctx& C, const float* convw, const float* convb, int h) { LAS float* cw = (LAS float*)(C.lds + CW_OFF); const int g = h >> 1;
    for (int i = C.tid; i < 768; i += NTHR) { const int j = i < 576 ? i : i - 576, dw = j >> 6, c = j & 63, dd = dw / 3, which = i < 576 ? dw - dd * 3 : dw;
        const int ch = (which == 0 ? h * 64 : which == 1 ? 256 + g * 64 : 384 + g * 64) + c; cw[i] = i < 576 ? convw[dd * 512 + ch] : convb[ch]; } }
DI void ss_consume(const Ctx& C, const SsLds& L, const SsRaw& R, float a_neg, float dtb, int h, bool wantc) {
    const LAS float* cw = (const LAS float*)(C.lds + CW_OFF);
    const int i = C.tid >> 3, c8 = (C.tid & 7) * 8; const int g = h >> 1;
#pragma unroll
    for (int which = 0; which < 3; ++which) {
        if (which == 2 && !wantc) continue;
        const int ch = (which == 0 ? h * 64 : which == 1 ? 256 + g * 64 : 384 + g * 64) + c8; float acc[8];
        { const f32x4 b0 = *(const LAS f32x4*)(cw + 576 + which * 64 + c8), b1 = *(const LAS f32x4*)(cw + 576 + which * 64 + c8 + 4); acc[0] = b0.x; acc[1] = b0.y; acc[2] = b0.z; acc[3] = b0.w; acc[4] = b1.x; acc[5] = b1.y; acc[6] = b1.z; acc[7] = b1.w; }
#pragma unroll
        for (int dd = 0; dd < 3; ++dd) { float x[8]; unpack8(R.r[which][dd], x); const LAS float* w = cw + (dd * 3 + which) * 64 + c8;
            const float wzd = dd == 0 ? R.wa : (dd == 1 ? R.wb : R.wc); const f32x4 w0 = *(const LAS f32x4*)w * wzd, w1 = *(const LAS f32x4*)(w + 4) * wzd;
            acc[0] += w0.x * x[0]; acc[1] += w0.y * x[1]; acc[2] += w0.z * x[2]; acc[3] += w0.w * x[3]; acc[4] += w1.x * x[4]; acc[5] += w1.y * x[5]; acc[6] += w1.z * x[6]; acc[7] += w1.w * x[7]; }
#pragma unroll
        for (int e = 0; e < 8; ++e) acc[e] = fsilu(acc[e]);
        if (which == 0) { LAS float* dst = L.Xs + i * FS + c8; *(LAS f32x4*)dst = (f32x4){acc[0], acc[1], acc[2], acc[3]}; *(LAS f32x4*)(dst + 4) = (f32x4){acc[4], acc[5], acc[6], acc[7]};
            store_T8(L.XT, c8, i, C.tid & 7, pack8(acc)); }
        else if (which == 1) { *(LAS u32x4*)(L.Bb + i * BS + c8) = pack8(acc);
            store_T8(L.BT, c8, i, C.tid & 7, pack8(acc)); }
        else *(LAS u32x4*)(L.Cb + i * BS + c8) = pack8(acc);
    }
    if (C.wave == 0) { const float dtv = fsoftplus(R.sd + dtb); L.dts[C.lane] = dtv;
        float v = a_neg * dtv;
#pragma unroll
        for (int o = 1; o < 64; o <<= 1) { const float tt = __shfl_up(v, o); if (C.lane >= o) v += tt; }
        L.ac[C.lane] = v; }
}
DI void ss_make_xf(const Ctx& C, const SsLds& L) {
    const int i = C.tid >> 3, c8 = (C.tid & 7) * 8; const float f = L.dts[i] * __expf(L.ac[63] - L.ac[i]);
    float xf[8];
#pragma unroll
    for (int e = 0; e < 8; ++e) xf[e] = L.Xs[i * FS + c8 + e] * f;
    store_T8(L.XfT, c8, i, C.tid & 7, pack8(xf));
}
DI void ss_phase1_item(const Ctx& C, int l, int item) {
    const SsLds L = ss_lds(C.lds);
    const int v = item >> 3, h = (item >> 1) & 3, d = item & 1, b = v >> 4, tsc = v & 15;
    const bf16* pB = (const bf16*)(C.ws + WS_PB); const float* side = (const float*)(C.ws + WS_SIDE);
    const float* convw = C.in[24] + (size_t)l * 3 * 512; const float* convb = C.in[25] + l * 512;
    const float a_neg = -expf(C.in[26][l * 8 + d * 4 + h]), dtb = C.in[27][l * 8 + d * 4 + h];
    const int row0 = TC + b * 4096;
    { const int i = C.tid >> 3, c8 = (C.tid & 7) * 8;
#pragma unroll
        for (int e = 0; e < 8; ++e) L.Hs[i * FS + c8 + e] = 0.f; }
    float dec = 0.f;
    ss_stage_cw(C, convw, convb, h);
    SsRaw R = ss_fetch(C, pB, side, row0, 4096, tsc * 256 + 64 * (d ? 3 : 0), d, h, d, false);
    lds_sync();
#pragma unroll 1
    for (int cc = 0; cc < 4; ++cc) {
        ss_consume(C, L, R, a_neg, dtb, h, false);
        if (cc < 3) R = ss_fetch(C, pB, side, row0, 4096, tsc * 256 + 64 * (d ? 2 - cc : cc + 1), d, h, d, false);
        lds_sync();
        const float alast = L.ac[63]; dec += alast;
        ss_make_xf(C, L);
        lds_sync();
        { f32x4 c0 = Z4, c1 = Z4; mmb(c0, c1, L.XfT, L.BT, C.wave, C.lane); const float eg = __expf(alast);
          MM_EPI(c0, c1, { L.Hs[row * FS + col] = L.Hs[row * FS + col] * eg + val; }); }
        lds_sync();
    }
    float* cs = (float*)(C.ws + WS_CS) + (size_t)item * 4096;
    { const int i = C.tid >> 3, c8 = (C.tid & 7) * 8;
#pragma unroll
        for (int e = 0; e < 8; ++e) cs[i * 64 + c8 + e] = L.Hs[i * FS + c8 + e]; }
    if (C.tid == 0) ((float*)(C.ws + WS_CD))[item] = expf(dec);
    __syncthreads();
}
DI void ss_scan(const Ctx& C, int l) {
    const int gid = C.bid * NTHR + C.tid; if (gid >= 32 * 4096) return;
    const int chain = gid >> 12, e = gid & 4095, b = chain >> 3, h = (chain >> 1) & 3, d = chain & 1;
    float st = C.in[6][((size_t)((b * 2 + l) * 2 + d) * 4 + h) * 4096 + e];
    float* cs = (float*)(C.ws + WS_CS); const float* cd = (const float*)(C.ws + WS_CD);
    for (int k = 0; k < 16; ++k) { const int tsc = d ? 15 - k : k; const size_t slot = (size_t)((b * 16 + tsc) * 8) + h * 2 + d;
        const float c = cs[slot * 4096 + e]; cs[slot * 4096 + e] = st; st = st * cd[slot] + c; }
}
DI void ss_phase3_item(const Ctx& C, int l, int item) {
    const SsLds L = ss_lds(C.lds);
    const int u = item >> 2, h = item & 3; const bool lat = u >= 32;
    const int v = u - 32, b = lat ? (v >> 4) : u, tsc = lat ? (v & 15) : 0;
    const int row0 = lat ? TC + b * 4096 : u * 256, seq_len = lat ? 4096 : 256, tbase = tsc * 256;
    const bf16* pB = (const bf16*)(C.ws + WS_PB); const float* side = (const float*)(C.ws + WS_SIDE); bf16* mix = (bf16*)(C.ws + WS_MIX); float* ssq = (float*)(C.ws + WS_SSQ); bf16* yf = (bf16*)(C.ws + WS_XN) + (size_t)T * 256;
    const float* convw = C.in[24] + (size_t)l * 3 * 512; const float* convb = C.in[25] + l * 512; const float Dh = C.in[28][l * 4 + h];
    ss_stage_cw(C, convw, convb, h);
    lds_sync();
#pragma unroll 1
    for (int d = 0; d < 2; ++d) {
        const float a_neg = -expf(C.in[26][l * 8 + d * 4 + h]), dtb = C.in[27][l * 8 + d * 4 + h];
        SsRaw R = ss_fetch(C, pB, side, row0, seq_len, tbase + 64 * (d ? 3 : 0), d, h, d, true);
        { const int i = C.tid >> 3, c8 = (C.tid & 7) * 8; const float* sin_ = lat ? (const float*)(C.ws + WS_CS) + (size_t)((v * 8) + h * 2 + d) * 4096 : nullptr;
#pragma unroll
            for (int e = 0; e < 8; ++e) { const float sv = lat ? sin_[i * 64 + c8 + e] : 0.f; L.Hs[i * FS + c8 + e] = sv; L.Hb[i * BS + c8 + e] = tobf(sv); } }
#pragma unroll 1
        for (int cc = 0; cc < 4; ++cc) {
            LAS bf16* hb_cur = (cc & 1) ? L.Hb2 : L.Hb; LAS bf16* hb_nxt = (cc & 1) ? L.Hb : L.Hb2;
            const int cloc = d ? 3 - cc : cc, t0 = tbase + 64 * cloc;
            u32x4 zr = {0u, 0u, 0u, 0u}, fv = {0u, 0u, 0u, 0u};
            if (d == 1) { const int i = C.tid >> 3, c8 = (C.tid & 7) * 8; const size_t grow = (size_t)row0 + t0 + 63 - i; zr = *(const u32x4*)(pB + grow * NB + 1040 + h * 64 + c8);
                const unsigned* fp = (const unsigned*)(yf + grow * 256 + h * 64 + c8);
                fv.x = __hip_atomic_load(fp, __ATOMIC_RELAXED, __HIP_MEMORY_SCOPE_AGENT); fv.y = __hip_atomic_load(fp + 1, __ATOMIC_RELAXED, __HIP_MEMORY_SCOPE_AGENT);
                fv.z = __hip_atomic_load(fp + 2, __ATOMIC_RELAXED, __HIP_MEMORY_SCOPE_AGENT); fv.w = __hip_atomic_load(fp + 3, __ATOMIC_RELAXED, __HIP_MEMORY_SCOPE_AGENT); }
            ss_consume(C, L, R, a_neg, dtb, h, true);
            if (cc < 3) R = ss_fetch(C, pB, side, row0, seq_len, tbase + 64 * (d ? 2 - cc : cc + 1), d, h, d, true);
            lds_sync();
            const float alast = L.ac[63];
            ss_make_xf(C, L);
            { f32x4 c0 = Z4, c1 = Z4; mmb(c0, c1, L.Cb, L.Bb, C.wave, C.lane);
              MM_EPI(c0, c1, { L.Scb[row * BS + col] = tobf(col <= row ? val * __expf(L.ac[row] - L.ac[col]) * L.dts[col] : 0.f); }); }
            lds_sync();
            { f32x4 c0 = Z4, c1 = Z4; mmb(c0, c1, L.Cb, hb_cur, C.wave, C.lane);
              { const int q_ = C.lane >> 4, tr_ = C.wave >> 1;
#pragma unroll
                for (int j = 0; j < 4; ++j) { const float f = __expf(L.ac[tr_ * 16 + q_ * 4 + j]); c0[j] *= f; c1[j] *= f; } }
              mmb(c0, c1, L.Scb, L.XT, C.wave, C.lane);
              MM_EPI(c0, c1, { L.Xs[row * FS + col] = d == 0 ? val + Dh * L.Xs[row * FS + col] : val; }); }
            { f32x4 c0 = Z4, c1 = Z4; mmb(c0, c1, L.XfT, L.BT, C.wave, C.lane); const float eg = __expf(alast);
              MM_EPI(c0, c1, { const float hn = L.Hs[row * FS + col] * eg + val; L.Hs[row * FS + col] = hn; hb_nxt[row * BS + col] = tobf(hn); }); }
            lds_sync();
            { const int i = C.tid >> 3, c8 = (C.tid & 7) * 8; float o[8];
#pragma unroll
              for (int e = 0; e < 8; ++e) o[e] = L.Xs[i * FS + c8 + e];
              if (d == 0) { const size_t grow = (size_t)row0 + t0 + i; *(u32x4*)(yf + grow * 256 + h * 64 + c8) = pack8(o); }
              else { const size_t grow = (size_t)row0 + t0 + 63 - i;
                  float f8[8], z[8]; unpack8(fv, f8); unpack8(zr, z); float ss = 0.f;
#pragma unroll
                  for (int e = 0; e < 8; ++e) { o[e] = (o[e] + f8[e]) * fsilu(z[e]); ss += o[e] * o[e]; }
                  ss += __shfl_xor(ss, 1); ss += __shfl_xor(ss, 2); ss += __shfl_xor(ss, 4);
                  *(u32x4*)(mix + grow * D + 512 + h * 64 + c8) = pack8(o);
                  if ((C.tid & 7) == 0) ssq[grow * 4 + h] = ss; } }
        }
        if (!lat) { float* o = C.out + O_SSM + ((size_t)((u * 2 + l) * 2 + d) * 4 + h) * 4096; const int i = C.tid >> 3, c8 = (C.tid & 7) * 8;
#pragma unroll
            for (int e = 0; e < 8; ++e) o[i * 64 + c8 + e] = L.Hs[i * FS + c8 + e]; }
        __syncthreads();
    }
}
DI void ssd_fix_rows(const Ctx& C, int l, int r0, int nrows, int g_lo, int g_n) {
    bf16* mix = (bf16*)(C.ws + WS_MIX); const unsigned* ssq = (const unsigned*)(C.ws + WS_SSQ); const float* nw = C.in[29] + l * 256;
    const int per_row = g_n * 16;
    for (int i = C.tid; i < nrows * per_row; i += NTHR) { const int row = r0 + i / per_row, cc = i % per_row, g = g_lo + (cc >> 4), c8 = (g * 16 + (cc & 15)) * 8;
        const float s0 = __builtin_bit_cast(float, __hip_atomic_load(ssq + (size_t)row * 4 + 2 * g, __ATOMIC_RELAXED, __HIP_MEMORY_SCOPE_AGENT));
        const float s1 = __builtin_bit_cast(float, __hip_atomic_load(ssq + (size_t)row * 4 + 2 * g + 1, __ATOMIC_RELAXED, __HIP_MEMORY_SCOPE_AGENT));
        const float rstd = rsqrtf((s0 + s1) * (1.f / 128) + EPS);
        unsigned* p = (unsigned*)(mix + (size_t)row * D + 512 + c8); u32x4 v;
        v.x = __hip_atomic_load(p, __ATOMIC_RELAXED, __HIP_MEMORY_SCOPE_AGENT); v.y = __hip_atomic_load(p + 1, __ATOMIC_RELAXED, __HIP_MEMORY_SCOPE_AGENT);
        v.z = __hip_atomic_load(p + 2, __ATOMIC_RELAXED, __HIP_MEMORY_SCOPE_AGENT); v.w = __hip_atomic_load(p + 3, __ATOMIC_RELAXED, __HIP_MEMORY_SCOPE_AGENT);
        float x[8]; unpack8(v, x);
#pragma unroll
        for (int e = 0; e < 8; ++e) x[e] *= rstd * nw[c8 + e];
        *(u32x4*)p = pack8(x); }
}
DI void phase_ssd_fix(const Ctx& C, int l) {
    bf16* mix = (bf16*)(C.ws + WS_MIX); const float* ssq = (const float*)(C.ws + WS_SSQ); const float* nw = C.in[29] + l * 256;
    const int gt = C.bid * NTHR + C.tid, NGT = C.G * NTHR;
    for (int i = gt; i < T * 32; i += NGT) { const int row = i >> 5, c8 = (i & 31) * 8, g = c8 >> 7;
        const float rstd = rsqrtf((ssq[(size_t)row * 4 + 2 * g] + ssq[(size_t)row * 4 + 2 * g + 1]) * (1.f / 128) + EPS);
        bf16* p = mix + (size_t)row * D + 512 + c8; float x[8]; ld8(p, x);
#pragma unroll
        for (int e = 0; e < 8; ++e) x[e] *= rstd * nw[c8 + e];
        *(u32x4*)p = pack8(x); }
}
struct KVSeg { const bf16* k; int ldk; const bf16* kr; int ldkr; const bf16* v; int ldv; int nkeys; int rope; int pos0; int win; };
constexpr int VSB = 136;
struct Stage { u32x4 k0, k1, v; };
template <int MODE> DI Stage kv_gload(const bf16* sk, int ldk, const bf16* skr, int ldkr, const bf16* sv, int ldv, int k0, int tid) {
    Stage st; const int key = tid >> 3, c = tid & 7;
    st.v = *(const u32x4*)(sv + (size_t)(k0 + key) * ldv + c * 8);
    st.k0 = *(const u32x4*)(sk + (size_t)(k0 + key) * ldk + c * 8);
    if (MODE == 0) { const int kk = (tid & 255) >> 2, j = tid & 3; st.k1 = *(const u32x4*)(skr + (size_t)(k0 + kk) * ldkr + j * 8); } else st.k1 = st.k0;
    return st;
}
template <int MODE> DI void kv_lstore(const Stage st, LAS unsigned char* Kl, LAS unsigned char* Vl, int KSB, int tid) {
    const int key = tid >> 3, c = tid & 7;
    { LAS bf16* vt = (LAS bf16*)Vl;
      vt[(c * 8 + 0) * (VSB / 2) + key] = (bf16)(st.v.x & 0xffffu); vt[(c * 8 + 1) * (VSB / 2) + key] = (bf16)(st.v.x >> 16);
      vt[(c * 8 + 2) * (VSB / 2) + key] = (bf16)(st.v.y & 0xffffu); vt[(c * 8 + 3) * (VSB / 2) + key] = (bf16)(st.v.y >> 16);
      vt[(c * 8 + 4) * (VSB / 2) + key] = (bf16)(st.v.z & 0xffffu); vt[(c * 8 + 5) * (VSB / 2) + key] = (bf16)(st.v.z >> 16);
      vt[(c * 8 + 6) * (VSB / 2) + key] = (bf16)(st.v.w & 0xffffu); vt[(c * 8 + 7) * (VSB / 2) + key] = (bf16)(st.v.w >> 16); }
    *(LAS u32x4*)(Kl + key * KSB + c * 16) = st.k0;
    if (MODE == 0) { if (tid < 256) { const int kk = tid >> 2, j = tid & 3; *(LAS u32x4*)(Kl + kk * KSB + 128 + j * 16) = st.k1; } }
}
template <int MODE>
DI void attn_unit(const Ctx& C, const bf16* qb0, const bf16* qb1, int ldq, int ro0, int ro1, int qrope, int qpos0, float qscale,
                  const KVSeg s0, const KVSeg s1, int nseg, float sink0, float sink1, bf16* ob0, bf16* ob1, int ldo, const float* cosT, const float* sinT) {
    constexpr int DQK = MODE == 0 ? 96 : 64, NKS = DQK / 32, KSB = (DQK + 8) * 2;
    constexpr int TILEB = 64 * KSB + 64 * VSB;
    LAS unsigned char* Kl0 = C.lds; LAS unsigned char* Vl0 = C.lds + 64 * KSB;
    const int lane = C.lane, r = lane & 15, quad = lane >> 4, tid = C.tid;
    bf16x8 qf[2][NKS]; int qpos[2];
#pragma unroll
    for (int sq = 0; sq < 2; ++sq) { const int row = (sq ? ro1 : ro0) + r; qpos[sq] = qpos0 + row; const bf16* qp = (sq ? qb1 : qb0) + (size_t)row * ldq;
#pragma unroll
        for (int ks = 0; ks < NKS; ++ks) { float x[8];
            if (MODE == 0) { if (ks < 2 || !qrope) ld8(qp + ks * 32 + quad * 8, x);
                else { float x1[8], x2[8]; ld8(qp + 64 + (quad & 1) * 8, x1); ld8(qp + 80 + (quad & 1) * 8, x2); const float* cs = cosT + qpos[sq] * 16 + (quad & 1) * 8; const float* sn = sinT + qpos[sq] * 16 + (quad & 1) * 8;
#pragma unroll
                    for (int e = 0; e < 8; ++e) x[e] = quad < 2 ? x1[e] * cs[e] - x2[e] * sn[e] : x1[e] * sn[e] + x2[e] * cs[e]; } }
            else { if (!qrope) ld8(qp + ks * 32 + quad * 8, x);
                else { float x1[8], x2[8]; ld8(qp + quad * 8, x1); ld8(qp + 32 + quad * 8, x2); const float* cs = cosT + qpos[sq] * 32 + quad * 8; const float* sn = sinT + qpos[sq] * 32 + quad * 8;
#pragma unroll
                    for (int e = 0; e < 8; ++e) x[e] = ks == 0 ? x1[e] * cs[e] - x2[e] * sn[e] : x1[e] * sn[e] + x2[e] * cs[e]; } }
#pragma unroll
            for (int e = 0; e < 8; ++e) x[e] *= qscale;
            qf[sq][ks] = __builtin_bit_cast(bf16x8, pack8(x)); } }
    f32x4 oacc[2][4]; float mrun[2], lrun[2];
#pragma unroll
    for (int sq = 0; sq < 2; ++sq) { mrun[sq] = -1e30f; lrun[sq] = 0.f;
#pragma unroll
        for (int dt = 0; dt < 4; ++dt) oacc[sq][dt] = Z4; }
    const int nt0 = s0.nkeys >> 6, ntt = nt0 + (nseg > 1 ? (s1.nkeys >> 6) : 0);
#define SEGSEL(ti_) const bool second_ = (ti_) >= nt0; const int k0_ = (second_ ? (ti_) - nt0 : (ti_)) * 64; \
        const bf16* sk_ = second_ ? s1.k : s0.k; const int ldk_ = second_ ? s1.ldk : s0.ldk; const bf16* skr_ = second_ ? s1.kr : s0.kr; const int ldkr_ = second_ ? s1.ldkr : s0.ldkr; \
        const bf16* sv_ = second_ ? s1.v : s0.v; const int ldv_ = second_ ? s1.ldv : s0.ldv; const int rope_ = second_ ? s1.rope : s0.rope; const int pos0_ = second_ ? s1.pos0 : s0.pos0; const int swin = second_ ? s1.win : s0.win;
    Stage stA, stB;
    { const int tn = 0; const bool sec2 = tn >= nt0; const int k02 = (sec2 ? tn - nt0 : tn) * 64; stA = kv_gload<MODE>(sec2 ? s1.k : s0.k, sec2 ? s1.ldk : s0.ldk, sec2 ? s1.kr : s0.kr, sec2 ? s1.ldkr : s0.ldkr, sec2 ? s1.v : s0.v, sec2 ? s1.ldv : s0.ldv, k02, tid); stB = stA; }
    kv_lstore<MODE>(stA, Kl0, Vl0, KSB, tid);
    { const int tn = 1; if (tn < ntt) { const bool sec2 = tn >= nt0; const int k02 = (sec2 ? tn - nt0 : tn) * 64; stA = kv_gload<MODE>(sec2 ? s1.k : s0.k, sec2 ? s1.ldk : s0.ldk, sec2 ? s1.kr : s0.kr, sec2 ? s1.ldkr : s0.ldkr, sec2 ? s1.v : s0.v, sec2 ? s1.ldv : s0.ldv, k02, tid); } }
    { const int tn = 2; if (tn < ntt) { const bool sec2 = tn >= nt0; const int k02 = (sec2 ? tn - nt0 : tn) * 64; stB = kv_gload<MODE>(sec2 ? s1.k : s0.k, sec2 ? s1.ldk : s0.ldk, sec2 ? s1.kr : s0.kr, sec2 ? s1.ldkr : s0.ldkr, sec2 ? s1.v : s0.v, sec2 ? s1.ldv : s0.ldv, k02, tid); } }
    lds_sync();
    for (int ti0 = 0; ti0 < ntt; ti0 += 2) {
        { const int ti = ti0;
        { if (ti + 1 < ntt) kv_lstore<MODE>(stA, Kl0 + ((ti + 1) & 1) * TILEB, Vl0 + ((ti + 1) & 1) * TILEB, KSB, tid);
        { const int tn = ti + 3; if (tn < ntt) { const bool sec2 = tn >= nt0; const int k02 = (sec2 ? tn - nt0 : tn) * 64; stA = kv_gload<MODE>(sec2 ? s1.k : s0.k, sec2 ? s1.ldk : s0.ldk, sec2 ? s1.kr : s0.kr, sec2 ? s1.ldkr : s0.ldkr, sec2 ? s1.v : s0.v, sec2 ? s1.ldv : s0.ldv, k02, tid); } }
        LAS unsigned char* Kl = Kl0 + (ti & 1) * TILEB; LAS unsigned char* Vl = Vl0 + (ti & 1) * TILEB;
        SEGSEL(ti)
        (void)sk_; (void)ldk_; (void)skr_; (void)ldkr_; (void)sv_; (void)ldv_; (void)rope_;
        const int kpos0 = pos0_ + k0_;
        f32x4 sacc[2][4];
#pragma unroll
        for (int sq = 0; sq < 2; ++sq)
#pragma unroll
            for (int nt = 0; nt < 4; ++nt) sacc[sq][nt] = Z4;
#pragma unroll
        for (int ks = 0; ks < NKS; ++ks)
#pragma unroll
            for (int nt = 0; nt < 4; ++nt) { const bf16x8 kf = *(const LAS bf16x8*)(Kl + (nt * 16 + r) * KSB + (ks * 32 + quad * 8) * 2);
                sacc[0][nt] = __builtin_amdgcn_mfma_f32_16x16x32_bf16(kf, qf[0][ks], sacc[0][nt], 0, 0, 0);
                sacc[1][nt] = __builtin_amdgcn_mfma_f32_16x16x32_bf16(kf, qf[1][ks], sacc[1][nt], 0, 0, 0); }
        bf16x8 pb[2][2];
#pragma unroll
        for (int sq = 0; sq < 2; ++sq) {
            float mx = -1e30f;
#pragma unroll
            for (int nt = 0; nt < 4; ++nt)
#pragma unroll
                for (int j = 0; j < 4; ++j) { float s = sacc[sq][nt][j];
                    if (swin) { const int dk = kpos0 + nt * 16 + quad * 4 + j - qpos[sq]; if (dk > 128 || dk < -128) s = -1e30f; sacc[sq][nt][j] = s; }
                    mx = fmaxf(mx, s); }
            mx = fmaxf(mx, __shfl_xor(mx, 16)); mx = fmaxf(mx, __shfl_xor(mx, 32));
            const float mnew = fmaxf(mrun[sq], mx), alpha = __builtin_amdgcn_exp2f(mrun[sq] - mnew); mrun[sq] = mnew;
            float ps = 0.f; float p[16];
#pragma unroll
            for (int nt = 0; nt < 4; ++nt)
#pragma unroll
                for (int j = 0; j < 4; ++j) { const float e = __builtin_amdgcn_exp2f(sacc[sq][nt][j] - mnew); p[nt * 4 + j] = e; ps += e; }
            lrun[sq] = lrun[sq] * alpha + ps;
#pragma unroll
            for (int dt = 0; dt < 4; ++dt) oacc[sq][dt] *= alpha;
            pb[sq][0] = __builtin_bit_cast(bf16x8, pack8(p)); pb[sq][1] = __builtin_bit_cast(bf16x8, pack8(p + 8));
        }
#pragma unroll
        for (int m2 = 0; m2 < 2; ++m2)
#pragma unroll
            for (int dt = 0; dt < 4; ++dt) { const LAS unsigned char* vp = Vl + (dt * 16 + r) * VSB + (32 * m2 + 4 * quad) * 2;
                const u32x2 lo = *(const LAS u32x2*)vp, hi = *(const LAS u32x2*)(vp + 32);
                const bf16x8 av = __builtin_bit_cast(bf16x8, (u32x4){lo.x, lo.y, hi.x, hi.y});
                oacc[0][dt] = __builtin_amdgcn_mfma_f32_16x16x32_bf16(av, pb[0][m2], oacc[0][dt], 0, 0, 0);
                oacc[1][dt] = __builtin_amdgcn_mfma_f32_16x16x32_bf16(av, pb[1][m2], oacc[1][dt], 0, 0, 0); }

        lds_sync(); }
        }
        if (ti0 + 1 < ntt) { const int ti = ti0 + 1;
        { if (ti + 1 < ntt) kv_lstore<MODE>(stB, Kl0 + ((ti + 1) & 1) * TILEB, Vl0 + ((ti + 1) & 1) * TILEB, KSB, tid);
        { const int tn = ti + 3; if (tn < ntt) { const bool sec2 = tn >= nt0; const int k02 = (sec2 ? tn - nt0 : tn) * 64; stB = kv_gload<MODE>(sec2 ? s1.k : s0.k, sec2 ? s1.ldk : s0.ldk, sec2 ? s1.kr : s0.kr, sec2 ? s1.ldkr : s0.ldkr, sec2 ? s1.v : s0.v, sec2 ? s1.ldv : s0.ldv, k02, tid); } }
        LAS unsigned char* Kl = Kl0 + (ti & 1) * TILEB; LAS unsigned char* Vl = Vl0 + (ti & 1) * TILEB;
        SEGSEL(ti)
        (void)sk_; (void)ldk_; (void)skr_; (void)ldkr_; (void)sv_; (void)ldv_; (void)rope_;
        const int kpos0 = pos0_ + k0_;
        f32x4 sacc[2][4];
#pragma unroll
        for (int sq = 0; sq < 2; ++sq)
#pragma unroll
            for (int nt = 0; nt < 4; ++nt) sacc[sq][nt] = Z4;
#pragma unroll
        for (int ks = 0; ks < NKS; ++ks)
#pragma unroll
            for (int nt = 0; nt < 4; ++nt) { const bf16x8 kf = *(const LAS bf16x8*)(Kl + (nt * 16 + r) * KSB + (ks * 32 + quad * 8) * 2);
                sacc[0][nt] = __builtin_amdgcn_mfma_f32_16x16x32_bf16(kf, qf[0][ks], sacc[0][nt], 0, 0, 0);
                sacc[1][nt] = __builtin_amdgcn_mfma_f32_16x16x32_bf16(kf, qf[1][ks], sacc[1][nt], 0, 0, 0); }
        bf16x8 pb[2][2];
#pragma unroll
        for (int sq = 0; sq < 2; ++sq) {
            float mx = -1e30f;
#pragma unroll
            for (int nt = 0; nt < 4; ++nt)
#pragma unroll
                for (int j = 0; j < 4; ++j) { float s = sacc[sq][nt][j];
                    if (swin) { const int dk = kpos0 + nt * 16 + quad * 4 + j - qpos[sq]; if (dk > 128 || dk < -128) s = -1e30f; sacc[sq][nt][j] = s; }
                    mx = fmaxf(mx, s); }
            mx = fmaxf(mx, __shfl_xor(mx, 16)); mx = fmaxf(mx, __shfl_xor(mx, 32));
            const float mnew = fmaxf(mrun[sq], mx), alpha = __builtin_amdgcn_exp2f(mrun[sq] - mnew); mrun[sq] = mnew;
            float ps = 0.f; float p[16];
#pragma unroll
            for (int nt = 0; nt < 4; ++nt)
#pragma unroll
                for (int j = 0; j < 4; ++j) { const float e = __builtin_amdgcn_exp2f(sacc[sq][nt][j] - mnew); p[nt * 4 + j] = e; ps += e; }
            lrun[sq] = lrun[sq] * alpha + ps;
#pragma unroll
            for (int dt = 0; dt < 4; ++dt) oacc[sq][dt] *= alpha;
            pb[sq][0] = __builtin_bit_cast(bf16x8, pack8(p)); pb[sq][1] = __builtin_bit_cast(bf16x8, pack8(p + 8));
        }
#pragma unroll
        for (int m2 = 0; m2 < 2; ++m2)
#pragma unroll
            for (int dt = 0; dt < 4; ++dt) { const LAS unsigned char* vp = Vl + (dt * 16 + r) * VSB + (32 * m2 + 4 * quad) * 2;
                const u32x2 lo = *(const LAS u32x2*)vp, hi = *(const LAS u32x2*)(vp + 32);
                const bf16x8 av = __builtin_bit_cast(bf16x8, (u32x4){lo.x, lo.y, hi.x, hi.y});
                oacc[0][dt] = __builtin_amdgcn_mfma_f32_16x16x32_bf16(av, pb[0][m2], oacc[0][dt], 0, 0, 0);
                oacc[1][dt] = __builtin_amdgcn_mfma_f32_16x16x32_bf16(av, pb[1][m2], oacc[1][dt], 0, 0, 0); }

        lds_sync(); }
        }
    }
#pragma unroll
    for (int sq = 0; sq < 2; ++sq) { float l = lrun[sq]; l += __shfl_xor(l, 16); l += __shfl_xor(l, 32);
        const float sk = sq ? sink1 : sink0; if (sk > -1e29f) l += __builtin_amdgcn_exp2f(sk - mrun[sq]);
        const float inv = __builtin_amdgcn_rcpf(l); bf16* op = (sq ? ob1 : ob0) + (size_t)((sq ? ro1 : ro0) + r) * ldo;
#pragma unroll
        for (int dt = 0; dt < 4; ++dt) { u32x2 o; o.x = pk2(oacc[sq][dt][0] * inv, oacc[sq][dt][1] * inv); o.y = pk2(oacc[sq][dt][2] * inv, oacc[sq][dt][3] * inv); *(u32x2*)(op + dt * 16 + quad * 4) = o; } }
    __syncthreads();
}

DI void attn_phase_unit(const Ctx& C, int l, int u) {
    const bf16* pA = (const bf16*)(C.ws + WS_PA); const bf16* kv16 = (const bf16*)(C.ws + WS_KV16); const bf16* qraw = (const bf16*)(C.ws + WS_QRAW);
    const bf16* kpec = (const bf16*)(C.ws + WS_KPEC); const bf16* skc = (const bf16*)(C.ws + WS_SWAKC); const bf16* svc = (const bf16*)(C.ws + WS_SWAVC);
    bf16* mix = (bf16*)(C.ws + WS_MIX); const float* rt = (const float*)(C.ws + WS_ROPE);
    const float mla_qs = 0.10206207261596577f * LOG2E, swa_qs = 0.125f * LOG2E;
    KVSeg s0{}, s1{};
    if (u < 384) {
        const bool lat = u < 256; int b, h, qrow0, qpos0;
        if (lat) { b = u >> 6; h = (u >> 4) & 3; const int qt = u & 15; qrow0 = TC + b * 4096 + qt * 256; qpos0 = qt * 256; } else { const int v = u - 256; b = v >> 2; h = v & 3; qrow0 = b * 256; qpos0 = 0; }
        const int ro0 = C.wave * 32, ro1 = ro0 + 16;
        const bf16* qb = qraw + (size_t)qrow0 * 384 + h * 96; bf16* ob = mix + (size_t)qrow0 * D + 256 + h * 64;
        if (lat) { const int cr = T + b * 256, lr = TC + b * 4096;
            s0 = KVSeg{kv16 + (size_t)cr * 512 + h * 128, 512, kpec + (size_t)(b * 256) * 32, 32, kv16 + (size_t)cr * 512 + h * 128 + 64, 512, 256, 0, 0, 0};
            s1 = KVSeg{kv16 + (size_t)lr * 512 + h * 128, 512, (const bf16*)(C.ws + WS_KPER) + (size_t)(b * 4096) * 32, 32, kv16 + (size_t)lr * 512 + h * 128 + 64, 512, 4096, 0, 0, 0};
            attn_unit<0>(C, qb, qb, 384, ro0, ro1, 1, qpos0, mla_qs, s0, s1, 2, -1e30f, -1e30f, ob, ob, D, rt, rt + 65536);
        } else { const int cr = b * 256;
            s0 = KVSeg{kv16 + (size_t)cr * 512 + h * 128, 512, pA + (size_t)cr * NA + 384, NA, kv16 + (size_t)cr * 512 + h * 128 + 64, 512, 256, 0, 0, 0};
            attn_unit<0>(C, qb, qb, 384, ro0, ro1, 0, qpos0, mla_qs, s0, s0, 1, -1e30f, -1e30f, ob, ob, D, rt, rt + 65536); }
    } else {
        const bool lat = u >= 512; int b, kvh, qrow0, qpos0;
        if (lat) { const int v = u - 512; b = v >> 6; kvh = (v >> 5) & 1; const int qbk = v & 31; qrow0 = TC + b * 4096 + qbk * 128; qpos0 = qbk * 128; }
        else { const int v = u - 384; b = v >> 2; kvh = (v >> 1) & 1; const int qt = v & 1; qrow0 = b * 256 + qt * 128; qpos0 = qt * 128; }
        const int ro = C.wave * 16; const int h0 = kvh * 2;
        const bf16* qb0 = pA + (size_t)qrow0 * NA + 416 + h0 * 64; const bf16* qb1 = qb0 + 64;
        bf16* ob0 = mix + (size_t)qrow0 * D + 768 + h0 * 64; bf16* ob1 = ob0 + 64;
        const float sk0 = C.in[30][l * 4 + h0] * LOG2E, sk1 = C.in[30][l * 4 + h0 + 1] * LOG2E;
        if (lat) { const int lr = TC + b * 4096; int klo = qpos0 - 128, khi = qpos0 + 256; if (klo < 0) klo = 0; if (khi > 4096) khi = 4096;
            s0 = KVSeg{skc + (size_t)(b * 256) * 128 + kvh * 64, 128, nullptr, 0, svc + (size_t)(b * 256) * 128 + kvh * 64, 128, 256, 0, 0, 0};
            s1 = KVSeg{(const bf16*)(C.ws + WS_KSR) + (size_t)(b * 4096 + klo) * 128 + kvh * 64, 128, nullptr, 0, pA + (size_t)(lr + klo) * NA + 800 + kvh * 64, NA, khi - klo, 0, klo, 1};
            attn_unit<1>(C, qb0, qb1, NA, ro, ro, 1, qpos0, swa_qs, s0, s1, 2, sk0, sk1, ob0, ob1, D, rt + 131072, rt + 262144);
        } else { const int cr = b * 256;
            s0 = KVSeg{pA + (size_t)cr * NA + 672 + kvh * 64, NA, nullptr, 0, pA + (size_t)cr * NA + 800 + kvh * 64, NA, 256, 0, 0, 0};
            attn_unit<1>(C, qb0, qb1, NA, ro, ro, 0, qpos0, swa_qs, s0, s0, 1, sk0, sk1, ob0, ob1, D, rt + 131072, rt + 262144); }
    }
}
struct Args { const float* in[34]; float* out; unsigned char* ws; int ph_lo, ph_hi; };
constexpr int NPHASES = 1 + 2 * 13 + 1;

__global__ void __launch_bounds__(NTHR) mk_fwd(Args args) {
    extern __shared__ __attribute__((aligned(16))) unsigned char lds_raw[];
    Ctx C; C.in = args.in; C.out = args.out; C.ws = args.ws; C.lds = (LAS unsigned char*)lds_raw;
    const int wave0 = __builtin_amdgcn_readfirstlane((int)threadIdx.x >> 6); C.tid = 0; C.lane = 0; C.wave = 0; C.bid = blockIdx.x; C.G = gridDim.x;
    unsigned char* ws = args.ws;
    volatile LAS unsigned* bst = (volatile LAS unsigned*)(C.lds + LDS_BYTES - 16);
    if (threadIdx.x < 4) bst[threadIdx.x] = 0u;
    __syncthreads();
    XcdBarrier xbar = xcd_barrier_post((unsigned*)ws, bst);
    int ph = 0;
#define PH_BEGIN if (ph >= args.ph_lo && ph < args.ph_hi) { { int w_ = wave0; asm volatile("" : "+s"(w_)); C.wave = w_; { int ln_; asm volatile("v_mbcnt_lo_u32_b32 %0, -1, 0\n\tv_mbcnt_hi_u32_b32 %0, -1, %0" : "=v"(ln_)); C.lane = ln_; } C.tid = C.wave * 64 + C.lane; }
#define PH_END } { const bool inside_ = (ph >= args.ph_lo && ph + 1 < args.ph_hi); ++ph; if (inside_) { if (args.ph_hi < 0) { __threadfence(); cg::this_grid().sync(); } else xcd_barrier(xbar); } }
    const float* ada_all = (const float*)(ws + WS_ADA);
    PH_BEGIN phase_ada_rope(C); PH_END
#pragma unroll 1
    for (int l = 0; l < 2; ++l) {
        asm volatile("" : "+s"(l));
        const float* ada = ada_all + (size_t)l * 5 * 6144;
        const float* xc = l == 0 ? args.in[0] : args.out; const float* xl = l == 0 ? args.in[1] : args.out + (size_t)TC * D;
        PH_BEGIN if (l == 0) { int g2_ = C.G; asm volatile("" : "+s"(g2_)); phase_weights(C, 0, 1, C.bid, g2_); } phase_norm(C, xc, xl, args.in[10] + l * D, ada, 0, (bf16*)(ws + WS_XN)); PH_END
        PH_BEGIN { pg8::Gemm g{(const pg8::bf16_t*)(ws + WS_XN), (const pg8::bf16_t*)(ws + WS_WIN), T, 1024, 1024, 1024, C.tid}; pg8::StaticOrder S; S.init(T, 1024, C.G, C.bid);
            EpiP E{(bf16*)(ws + WS_PA), NA, NA, 0, l, args.out, nullptr}; pg8::gemm_phase<EpiP, pg8::StaticOrder, true, true>(C.lds, g, S, E);
            if (C.bid >= 128) { Ctx C2 = C; asm volatile("" : "+v"(C2.tid), "+v"(C2.lane)); phase_weights(C2, l, l == 0 ? 6 : 2, C.bid - 128, 128); } } PH_END
        PH_BEGIN phase_mla_prep(C, l); PH_END
        PH_BEGIN { int kq_ = 256; asm volatile("" : "+s"(kq_)); const int half_ = __builtin_amdgcn_readfirstlane(C.bid >= 128 ? 1 : 0);
            const bool q_ = half_ == 0;
            pg8::Gemm g{(const pg8::bf16_t*)(ws + (q_ ? WS_QN16 : WS_CKV16)), (const pg8::bf16_t*)(ws + (q_ ? WS_WUQ : WS_WUKV)), q_ ? T : NKV, 512, kq_, kq_, C.tid};
            pg8::StaticOrder S; S.init(q_ ? T : NKV, 512, 128, C.bid & 127);
            EpiRS E{(bf16*)(ws + (q_ ? WS_QRAW : WS_KV16)), q_ ? 384 : 512, q_ ? 384 : 512}; pg8::gemm_phase<EpiRS, pg8::StaticOrder, true, true>(C.lds, g, S, E); } PH_END
        PH_BEGIN for (int u = (C.bid & 7) * 32 + (C.bid >> 3); u < 768; u += 256) { Ctx C2 = C;     asm volatile("" : "+v"(C2.tid), "+v"(C2.lane)); attn_phase_unit(C2, l, u); } PH_END
        PH_BEGIN { pg8::Gemm g{(const pg8::bf16_t*)(ws + WS_XN), (const pg8::bf16_t*)(ws + WS_WIN) + (size_t)1024 * 1024, T, 2048, 1024, 1024, C.tid}; pg8::StaticOrder S; S.init(T, 2048, C.G, C.bid);
            EpiP E{(bf16*)(ws + WS_PB), NB, NB, 1, l, args.out, (float*)(ws + WS_SIDE)}; pg8::gemm_phase<EpiP, pg8::StaticOrder, true, true>(C.lds, g, S, E); } PH_END
        PH_BEGIN for (int it = C.bid; it < 1024; it += C.G) { Ctx C2 = C; asm volatile("" : "+v"(C2.tid), "+v"(C2.lane)); if (it < 512) dn_phase1_item(C2, l, it); else ss_phase1_item(C2, l, it - 512); } PH_END
        PH_BEGIN ss_scan(C, l); if (C.bid < 128) dn_scan_unit(C, l, C.bid); else if (C.bid < 256) { Ctx C2 = C; asm volatile("" : "+v"(C2.tid), "+v"(C2.lane)); ss_phase3_item(C2, l, C.bid - 128); } PH_END
        PH_BEGIN for (int rnd = 0; rnd < 3; ++rnd) { Ctx C2 = C; asm volatile("" : "+v"(C2.tid), "+v"(C2.lane));
            if (C.bid < 128) { if (rnd == 0) dn_phase3_item(C2, l, C.bid); else if (rnd == 1) dn_phase3_item(C2, l, 256 + C.bid); else ssd_fix_rows(C2, l, C.bid * 64, 64, 0, 2); }
            else if (C.bid < 256) { const int it0 = 128 + (C.bid - 128) * 2; if (rnd == 0) dn_phase3_item(C2, l, C.bid); else ss_phase3_item(C2, l, it0 + (rnd - 1));
                if (rnd == 2) { const int v_ = (it0 >> 2) - 32; ssd_fix_rows(C2, l, TC + (v_ >> 4) * 4096 + (v_ & 15) * 256, 256, (it0 & 3) >> 1, 1); } } } PH_END
        PH_BEGIN { pg8::Gemm g{(const pg8::bf16_t*)(ws + WS_MIX), (const pg8::bf16_t*)(ws + WS_WOUT), T, 1024, 1024, 1024, C.tid}; pg8::StaticOrder S; S.init(T, 1024, C.G, C.bid);
            EpiRes E{xc, xl, args.out, ada, 2048}; pg8::gemm_phase<EpiRes, pg8::StaticOrder, true, true>(C.lds, g, S, E);
            if (l == 0 && C.bid >= 128) { Ctx C2 = C; asm volatile("" : "+v"(C2.tid), "+v"(C2.lane)); phase_weights(C2, 0, 8, C.bid - 128, 128); } } PH_END
        PH_BEGIN phase_norm(C, args.out, args.out + (size_t)TC * D, args.in[11] + l * D, ada, 1, (bf16*)(ws + WS_XN)); PH_END
        PH_BEGIN { pg8::Gemm g{(const pg8::bf16_t*)(ws + WS_XN), (const pg8::bf16_t*)(ws + WS_WGU), T, 5632, 1024, 1024, C.tid}; pg8::StaticOrder S; S.init(T, 5632, C.G, C.bid);
            EpiSwiglu E{(bf16*)(ws + WS_ACT)}; pg8::gemm_phase<EpiSwiglu, pg8::StaticOrder, true, true>(C.lds, g, S, E); } PH_END
        PH_BEGIN { pg8::Gemm g{(const pg8::bf16_t*)(ws + WS_ACT), (const pg8::bf16_t*)(ws + WS_WDN), T, 1024, 2816, 2816, C.tid}; pg8::StaticOrder S; S.init(T, 1024, C.G, C.bid);
            EpiRes E{args.out, args.out + (size_t)TC * D, args.out, ada, 5120}; pg8::gemm_phase<EpiRes, pg8::StaticOrder, true, true>(C.lds, g, S, E);
            if (l == 0 && C.bid >= 128) { Ctx C2 = C; asm volatile("" : "+v"(C2.tid), "+v"(C2.lane)); phase_weights(C2, 1, 13, C.bid - 128, 128); } } PH_END
    }
    PH_BEGIN phase_final_norm(C, args.in[33]); PH_END
}

extern "C" void kernel_launch(void* const* d_in, const int* in_sizes, int n_in, void* d_out, int out_size, void* d_ws, size_t ws_size, hipStream_t stream) {
    static int grid = 0;
    if (grid == 0) {
        if (n_in != 34 || out_size != 36175872 || ws_size < WS_END) { fprintf(stderr, "kernel_launch: unexpected problem (n_in %d out %d ws %zu)\n", n_in, out_size, ws_size); grid = -1; return; }
        int dev = 0, cus = 0, per_cu = 0;
        if (hipGetDevice(&dev) != hipSuccess || hipDeviceGetAttribute(&cus, hipDeviceAttributeMultiprocessorCount, dev) != hipSuccess) { grid = -1; return; }
        if (hipFuncSetAttribute((const void*)mk_fwd, hipFuncAttributeMaxDynamicSharedMemorySize, LDS_BYTES) != hipSuccess) { fprintf(stderr, "kernel_launch: hipFuncSetAttribute failed\n"); grid = -1; return; }
        if (hipOccupancyMaxActiveBlocksPerMultiprocessor(&per_cu, (const void*)mk_fwd, NTHR, LDS_BYTES) != hipSuccess || per_cu < 1) { fprintf(stderr, "kernel_launch: occupancy query says %d\n", per_cu); per_cu = 1; }
        (void)hipGetLastError();
        grid = cus * per_cu;
        if (grid >= 256) grid = 256;
        else { fprintf(stderr, "kernel_launch: needs 256 co-resident workgroups, device offers %d\n", grid); grid = -1; return; }
    }
    if (grid < 0) return;
    if (hipMemsetAsync(d_ws, 0, 16384, stream) != hipSuccess) { fprintf(stderr, "kernel_launch: memset failed\n"); return; }
    Args a{};
    for (int i = 0; i < 34; ++i) a.in[i] = (const float*)d_in[i];
    a.out = (float*)d_out; a.ws = (unsigned char*)d_ws;
#if MK_SINGLE
    a.ph_lo = 0; a.ph_hi = NPHASES;
    void* kargs[] = {&a};
    hipError_t e = hipLaunchCooperativeKernel((const void*)mk_fwd, dim3(grid), dim3(NTHR), kargs, LDS_BYTES, stream);
    if (e != hipSuccess) fprintf(stderr, "kernel_launch: cooperative launch failed: %s (grid %d)\n", hipGetErrorString(e), grid);
#else
    for (int p = 0; p < NPHASES; ++p) { a.ph_lo = p; a.ph_hi = p + 1; hipLaunchKernelGGL(mk_fwd, dim3(grid), dim3(NTHR), LDS_BYTES, stream, a); }
#endif
}
```

```cpp
#include <hip/hip_runtime.h>
#include <hip/hip_cooperative_groups.h>
#include <cstdio>
#include <cstdint>
namespace cg = cooperative_groups;
namespace pg8 {
#define PG8_LAS __attribute__((address_space(3)))
typedef unsigned short bf16_t;
typedef short bf16x8 __attribute__((ext_vector_type(8)));
typedef float f32x4 __attribute__((ext_vector_type(4)));
typedef unsigned u32x4 __attribute__((ext_vector_type(4)));
constexpr int BM = 256, BK = 64, HALF = 128, HTB = HALF * BK * 2  , STAGE_BYTES = 8 * HTB, NXCD = 8, WGM = 8;

__host__ __device__ __forceinline__ int lds_byte(int r, int c) { const int st = (r >> 4) * 2 + (c >> 5), rr = r & 15, cc = c & 31, ob = rr * 64 + cc * 2; return st * 1024 + (ob ^ (((ob >> 9) & 1) << 5)); }
__host__ __device__ __forceinline__ void stage_rc(int b, int& R, int& C) { const int st = b / 1024, sb = b % 1024, swz = sb ^ (((sb >> 9) & 1) << 5); R = (st >> 1) * 16 + swz / 64; C = (st & 1) * 32 + (swz % 64) / 2; }
__host__ __device__ __forceinline__ int perm32(int rho) { const int n = rho >> 4, i = rho & 15; return 8 * (i >> 2) + 4 * n + (i & 3); }

struct Unit { int pm, pn; };
struct Gemm { const bf16_t* A; const bf16_t* Bt; int M, N, K, lda; int tid; };
struct StaticOrder {
    int nM, nN, nwg, G, c;
    __host__ __device__ void init(int M, int N, int G_, int c_) { nM = M / BM; nN = N / BM; nwg = nM * nN; G = G_; c = c_; }
    __host__ __device__ bool next(int i, Unit& u) const {
        const long L = (long)i * G + c; if (L >= nwg) return false;
        int wgid = (int)L; { const int q = nwg / NXCD, r = nwg % NXCD, xcd = wgid % NXCD, off = wgid / NXCD; wgid = (xcd < r ? xcd * (q + 1) : r * (q + 1) + (xcd - r) * q) + off; }
        const int nig = WGM * nN, gid = wgid / nig, fm = gid * WGM, gsz = (nM - fm) < WGM ? (nM - fm) : WGM;
        u.pm = fm + ((wgid % nig) % gsz); u.pn = (wgid % nig) / gsz; return true;
    }
    __device__ __forceinline__ void a_ready(const Unit&) const {}
    __device__ __forceinline__ void done(const Unit&) const {}
};
__device__ __forceinline__ unsigned cvt_pk_bf16(float lo, float hi) { unsigned r; asm volatile("v_cvt_pk_bf16_f32 %0, %1, %2" : "=v"(r) : "v"(lo), "v"(hi)); return r; }
template <class Epi, class Sched, bool ALIGN_EPI = false, bool SP2 = false>
__device__ __forceinline__ void gemm_phase(PG8_LAS unsigned char* lds, const Gemm g, const Sched& S, const Epi& E) {
    const int tid = g.tid, wid = __builtin_amdgcn_readfirstlane(tid >> 6), lane = tid & 63, wr = wid >> 2, wc = wid & 3, fr = lane & 15, fq = lane >> 4;
    const int K = g.K, nt = K / BK;
    unsigned voffA[2], voffB[2];
#pragma unroll
    for (int i = 0; i < 2; ++i) { int R, C; stage_rc(tid * 16 + i * 8192, R, C); const int Rb = Epi::PERM ? ((R & ~31) + perm32(R & 31)) : R;
        voffA[i] = (unsigned)(R * g.lda + C) * 2u; voffB[i] = (unsigned)(Rb * K + C) * 2u; }
    const size_t kstep = (size_t)(BK * 2);
    const size_t hstep = (size_t)HALF * K * 2;
    const size_t tstep = 2 * hstep; const size_t hstepA = (size_t)HALF * g.lda * 2, tstepA = 2 * hstepA;
    const unsigned ldsw = (unsigned)wid * 1024u;
    const int aoff = lds_byte(wr * 64 + fr, fq * 8), boff = lds_byte(wc * 32 + fr, fq * 8);
#define PG8_SA(b, h) (((b) * 2 + (h)) * HTB)
#define PG8_SB(b, h) ((4 + (b) * 2 + (h)) * HTB)
#define PG8_STAGE(bufoff, gbase, voff) do { _Pragma("unroll") for (int _i = 0; _i < 2; ++_i) \
        __builtin_amdgcn_global_load_lds((const unsigned*)((const char*)(gbase) + (voff)[_i]), (PG8_LAS unsigned*)(lds + (bufoff) + ldsw + _i * 8192), 16, 0, 0); } while (0)
#define PG8_LDA(dst, b, h) do { _Pragma("unroll") for (int m = 0; m < 4; ++m) _Pragma("unroll") for (int k = 0; k < 2; ++k) dst[m][k] = *(const PG8_LAS bf16x8*)(lds + PG8_SA(b, h) + aoff + m * 2048 + k * 1024); } while (0)
#define PG8_LDB(dst, b, h) do { _Pragma("unroll") for (int n = 0; n < 2; ++n) _Pragma("unroll") for (int k = 0; k < 2; ++k) dst[n][k] = *(const PG8_LAS bf16x8*)(lds + PG8_SB(b, h) + boff + n * 2048 + k * 1024); } while (0)
#define PG8_MMA(ai, bj, At, Bt) do { __builtin_amdgcn_s_setprio(1); _Pragma("unroll") for (int m = 0; m < 4; ++m) _Pragma("unroll") for (int n = 0; n < 2; ++n) _Pragma("unroll") for (int k = 0; k < 2; ++k) \
        acc[ai][bj][m][n] = __builtin_amdgcn_mfma_f32_16x16x32_bf16(Bt[n][k], At[m][k], acc[ai][bj][m][n], 0, 0, 0); __builtin_amdgcn_s_setprio(0); } while (0)
#define PG8_WAIT_V(n) asm volatile("s_waitcnt vmcnt(" #n ")" ::: "memory")
#define PG8_WAIT_L(n) asm volatile("s_waitcnt lgkmcnt(" #n ")" ::: "memory")
#define PG8_BAR __builtin_amdgcn_s_barrier()
#define PG8_SCHED __builtin_amdgcn_sched_barrier(0)
    Unit cur, nxt; int ui = 0;
    if (!S.next(0, cur)) return;
    f32x4 acc[2][2][4][2];
#pragma unroll
    for (int a = 0; a < 2; ++a)
#pragma unroll
        for (int b = 0; b < 2; ++b)
#pragma unroll
            for (int m = 0; m < 4; ++m)
#pragma unroll
                for (int n = 0; n < 2; ++n) acc[a][b][m][n] = (f32x4){0.f, 0.f, 0.f, 0.f};
    bf16x8 At[4][2], B0[2][2], B1[2][2];
    const char* cA = (const char*)g.A + (size_t)cur.pm * tstepA; const char* cB = (const char*)g.Bt + (size_t)cur.pn * tstep;
    S.a_ready(cur);
    if constexpr (SP2) {
        PG8_STAGE(PG8_SB(0, 0), cB, voffB); PG8_STAGE(PG8_SB(0, 1), cB + hstep, voffB); PG8_STAGE(PG8_SA(0, 0), cA, voffA); PG8_STAGE(PG8_SA(0, 1), cA + hstepA, voffA);
        if (wr == 1) PG8_BAR;
        PG8_WAIT_V(2); PG8_BAR;
        PG8_STAGE(PG8_SB(1, 0), cB + kstep, voffB); PG8_STAGE(PG8_SA(1, 0), cA + kstep, voffA); PG8_STAGE(PG8_SB(1, 1), cB + hstep + kstep, voffB);
        PG8_WAIT_V(6); PG8_BAR;
    } else {
        PG8_STAGE(PG8_SB(0, 0), cB, voffB); PG8_STAGE(PG8_SA(0, 0), cA, voffA); PG8_STAGE(PG8_SB(0, 1), cB + hstep, voffB); PG8_STAGE(PG8_SA(0, 1), cA + hstepA, voffA);
        if (wr == 1) PG8_BAR;
        PG8_WAIT_V(4); PG8_BAR;
        PG8_STAGE(PG8_SB(1, 0), cB + kstep, voffB); PG8_STAGE(PG8_SA(1, 0), cA + kstep, voffA); PG8_STAGE(PG8_SB(1, 1), cB + hstep + kstep, voffB);
        PG8_WAIT_V(6); PG8_BAR;
    }
    for (;;) {
        const bool has_next = S.next(ui + 1, nxt);
        const char* nA = has_next ? (const char*)g.A + (size_t)nxt.pm * tstepA : cA; const char* nB = has_next ? (const char*)g.Bt + (size_t)nxt.pn * tstep : cB;
        for (int t = 0; t < nt; t += 2) {
            const bool last = (t == nt - 2);
            const char* a1 = cA + (size_t)(t + 1) * kstep;
            const char* a2 = last ? nA : cA + (size_t)(t + 2) * kstep; const char* b2 = last ? nB : cB + (size_t)(t + 2) * kstep;
            const char* a3 = a2 + kstep; const char* b3 = b2 + kstep;
            if (last && has_next) S.a_ready(nxt);
            if constexpr (SP2) {
            PG8_LDB(B0, 0, 0); PG8_LDB(B1, 0, 1); PG8_SCHED; PG8_LDA(At, 0, 0); PG8_STAGE(PG8_SA(1, 1), a1 + hstepA, voffA);
            PG8_WAIT_V(8); PG8_WAIT_L(0); PG8_BAR; PG8_MMA(0, 0, At, B0); PG8_MMA(0, 1, At, B1); PG8_BAR; PG8_SCHED;
            PG8_LDA(At, 0, 1); PG8_STAGE(PG8_SB(0, 0), b2, voffB); PG8_STAGE(PG8_SB(0, 1), b2 + hstep, voffB); PG8_STAGE(PG8_SA(0, 0), a2, voffA);
            PG8_WAIT_V(8); PG8_WAIT_L(0); PG8_BAR; PG8_MMA(1, 0, At, B0); PG8_MMA(1, 1, At, B1); PG8_BAR; PG8_SCHED;
            PG8_LDB(B0, 1, 0); PG8_LDB(B1, 1, 1); PG8_SCHED; PG8_LDA(At, 1, 0); PG8_STAGE(PG8_SA(0, 1), a2 + hstepA, voffA);
            PG8_WAIT_V(8); PG8_WAIT_L(0); PG8_BAR; PG8_MMA(0, 0, At, B0); PG8_MMA(0, 1, At, B1); PG8_BAR; PG8_SCHED;
            PG8_LDA(At, 1, 1); PG8_STAGE(PG8_SB(1, 0), b3, voffB); PG8_STAGE(PG8_SB(1, 1), b3 + hstep, voffB); PG8_STAGE(PG8_SA(1, 0), a3, voffA);
            PG8_WAIT_V(8); PG8_WAIT_L(0); PG8_BAR; PG8_MMA(1, 0, At, B0); PG8_MMA(1, 1, At, B1); PG8_BAR; PG8_SCHED;
            } else {
            PG8_LDB(B0, 0, 0); PG8_SCHED; PG8_LDA(At, 0, 0); PG8_STAGE(PG8_SA(1, 1), a1 + hstepA, voffA);
            PG8_WAIT_L(8); PG8_BAR; PG8_WAIT_L(0); PG8_MMA(0, 0, At, B0); PG8_BAR; PG8_SCHED;
            PG8_LDB(B1, 0, 1); PG8_STAGE(PG8_SB(0, 0), b2, voffB);
            PG8_BAR; PG8_WAIT_L(0); PG8_MMA(0, 1, At, B1); PG8_BAR;
            PG8_LDA(At, 0, 1); PG8_STAGE(PG8_SA(0, 0), a2, voffA);
            PG8_BAR; PG8_WAIT_L(0); PG8_MMA(1, 0, At, B0); PG8_BAR; PG8_SCHED;
            PG8_STAGE(PG8_SB(0, 1), b2 + hstep, voffB);
            PG8_WAIT_V(6); PG8_BAR; PG8_MMA(1, 1, At, B1); PG8_BAR;
            PG8_LDB(B0, 1, 0); PG8_SCHED; PG8_LDA(At, 1, 0); PG8_STAGE(PG8_SA(0, 1), a2 + hstepA, voffA);
            PG8_WAIT_L(8); PG8_BAR; PG8_WAIT_L(0); PG8_MMA(0, 0, At, B0); PG8_BAR; PG8_SCHED;
            PG8_LDB(B1, 1, 1); PG8_STAGE(PG8_SB(1, 0), b3, voffB);
            PG8_BAR; PG8_WAIT_L(0); PG8_MMA(0, 1, At, B1); PG8_BAR;
            PG8_LDA(At, 1, 1); PG8_STAGE(PG8_SA(1, 0), a3, voffA);
            PG8_BAR; PG8_WAIT_L(0); PG8_MMA(1, 0, At, B0); PG8_BAR; PG8_SCHED;
            PG8_STAGE(PG8_SB(1, 1), b3 + hstep, voffB);
            PG8_WAIT_V(6); PG8_BAR; PG8_MMA(1, 1, At, B1); PG8_BAR;
            }
        }
        if constexpr (ALIGN_EPI) { if (wr == 0) PG8_BAR; }
        if constexpr (!Epi::AFTER_DRAIN) { E(acc, cur, wr, wc, fr, fq); S.done(cur); }
        if (!has_next) break;
#pragma unroll
        for (int a = 0; a < 2; ++a)
#pragma unroll
            for (int b = 0; b < 2; ++b)
#pragma unroll
                for (int m = 0; m < 4; ++m)
#pragma unroll
                    for (int n = 0; n < 2; ++n) acc[a][b][m][n] = (f32x4){0.f, 0.f, 0.f, 0.f};
        cur = nxt; cA = nA; cB = nB; ++ui;
        if constexpr (ALIGN_EPI) { if (wr == 1) PG8_BAR; }
    }
    PG8_WAIT_V(0);
    if constexpr (!ALIGN_EPI) { if (wr == 0) PG8_BAR; }
    PG8_BAR;
    if constexpr (Epi::AFTER_DRAIN) { E.fused(acc, cur, wr, wc, fr, fq, lds, wid, lane); S.done(cur); }
#undef PG8_SA
#undef PG8_SB
#undef PG8_STAGE
#undef PG8_LDA
#undef PG8_LDB
#undef PG8_MMA
#undef PG8_WAIT_V
#undef PG8_WAIT_L
#undef PG8_BAR
#undef PG8_SCHED
}
}
#ifndef MK_SINGLE
#define MK_SINGLE 1
#endif
#define DI __device__ __forceinline__
#define LAS __attribute__((address_space(3)))
typedef unsigned short bf16;
typedef float f32x4 __attribute__((ext_vector_type(4)));
typedef short bf16x8 __attribute__((ext_vector_type(8)));
typedef unsigned u32x4 __attribute__((ext_vector_type(4)));
typedef unsigned u32x2 __attribute__((ext_vector_type(2)));

constexpr int T = 24576, TC = 8192, D = 1024, FF = 2816, NA = 928, NB = 1816, NKV = 25600;
constexpr int NWAVES = 8, NTHR = 512;
constexpr float EPS = 1e-6f;
constexpr float LOG2E = 1.4426950408889634f;
constexpr size_t O_Y = 0, O_SDN = 25165824, O_CKV = 27262976, O_KPE = 29360128, O_SSM = 29884416, O_SK = 31981568, O_SV = 34078720;
constexpr size_t MiB = 1u << 20, KiB = 1024;
constexpr size_t WS_ADA = 64 * KiB;
constexpr size_t WS_ROPE = 1 * MiB;
constexpr size_t WS_RS = 3 * MiB;
constexpr size_t WS_SSQ = 3 * MiB + 256 * KiB;
constexpr size_t WS_CKVC = 4 * MiB;
constexpr size_t WS_KPEC = 4 * MiB + 512 * KiB;
constexpr size_t WS_SWAKC = WS_KPEC + 64 * KiB;
constexpr size_t WS_SWAVC = WS_SWAKC + 256 * KiB;
constexpr size_t WS_WUQ = 5 * MiB + 256 * KiB;
constexpr size_t WS_WUKV = WS_WUQ + 256 * KiB;
constexpr size_t WS_WUKVC = WS_WUKV + 256 * KiB;
constexpr size_t WS_WIN = 6 * MiB;
constexpr size_t WS_WOUT = 12 * MiB;
constexpr size_t WS_WGU = 14 * MiB;
constexpr size_t WS_WDN = 25 * MiB;
constexpr size_t WS_XN = 31 * MiB;
constexpr size_t WS_MIX = 79 * MiB;
constexpr size_t WS_PA = 127 * MiB;
constexpr size_t WS_KV16 = 171 * MiB;
constexpr size_t WS_QRAW = 196 * MiB;
constexpr size_t WS_PB = 127 * MiB;
constexpr size_t WS_MN = 213 * MiB;
constexpr size_t WS_CS = 229 * MiB;
constexpr size_t WS_CD = 237 * MiB;
constexpr size_t WS_SIDE = 238 * MiB;
constexpr size_t WS_CKV16 = 214 * MiB;
constexpr size_t WS_QN16 = 227 * MiB;
constexpr size_t WS_ACT = 79 * MiB;
constexpr size_t WS_KPER = 239 * MiB;
constexpr size_t WS_KSR = 240 * MiB;
constexpr size_t WS_END = 244 * MiB;
constexpr int LDS_BYTES = 147456;

typedef float f32x2_t __attribute__((ext_vector_type(2)));
typedef __bf16 bf16x2_t __attribute__((ext_vector_type(2)));
DI unsigned pk2(float lo, float hi) { const f32x2_t v = {lo, hi}; const bf16x2_t b = __builtin_convertvector(v, bf16x2_t); return __builtin_bit_cast(unsigned, b); }
DI unsigned f2bf(float f) { return pk2(f, 0.f) & 0xffffu; }
DI float bflo(unsigned v) { return __builtin_bit_cast(float, v << 16); }
DI float bfhi(unsigned v) { return __builtin_bit_cast(float, v & 0xffff0000u); }
DI void unpack8(u32x4 v, float* f) { f[0] = bflo(v.x); f[1] = bfhi(v.x); f[2] = bflo(v.y); f[3] = bfhi(v.y); f[4] = bflo(v.z); f[5] = bfhi(v.z); f[6] = bflo(v.w); f[7] = bfhi(v.w); }
DI void ld8(const bf16* p, float* f) { unpack8(*(const u32x4*)p, f); }
DI u32x4 pack8(const float* f) { u32x4 o; o.x = pk2(f[0], f[1]); o.y = pk2(f[2], f[3]); o.z = pk2(f[4], f[5]); o.w = pk2(f[6], f[7]); return o; }
DI float wave_sum(float v) {
#pragma unroll
    for (int o = 32; o; o >>= 1) v += __shfl_xor(v, o);
    return v; }
DI float siluf(float x) { return x / (1.f + expf(-x)); }
DI float fsilu(float x) { return x * __builtin_amdgcn_rcpf(1.f + __expf(-x)); }
DI float softplusf(float x) { return x > 20.f ? x : log1pf(expf(x)); }
DI float fsoftplus(float x) { const float y = __expf(x); return x > 20.f ? x : (y < 1e-3f ? y * (1.f - 0.5f * y) : __logf(1.f + y)); }

struct EpiP {
    static constexpr bool PERM = true, AFTER_DRAIN = false;
    bf16* P; int ldc, ncols, mode, layer; float* out; float* side;
    DI void operator()(const pg8::f32x4 (&acc)[2][2][4][2], const pg8::Unit& u, int wr, int wc, int fr, int fq) const {
        const int row0 = u.pm * 256 + wr * 64 + fr, col0 = u.pn * 256 + wc * 32 + 8 * fq;
#pragma unroll
        for (int ai = 0; ai < 2; ++ai)
#pragma unroll
            for (int m = 0; m < 4; ++m) { const int row = row0 + ai * 128 + m * 16;
#pragma unroll
                for (int bj = 0; bj < 2; ++bj) { const int c = col0 + bj * 128; const pg8::f32x4 v0 = acc[ai][bj][m][0], v1 = acc[ai][bj][m][1];
                    if (c < ncols) { u32x4 w; w.x = pk2(v0[0], v0[1]); w.y = pk2(v0[2], v0[3]); w.z = pk2(v1[0], v1[1]); w.w = pk2(v1[2], v1[3]); *(u32x4*)(P + (size_t)row * ldc + c) = w; }
                    float* dst = nullptr;
                    if (mode == 0) { if (row < TC) { const size_t rb = (size_t)((row >> 8) * 2 + layer) * 256 + (row & 255);
                            if (c >= 256 && c < 384) dst = out + O_CKV + rb * 128 + (c - 256);
                            else if (c >= 384 && c < 416) dst = out + O_KPE + rb * 32 + (c - 384);
                            else if (c >= 672 && c < 800) dst = out + O_SK + rb * 128 + (c - 672);
                            else if (c >= 800 && c < 928) dst = out + O_SV + rb * 128 + (c - 800); } }
                    else { if (c >= 1024 && c < 1040) dst = side + (size_t)row * 24 + (c - 1024); else if (c >= 1808 && c < 1816) dst = side + (size_t)row * 24 + 16 + (c - 1808); }
                    if (dst) { *(pg8::f32x4*)dst = v0; *(pg8::f32x4*)(dst + 4) = v1; } } }
    }
};
struct EpiRS {
    static constexpr bool PERM = true, AFTER_DRAIN = false;
    bf16* O; int ldc, ncols;
    DI void operator()(const pg8::f32x4 (&acc)[2][2][4][2], const pg8::Unit& u, int wr, int wc, int fr, int fq) const {
        const int row0 = u.pm * 256 + wr * 64 + fr, col0 = u.pn * 256 + wc * 32 + 8 * fq;
#pragma unroll
        for (int ai = 0; ai < 2; ++ai)
#pragma unroll
            for (int m = 0; m < 4; ++m) { const int row = row0 + ai * 128 + m * 16;
#pragma unroll
                for (int bj = 0; bj < 2; ++bj) { const int c = col0 + bj * 128; const pg8::f32x4 v0 = acc[ai][bj][m][0], v1 = acc[ai][bj][m][1];
                    if (c < ncols) { u32x4 w; w.x = pk2(v0[0], v0[1]); w.y = pk2(v0[2], v0[3]); w.z = pk2(v1[0], v1[1]); w.w = pk2(v1[2], v1[3]); *(u32x4*)(O + (size_t)row * ldc + c) = w; } } }
    }
};
struct EpiRes {
    static constexpr bool PERM = false, AFTER_DRAIN = false;
    const float* src_c; const float* src_l; float* dst; const float* ada; int goff;
    DI void operator()(const pg8::f32x4 (&acc)[2][2][4][2], const pg8::Unit& u, int wr, int wc, int fr, int fq) const {
        const int row0 = u.pm * 256 + wr * 64 + fr, col0 = u.pn * 256 + wc * 32 + 4 * fq;
        const int rt = u.pm * 256; const int r = rt < TC ? 0 : 1 + ((rt - TC) >> 12);
        const float* g = ada + (size_t)r * 6144 + goff;
        pg8::f32x4 gv[2][2];
#pragma unroll
        for (int bj = 0; bj < 2; ++bj)
#pragma unroll
            for (int n = 0; n < 2; ++n) gv[bj][n] = *(const pg8::f32x4*)(g + col0 + bj * 128 + n * 16);
#pragma unroll
        for (int ai = 0; ai < 2; ++ai)
#pragma unroll
            for (int m = 0; m < 4; ++m) { const int row = row0 + ai * 128 + m * 16;
                const float* sp = (row < TC ? src_c + (size_t)row * D : src_l + (size_t)(row - TC) * D) + col0; float* dp = dst + (size_t)row * D + col0;
#pragma unroll
                for (int bj = 0; bj < 2; ++bj)
#pragma unroll
                    for (int n = 0; n < 2; ++n) { const pg8::f32x4 xo = *(const pg8::f32x4*)(sp + bj * 128 + n * 16); *(pg8::f32x4*)(dp + bj * 128 + n * 16) = xo + gv[bj][n] * acc[ai][bj][m][n]; } }
    }
};
struct EpiSwiglu {
    static constexpr bool PERM = true, AFTER_DRAIN = false;
    bf16* O;
    DI void operator()(const pg8::f32x4 (&acc)[2][2][4][2], const pg8::Unit& u, int wr, int wc, int fr, int fq) const {
        const int row0 = u.pm * 256 + wr * 64 + fr, col0 = u.pn * 128 + wc * 32 + 8 * fq;
#pragma unroll
        for (int ai = 0; ai < 2; ++ai)
#pragma unroll
            for (int m = 0; m < 4; ++m) { const int row = row0 + ai * 128 + m * 16; float o[8];
#pragma unroll
                for (int n = 0; n < 2; ++n)
#pragma unroll
                    for (int i = 0; i < 4; ++i) { const float gt = acc[ai][0][m][n][i], up = acc[ai][1][m][n][i]; o[n * 4 + i] = fsilu(gt) * up; }
                *(u32x4*)(O + (size_t)row * FF + col0) = pack8(o); }
    }
};
#define RLX_AGENT __ATOMIC_RELAXED, __HIP_MEMORY_SCOPE_AGENT
#define XB_TMO      128
#define XB_XCNT(j)  (256  + 64 * (j))
#define XB_XSUB(j)  (1280 + 64 * (j))
#define XB_XGEN(j)  (2304 + 64 * (j))
#define XB_TOP      3328
#define XB_TOPGEN   3392
#define XCD_BAR_WORDS 3456
#define XB_SPIN_CAP (1u << 18)

__device__ __forceinline__ unsigned xb_ld(unsigned* p)              { return __hip_atomic_load(p, __ATOMIC_RELAXED, __HIP_MEMORY_SCOPE_AGENT); }
__device__ __forceinline__ unsigned xb_add(unsigned* p, unsigned v) { return __hip_atomic_fetch_add(p, v, __ATOMIC_RELAXED, __HIP_MEMORY_SCOPE_AGENT); }
__device__ __forceinline__ unsigned xb_xcc_id() { return (unsigned)__builtin_amdgcn_s_getreg((3 << 11) | 20) & 0xFu; }
#define XB_SPIN(cond, bar) do { unsigned _sp = 0; while (cond) { __builtin_amdgcn_s_sleep(1); \
    if ((++_sp & 255u) == 0u) { if (xb_ld(&(bar)[XB_TMO])) break; if (_sp > XB_SPIN_CAP) { atomicAdd(&(bar)[XB_TMO], 1u); break; } } } } while (0)

struct XcdBarrier {
    unsigned* bar; unsigned x;
    volatile LAS unsigned* st;
};

__device__ __forceinline__ XcdBarrier xcd_barrier_post(unsigned* bar, volatile LAS unsigned* st) {
    XcdBarrier b; b.bar = bar; b.x = xb_xcc_id(); b.st = st;
    if (threadIdx.x == 0) (void)xb_add(&bar[XB_XCNT(b.x)], 1u);
    return b;
}
__device__ __forceinline__ void xcd_barrier_complete(unsigned* bar, unsigned x, unsigned& nloc, unsigned& nx) {
    const unsigned G = gridDim.x * gridDim.y * gridDim.z;
    unsigned sum, cnt, mine, sp = 0u;
    for (;;) {
        sum = 0u; cnt = 0u; mine = 0u;
#pragma unroll
        for (unsigned j = 0; j < 16; ++j) { const unsigned c = xb_ld(&bar[XB_XCNT(j)]); sum += c; cnt += (c > 0u) ? 1u : 0u; mine = (j == x) ? c : mine; }
        if (sum == G) break;
        __builtin_amdgcn_s_sleep(1);
        if ((++sp & 255u) == 0u) { if (xb_ld(&bar[XB_TMO])) break; if (sp > XB_SPIN_CAP) { atomicAdd(&bar[XB_TMO], 1u); break; } }
    }
    nloc = mine > 0u ? mine : 1u; nx = cnt > 0u ? cnt : 1u;
}

__device__ __forceinline__ void xcd_barrier(const XcdBarrier& b) {
    asm volatile("s_waitcnt vmcnt(0)" ::: "memory");
    __syncthreads();
    if (threadIdx.x == 0) {
        unsigned* bar = b.bar;
        __builtin_amdgcn_s_waitcnt(0);
        unsigned nloc = b.st[0], nx = b.st[1];
        if (nloc == 0u) { xcd_barrier_complete(bar, b.x, nloc, nx); b.st[0] = nloc; b.st[1] = nx; }
        const unsigned old = xb_add(&bar[XB_XSUB(b.x)], 1u);
        const unsigned gen = old / nloc;
        if (old + 1u == (gen + 1u) * nloc) {
            __builtin_amdgcn_fence(__ATOMIC_RELEASE, "agent");
            asm volatile("s_waitcnt vmcnt(0)" ::: "memory");
            const unsigned og = xb_add(&bar[XB_TOP], 1u);
            const unsigned tg = og / nx;
            if (og + 1u == (tg + 1u) * nx) xb_add(&bar[XB_TOPGEN], 1u);
            else XB_SPIN(xb_ld(&bar[XB_TOPGEN]) == tg, bar);
            __builtin_amdgcn_fence(__ATOMIC_ACQUIRE, "agent");
            xb_add(&bar[XB_XGEN(b.x)], 1u);
            asm volatile("s_waitcnt vmcnt(0)" ::: "memory");
        } else {
            XB_SPIN(xb_ld(&bar[XB_XGEN(b.x)]) == gen, bar);
            __builtin_amdgcn_fence(__ATOMIC_ACQUIRE, "agent");
            asm volatile("s_waitcnt vmcnt(0)" ::: "memory");
        }
    }
    __syncthreads();
}
DI int map_col(int id, int n, int nvalid) {
    if (id == 0) return n;
    if (id == 1) { if (n < 1024) { if (n < 416) return 1040 + n; if (n < 928) return 2232 + (n - 416); return -1; }
        const int b = n - 1024; if (b < 1040) return b; if (b < 1816) return 1456 + (b - 1040); return -1; }
    if (id == 2) { const int pn = n >> 8, bj = (n >> 7) & 1, cc = n & 127; return bj * FF + pn * 128 + cc; }
    return n < nvalid ? n : -1;
}
DI void transpose_item(const float* W, int ldw, int Ksrc, int mapid, int nvalid, const float* kscale, bf16* WT, int Kd, int nblk, LAS float* scr, int item, int lane) {
    const int kb = item / nblk, nb = item % nblk, k0 = 64 * kb, n0 = 32 * nb;
    const int n4 = (lane & 7) * 4; const int sc = map_col(mapid, n0 + n4, nvalid);
    (void)kscale;
#pragma unroll
    for (int i = 0; i < 8; ++i) { const int kk = 8 * i + (lane >> 3), k = k0 + kk; f32x4 v = {0.f, 0.f, 0.f, 0.f};
        if (sc >= 0 && k < Ksrc) v = *(const f32x4*)(W + (size_t)k * ldw + sc);
        LAS float* d = scr + kk * 33 + n4; d[0] = v.x; d[1] = v.y; d[2] = v.z; d[3] = v.w; }
    asm volatile("s_waitcnt lgkmcnt(0)" ::: "memory");
    const int c = lane & 7;
#pragma unroll
    for (int j = 0; j < 4; ++j) { const int n = (lane >> 3) + 8 * j; const LAS float* s = scr + (8 * c) * 33 + n;
        u32x4 o; o.x = pk2(s[0 * 33], s[1 * 33]); o.y = pk2(s[2 * 33], s[3 * 33]); o.z = pk2(s[4 * 33], s[5 * 33]); o.w = pk2(s[6 * 33], s[7 * 33]);
        *(u32x4*)(WT + (size_t)(n0 + n) * Kd + k0 + 8 * c) = o; }
    asm volatile("s_waitcnt lgkmcnt(0)" ::: "memory");
}

struct Ctx {
    const float* const* in; float* out; unsigned char* ws; LAS unsigned char* lds; int tid, lane, wave, bid, G;
};

DI void phase_weights(const Ctx& C, int l, int mask, int bid, int G) {
    LAS float* scr = (LAS float*)(C.lds + C.wave * 16384);
    const int gw = bid * NWAVES + C.wave, NGW = G * NWAVES;
    constexpr int I_IN = 16 * 96, I_OUT = 16 * 32, I_GU = 16 * 176, I_DN = 44 * 32, I_Q = 4 * 16, I_KV = 4 * 16;
    constexpr int NIT = I_IN + I_OUT + I_GU + I_DN + I_Q + I_KV;
    unsigned char* ws = C.ws;
    for (int it = gw; it < NIT; it += NGW) { int r = it;
        { const int cls = it < I_IN ? 0 : (it < I_IN + I_OUT ? 2 : (it < I_IN + I_OUT + I_GU ? 3 : (it < I_IN + I_OUT + I_GU + I_DN ? 1 : 0))); if (!((mask >> cls) & 1)) continue; }
        if (r < I_IN) { transpose_item(C.in[14] + (size_t)l * 1024 * 2744, 2744, 1024, 1, 0, nullptr, (bf16*)(ws + WS_WIN), 1024, 96, scr, r, C.lane); continue; } r -= I_IN;
        if (r < I_OUT) { transpose_item(C.in[15] + (size_t)l * 1024 * 1024, 1024, 1024, 0, 0, nullptr, (bf16*)(ws + WS_WOUT), 1024, 32, scr, r, C.lane); continue; } r -= I_OUT;
        if (r < I_GU) { transpose_item(C.in[31] + (size_t)l * 1024 * 5632, 5632, 1024, 2, 0, nullptr, (bf16*)(ws + WS_WGU), 1024, 176, scr, r, C.lane); continue; } r -= I_GU;
        if (r < I_DN) { transpose_item(C.in[32] + (size_t)l * 2816 * 1024, 1024, 2816, 0, 0, nullptr, (bf16*)(ws + WS_WDN), 2816, 32, scr, r, C.lane); continue; } r -= I_DN;
        if (r < I_Q) { transpose_item(C.in[21] + (size_t)l * 256 * 384, 384, 256, 3, 384, nullptr, (bf16*)(ws + WS_WUQ), 256, 16, scr, r, C.lane); continue; } r -= I_Q;
        transpose_item(C.in[23] + (size_t)l * 128 * 512, 512, 128, 3, 512, nullptr, (bf16*)(ws + WS_WUKV), 256, 16, scr, r, C.lane);
    }
    if (!(mask & 1)) return;
    const int gt = bid * NTHR + C.tid, NGT = G * NTHR;
    bf16* ckvc = (bf16*)(ws + WS_CKV16) + (size_t)T * 256; bf16* kpec = (bf16*)(ws + WS_KPEC); bf16* skc = (bf16*)(ws + WS_SWAKC); bf16* svc = (bf16*)(ws + WS_SWAVC);
    for (int i = gt; i < 1024 * 256; i += NGT) { const int row = i >> 8, c = i & 255, b = row >> 8, t = row & 255;
        ckvc[i] = c < 128 ? (bf16)f2bf(C.in[4][((size_t)(b * 2 + l) * 256 + t) * 128 + c]) : (bf16)0; }
    for (int i = gt; i < 1024 * 32; i += NGT) { const int row = i >> 5, c = i & 31, b = row >> 8, t = row & 255; kpec[i] = (bf16)f2bf(C.in[5][((size_t)(b * 2 + l) * 256 + t) * 32 + c]); }
    for (int i = gt; i < 1024 * 128; i += NGT) { const int row = i >> 7, c = i & 127, b = row >> 8, t = row & 255; const size_t s = ((size_t)(b * 2 + l) * 256 + t) * 128 + c;
        skc[i] = (bf16)f2bf(C.in[7][s]); svc[i] = (bf16)f2bf(C.in[8][s]); }
}

DI void phase_ada_rope(const Ctx& C) {
    LAS float* sc = (LAS float*)C.lds;
    LAS float* red = sc + 5 * 1024;
    for (int i = C.tid; i < 5 * 1024; i += NTHR) { const int r = i >> 10, k = i & 1023; const float v = r == 0 ? C.in[9][k] : C.in[2][(r - 1) * 1024 + k]; sc[i] = siluf(v); }
    __syncthreads();
    float* ada = (float*)(C.ws + WS_ADA);
    for (int it = C.bid; it < 192; it += C.G) { const int l = it / 96, n = (it % 96) * 64 + C.lane;
        const float* w = C.in[12] + (size_t)l * 1024 * 6144 + n; float a[5] = {0.f, 0.f, 0.f, 0.f, 0.f};
#pragma unroll 4
        for (int kk = 0; kk < 128; ++kk) { const int k = C.wave * 128 + kk; const float wv = w[(size_t)k * 6144];
#pragma unroll
            for (int r = 0; r < 5; ++r) a[r] += sc[r * 1024 + k] * wv; }
#pragma unroll
        for (int r = 0; r < 5; ++r) red[(C.wave * 5 + r) * 64 + C.lane] = a[r];
        __syncthreads();
        if (C.tid < 320) { const int r = C.tid >> 6, ln = C.tid & 63; float s = 0.f;
#pragma unroll
            for (int w8 = 0; w8 < 8; ++w8) s += red[(w8 * 5 + r) * 64 + ln];
            const int nn = (it % 96) * 64 + ln; ada[((size_t)l * 5 + r) * 6144 + nn] = s + C.in[13][l * 6144 + nn]; }
        __syncthreads();
    }
    float* rt = (float*)(C.ws + WS_ROPE);
    const int gt = C.bid * NTHR + C.tid, NGT = C.G * NTHR;
    for (int i = gt; i < 4096 * 16; i += NGT) { const int t = i >> 4, j = i & 15; const float pos = (float)(j < 8 ? (t >> 6) : (t & 63)); const int f = j & 7;
        const float inv = powf(10000.f, -(float)f / 8.f); const float ang = pos * inv; rt[i] = cosf(ang); rt[65536 + i] = sinf(ang); }
    for (int i = gt; i < 4096 * 32; i += NGT) { const int t = i >> 5, j = i & 31; const float pos = (float)(j < 16 ? (t >> 6) : (t & 63)); const int f = j & 15;
        const float inv = powf(10000.f, -(float)f / 16.f); const float ang = pos * inv; rt[131072 + i] = cosf(ang); rt[262144 + i] = sinf(ang); }
}

DI void phase_norm(const Ctx& C, const float* src_c, const float* src_l, const float* nw, const float* ada, int which, bf16* dst) {
    const int gw = C.bid * NWAVES + C.wave, NGW = C.G * NWAVES;
    for (int row0 = gw; row0 < T; row0 += 4 * NGW) {
        f32x4 v[4][4]; float s[4]; const float* shp[4]; int rows[4]; bool ok[4];
#pragma unroll
        for (int u = 0; u < 4; ++u) { const int row = row0 + u * NGW; rows[u] = row; ok[u] = row < T; const int rr = ok[u] ? row : row0;
            const float* x = rr < TC ? src_c + (size_t)rr * D : src_l + (size_t)(rr - TC) * D;
            const int r = rr < TC ? 0 : 1 + ((rr - TC) >> 12); shp[u] = ada + (size_t)r * 6144 + which * 3072; s[u] = 0.f;
#pragma unroll
            for (int j = 0; j < 4; ++j) { v[u][j] = *(const f32x4*)(x + 256 * j + 4 * C.lane); s[u] += v[u][j].x * v[u][j].x + v[u][j].y * v[u][j].y + v[u][j].z * v[u][j].z + v[u][j].w * v[u][j].w; } }
#pragma unroll
        for (int u = 0; u < 4; ++u) { const float rstd = rsqrtf(wave_sum(s[u]) * (1.f / D) + EPS); const float* sh = shp[u]; const float* scl = sh + 1024;
            if (ok[u]) {
#pragma unroll
                for (int j = 0; j < 4; ++j) { const int c = 256 * j + 4 * C.lane; const f32x4 w = *(const f32x4*)(nw + c), a = *(const f32x4*)(scl + c), b = *(const f32x4*)(sh + c);
                    const f32x4 y = v[u][j] * rstd * w * (a + 1.f) + b; u32x2 o; o.x = pk2(y.x, y.y); o.y = pk2(y.z, y.w); *(u32x2*)(dst + (size_t)rows[u] * D + c) = o; } } }
    }
}
DI void phase_final_norm(const Ctx& C, const float* nw) {
    const int gw = C.bid * NWAVES + C.wave, NGW = C.G * NWAVES;
    for (int row0 = gw; row0 < T; row0 += 4 * NGW) {
        f32x4 v[4][4]; float s[4];
#pragma unroll
        for (int u = 0; u < 4; ++u) { const int row = row0 + u * NGW; const float* x = C.out + (size_t)(row < T ? row : row0) * D; s[u] = 0.f;
#pragma unroll
            for (int j = 0; j < 4; ++j) { v[u][j] = *(const f32x4*)(x + 256 * j + 4 * C.lane); s[u] += v[u][j].x * v[u][j].x + v[u][j].y * v[u][j].y + v[u][j].z * v[u][j].z + v[u][j].w * v[u][j].w; } }
#pragma unroll
        for (int u = 0; u < 4; ++u) { const int row = row0 + u * NGW; const float rstd = rsqrtf(wave_sum(s[u]) * (1.f / D) + EPS);
            if (row < T) { float* x = C.out + (size_t)row * D;
#pragma unroll
                for (int j = 0; j < 4; ++j) { const int c = 256 * j + 4 * C.lane; *(f32x4*)(x + c) = v[u][j] * rstd * *(const f32x4*)(nw + c); } } }
    }
}
DI void phase_mla_prep(const Ctx& C, int l) {
    const int gw = C.bid * NWAVES + C.wave, NGW = C.G * NWAVES;
    const bf16* pA = (const bf16*)(C.ws + WS_PA); bf16* qn = (bf16*)(C.ws + WS_QN16); bf16* ckv = (bf16*)(C.ws + WS_CKV16);
    const float* wq = C.in[20] + l * 256; const float* wkv = C.in[22] + l * 128; const float* rt = (const float*)(C.ws + WS_ROPE);
    for (int row0 = gw; row0 < T; row0 += 2 * NGW) {
        unsigned qa[2], qb[2]; float ka[2], kb[2]; float* op[2]; unsigned kpe1[2], kpe2[2], sk1[2], sk2[2];
#pragma unroll
        for (int u = 0; u < 2; ++u) { const int row = row0 + u * NGW; const bf16* p = pA + (size_t)row * NA;
            const unsigned* pq = (const unsigned*)p + 2 * C.lane; qa[u] = pq[0]; qb[u] = pq[1]; op[u] = nullptr; kpe1[u] = kpe2[u] = sk1[u] = sk2[u] = 0u;
            if (row < TC) { float* o = C.out + O_CKV + ((size_t)((row >> 8) * 2 + l) * 256 + (row & 255)) * 128; op[u] = o; ka[u] = o[2 * C.lane]; kb[u] = o[2 * C.lane + 1]; }
            else { const unsigned vv = ((const unsigned*)(p + 256))[C.lane]; ka[u] = bflo(vv); kb[u] = bfhi(vv);
                const int i16 = C.lane & 15, kvh = C.lane >> 5, i32 = C.lane & 31;
                kpe1[u] = p[384 + i16]; kpe2[u] = p[400 + i16]; sk1[u] = p[672 + kvh * 64 + i32]; sk2[u] = p[672 + kvh * 64 + 32 + i32]; } }
#pragma unroll
        for (int u = 0; u < 2; ++u) { const int row = row0 + u * NGW;
            { const float x0 = bflo(qa[u]), x1 = bfhi(qa[u]), x2 = bflo(qb[u]), x3 = bfhi(qb[u]);
              const float r = rsqrtf(wave_sum(x0 * x0 + x1 * x1 + x2 * x2 + x3 * x3) * (1.f / 256) + EPS); const f32x4 w = *(const f32x4*)(wq + 4 * C.lane);
              u32x2 o; o.x = pk2(x0 * r * w.x, x1 * r * w.y); o.y = pk2(x2 * r * w.z, x3 * r * w.w); *(u32x2*)(qn + (size_t)row * 256 + 4 * C.lane) = o; }
            const float r = rsqrtf(wave_sum(ka[u] * ka[u] + kb[u] * kb[u]) * (1.f / 128) + EPS); const float a = ka[u] * r * wkv[2 * C.lane], b = kb[u] * r * wkv[2 * C.lane + 1];
            if (op[u]) { op[u][2 * C.lane] = a; op[u][2 * C.lane + 1] = b; }
            unsigned* co = (unsigned*)(ckv + (size_t)row * 256); co[C.lane] = pk2(a, b); co[64 + C.lane] = 0u;
            if (row >= TC) { const int lr = row - TC, t = lr & 4095;
                bf16* kper = (bf16*)(C.ws + WS_KPER) + (size_t)lr * 32; bf16* ksr = (bf16*)(C.ws + WS_KSR) + (size_t)lr * 128;
                if (C.lane < 16) { const int i = C.lane; const float x1 = bflo(kpe1[u]), x2 = bflo(kpe2[u]), c = rt[t * 16 + i], s = rt[65536 + t * 16 + i];
                    kper[i] = (bf16)f2bf(x1 * c - x2 * s); kper[16 + i] = (bf16)f2bf(x1 * s + x2 * c); }
                { const int kvh = C.lane >> 5, i = C.lane & 31; const float x1 = bflo(sk1[u]), x2 = bflo(sk2[u]), c = rt[131072 + t * 32 + i], s = rt[262144 + t * 32 + i];
                    ksr[kvh * 64 + i] = (bf16)f2bf(x1 * c - x2 * s); ksr[kvh * 64 + 32 + i] = (bf16)f2bf(x1 * s + x2 * c); } }
        }
    }
}
DI void mm64(f32x4& c0, f32x4& c1, const LAS float* A, int sai, int sak, const LAS float* B, int sbk, int sbj, int wave, int lane) {
    const int r = lane & 15, q = lane >> 4, tr = wave >> 1, tc = (wave & 1) * 2;
    const LAS float* ap = A + (tr * 16 + r) * sai + q * sak;
    const LAS float* bp = B + q * sbk + (tc * 16 + r) * sbj;
#pragma unroll
    for (int s0 = 0; s0 < 16; s0 += 8) { float av[8], b0v[8], b1v[8];
#pragma unroll
        for (int s = 0; s < 8; ++s) { av[s] = ap[4 * (s0 + s) * sak]; b0v[s] = bp[4 * (s0 + s) * sbk]; b1v[s] = bp[4 * (s0 + s) * sbk + 16 * sbj]; }
        __builtin_amdgcn_sched_barrier(0);
#pragma unroll
        for (int s = 0; s < 8; ++s) { c0 = __builtin_amdgcn_mfma_f32_16x16x4f32(av[s], b0v[s], c0, 0, 0, 0); c1 = __builtin_amdgcn_mfma_f32_16x16x4f32(av[s], b1v[s], c1, 0, 0, 0); } }
}
DI void lds_sync() { asm volatile("s_waitcnt lgkmcnt(0)" ::: "memory"); __builtin_amdgcn_s_barrier(); asm volatile("" ::: "memory"); }
constexpr int BS = 72;
constexpr int BTB = 64 * BS * 2;
DI void mmb(f32x4& c0, f32x4& c1, const LAS bf16* A, const LAS bf16* B, int wave, int lane) {
    const int r = lane & 15, q = lane >> 4, tr = wave >> 1, tc = (wave & 1) * 2;
    const LAS bf16* ap = A + (tr * 16 + r) * BS + q * 8; const LAS bf16* bp = B + (tc * 16 + r) * BS + q * 8;
#pragma unroll
    for (int ks = 0; ks < 2; ++ks) {
        const bf16x8 a = *(const LAS bf16x8*)(ap + ks * 32), b0 = *(const LAS bf16x8*)(bp + ks * 32), b1 = *(const LAS bf16x8*)(bp + 16 * BS + ks * 32);
        c0 = __builtin_amdgcn_mfma_f32_16x16x32_bf16(a, b0, c0, 0, 0, 0);
        c1 = __builtin_amdgcn_mfma_f32_16x16x32_bf16(a, b1, c1, 0, 0, 0);
    }
}
#define MM_EPI(c0, c1, body) do { const int r_ = C.lane & 15, q_ = C.lane >> 4, tr_ = C.wave >> 1, tc_ = (C.wave & 1) * 2; \
    _Pragma("unroll") for (int j_ = 0; j_ < 4; ++j_) { const int row = tr_ * 16 + q_ * 4 + j_; { const int col = tc_ * 16 + r_; const float val = c0[j_]; body } { const int col = tc_ * 16 + 16 + r_; const float val = c1[j_]; body } } } while (0)
constexpr int FS = 68;
constexpr int FTB = 18432;
constexpr int LS = 68;
constexpr f32x4 Z4 = {0.f, 0.f, 0.f, 0.f};
DI bf16 tobf(float x) { return (bf16)f2bf(x); }

DI void tri_solve_blocked(const Ctx& C, const LAS float* As, LAS float* Us, LAS float* Ws, LAS float* Dv, LAS bf16* Wb) {
    if (C.wave == 0) { const int b = C.lane >> 4, c = C.lane & 15; float x[16];
#pragma unroll
        for (int i = 0; i < 16; ++i) { float v = (i == c) ? 1.f : 0.f;
#pragma unroll
            for (int j4 = 0; j4 < (i + 3) / 4; ++j4) { const f32x4 a = *(const LAS f32x4*)(As + (16 * b + i) * FS + 16 * b + 4 * j4);
                if (4 * j4 + 0 < i) v -= a.x * x[4 * j4 + 0];
                if (4 * j4 + 1 < i) v -= a.y * x[4 * j4 + 1];
                if (4 * j4 + 2 < i) v -= a.z * x[4 * j4 + 2];
                if (4 * j4 + 3 < i) v -= a.w * x[4 * j4 + 3]; }
            x[i] = v; Dv[(b * 16 + i) * 16 + c] = v; } }
    lds_sync();
    { LAS float* X = (C.wave < 4 ? Us : Ws) + (C.wave & 3) * 16; const int r = C.lane & 15, q = C.lane >> 4;
#pragma unroll
      for (int bi = 0; bi < 4; ++bi) {
          f32x4 c, c2 = Z4;
#pragma unroll
          for (int j = 0; j < 4; ++j) c[j] = X[(16 * bi + 4 * q + j) * FS + r];
          if (bi > 0) { float av[12], bv[12];
#pragma unroll
              for (int s = 0; s < 4 * bi; ++s) { av[s] = -As[(16 * bi + r) * FS + 4 * s + q]; bv[s] = X[(4 * s + q) * FS + r]; }
              __builtin_amdgcn_sched_barrier(0);
#pragma unroll
              for (int s = 0; s < 4 * bi; s += 2) { c = __builtin_amdgcn_mfma_f32_16x16x4f32(av[s], bv[s], c, 0, 0, 0); c2 = __builtin_amdgcn_mfma_f32_16x16x4f32(av[s + 1], bv[s + 1], c2, 0, 0, 0); }
              c += c2;
#pragma unroll
              for (int j = 0; j < 4; ++j) X[(16 * bi + 4 * q + j) * FS + r] = c[j]; }
          f32x4 dd = Z4, d2 = Z4; float dv[4], xv[4];
#pragma unroll
          for (int s = 0; s < 4; ++s) { dv[s] = Dv[(bi * 16 + r) * 16 + 4 * s + q]; xv[s] = X[(16 * bi + 4 * s + q) * FS + r]; }
          __builtin_amdgcn_sched_barrier(0);
          dd = __builtin_amdgcn_mfma_f32_16x16x4f32(dv[0], xv[0], dd, 0, 0, 0); d2 = __builtin_amdgcn_mfma_f32_16x16x4f32(dv[1], xv[1], d2, 0, 0, 0);
          dd = __builtin_amdgcn_mfma_f32_16x16x4f32(dv[2], xv[2], dd, 0, 0, 0); d2 = __builtin_amdgcn_mfma_f32_16x16x4f32(dv[3], xv[3], d2, 0, 0, 0);
          dd += d2;
#pragma unroll
          for (int j = 0; j < 4; ++j) X[(16 * bi + 4 * q + j) * FS + r] = dd[j];
          if (Wb && C.wave >= 4) {
#pragma unroll
              for (int j = 0; j < 4; ++j) Wb[(16 * bi + 4 * q + j) * BS + (C.wave & 3) * 16 + r] = tobf(dd[j]); }
      } }
    lds_sync();
}
DI void wave_cumsum(const LAS float* src, LAS float* dst, int lane) {
    float v = src[lane];
#pragma unroll
    for (int o = 1; o < 64; o <<= 1) { const float t = __shfl_up(v, o); if (lane >= o) v += t; }
    dst[lane] = v;
}

DI void store_T8(LAS bf16* T, int c8, int i, int j, u32x4 w) {
    unsigned a0 = w.x, a1 = w.y, a2 = w.z, a3 = w.w;
    { const bool on = (j & 1) != 0; const unsigned b0 = __builtin_amdgcn_alignbit(a1, a0, 16), b1 = __builtin_amdgcn_alignbit(a2, a1, 16), b2 = __builtin_amdgcn_alignbit(a3, a2, 16), b3 = __builtin_amdgcn_alignbit(a0, a3, 16);
      a0 = on ? b0 : a0; a1 = on ? b1 : a1; a2 = on ? b2 : a2; a3 = on ? b3 : a3; }
    { const bool on = (j & 2) != 0; const unsigned b0 = a1, b1 = a2, b2 = a3, b3 = a0; a0 = on ? b0 : a0; a1 = on ? b1 : a1; a2 = on ? b2 : a2; a3 = on ? b3 : a3; }
    { const bool on = (j & 4) != 0; const unsigned b0 = a2, b1 = a3, b2 = a0, b3 = a1; a0 = on ? b0 : a0; a1 = on ? b1 : a1; a2 = on ? b2 : a2; a3 = on ? b3 : a3; }
    LAS bf16* t = T + i;
    t[(c8 + ((0 + j) & 7)) * BS] = (bf16)(a0 & 0xffffu); t[(c8 + ((1 + j) & 7)) * BS] = (bf16)(a0 >> 16);
    t[(c8 + ((2 + j) & 7)) * BS] = (bf16)(a1 & 0xffffu); t[(c8 + ((3 + j) & 7)) * BS] = (bf16)(a1 >> 16);
    t[(c8 + ((4 + j) & 7)) * BS] = (bf16)(a2 & 0xffffu); t[(c8 + ((5 + j) & 7)) * BS] = (bf16)(a2 >> 16);
    t[(c8 + ((6 + j) & 7)) * BS] = (bf16)(a3 & 0xffffu); t[(c8 + ((7 + j) & 7)) * BS] = (bf16)(a3 >> 16);
}
struct DnLds { LAS float *As, *Us, *Ws, *Ss, *gc, *bt, *gr, *Dv; LAS bf16 *Kb, *KT, *Qb, *StT, *QKb, *Wb, *VnT, *VnsT, *oacc; LAS float *Mt, *Nt, *Mc, *Nc; LAS bf16 *WfT, *UfT; };
DI DnLds dn_lds3(LAS unsigned char* l) { DnLds L{};
    L.As = (LAS float*)l; L.Us = (LAS float*)(l + FTB); L.Ws = (LAS float*)(l + 2 * FTB); L.Ss = (LAS float*)(l + 3 * FTB);
    LAS unsigned char* b = l + 4 * FTB; L.Kb = (LAS bf16*)b; L.KT = (LAS bf16*)(b + BTB); L.Qb = (LAS bf16*)(b + 2 * BTB); L.StT = (LAS bf16*)(b + 3 * BTB); L.Wb = (LAS bf16*)(b + 4 * BTB);
    L.gc = (LAS float*)(b + 5 * BTB); L.bt = L.gc + 64; L.gr = L.bt + 64; L.Dv = (LAS float*)(b + 5 * BTB + 768);
    L.QKb = (LAS bf16*)l; L.VnT = (LAS bf16*)(l + 2 * FTB); L.VnsT = (LAS bf16*)(l + 2 * FTB + BTB); return L; }
DI DnLds dn_lds1(LAS unsigned char* l) { DnLds L{};
    L.As = (LAS float*)l; L.Us = (LAS float*)(l + FTB); L.Ws = (LAS float*)(l + 2 * FTB);
    LAS unsigned char* m = l + 3 * FTB; L.Mt = (LAS float*)m; L.Nt = (LAS float*)(m + 17408);
    LAS unsigned char* b = m + 2 * 17408; L.Kb = (LAS bf16*)b; L.KT = (LAS bf16*)(b + BTB); L.Wb = (LAS bf16*)(b + 2 * BTB); L.StT = (LAS bf16*)(b + 3 * BTB); L.Qb = (LAS bf16*)(b + 4 * BTB);
    L.gc = (LAS float*)(b + 5 * BTB); L.bt = L.gc + 64; L.gr = L.bt + 64; L.Dv = (LAS float*)(b + 5 * BTB + 768);
    L.VnT = (LAS bf16*)(l + 2 * FTB); L.VnsT = (LAS bf16*)(l + 2 * FTB + BTB); return L; }

struct DnRaw { u32x4 r[3][3]; float wa, wb, wc; float sb, sa; };
DI DnRaw dn_fetch(const Ctx& C, const bf16* pB, const float* side, int row0, int seq_len, int t0, int rev, int h, int d, bool wantq) {
    DnRaw R; const int i = C.tid >> 3, c8 = (C.tid & 7) * 8; const int t = rev ? (t0 + 63 - i) : (t0 + i);
#pragma unroll
    for (int dd = 0; dd < 3; ++dd) { const int tt = t + dd - 1; const int tc = tt < 0 ? 0 : (tt >= seq_len ? seq_len - 1 : tt); { const float wv_ = (tt == tc) ? 1.f : 0.f; if (dd == 0) R.wa = wv_; else if (dd == 1) R.wb = wv_; else R.wc = wv_; }
        const bf16* rp = pB + (size_t)(row0 + tc) * NB + h * 64 + c8;
        R.r[0][dd] = wantq ? *(const u32x4*)rp : (u32x4){0u, 0u, 0u, 0u}; R.r[1][dd] = *(const u32x4*)(rp + 256); R.r[2][dd] = *(const u32x4*)(rp + 512); }
    R.sb = 0.f; R.sa = 0.f;
    if (C.wave == 0) { const int tw = rev ? (t0 + 63 - C.lane) : (t0 + C.lane); const float* s = side + (size_t)(row0 + tw) * 24; R.sb = s[d * 4 + h]; R.sa = s[8 + d * 4 + h]; }
    return R;
}
constexpr int CW_OFF = 143360;
DI void dn_stage_cw(const Ctx& C, const float* convw, int h) { LAS float* cw = (LAS float*)(C.lds + CW_OFF);
    for (int i = C.tid; i < 576; i += NTHR) { const int dw = i >> 6, c = i & 63, dd = dw / 3, which = dw - dd * 3; cw[i] = convw[dd * 768 + which * 256 + h * 64 + c]; } }
DI void dn_consume(const Ctx& C, const DnLds& L, const DnRaw& R, float a_neg, float dtb, int h, bool wantq) {
    const LAS float* cw = (const LAS float*)(C.lds + CW_OFF);
    const int i = C.tid >> 3, c8 = (C.tid & 7) * 8;
#pragma unroll
    for (int which = 0; which < 3; ++which) {
        if (which == 0 && !wantq) continue;
        const int col = which * 256 + h * 64 + c8; float acc[8];
#pragma unroll
        for (int e = 0; e < 8; ++e) acc[e] = 0.f;
#pragma unroll
        for (int dd = 0; dd < 3; ++dd) { float x[8]; unpack8(R.r[which][dd], x); const LAS float* w = cw + (dd * 3 + which) * 64 + c8;
            const float wzd = dd == 0 ? R.wa : (dd == 1 ? R.wb : R.wc); const f32x4 w0 = *(const LAS f32x4*)w * wzd, w1 = *(const LAS f32x4*)(w + 4) * wzd;
            acc[0] += w0.x * x[0]; acc[1] += w0.y * x[1]; acc[2] += w0.z * x[2]; acc[3] += w0.w * x[3]; acc[4] += w1.x * x[4]; acc[5] += w1.y * x[5]; acc[6] += w1.z * x[6]; acc[7] += w1.w * x[7]; }
        float ss = 0.f;
#pragma unroll
        for (int e = 0; e < 8; ++e) { acc[e] = fsilu(acc[e]); ss += acc[e] * acc[e]; }
        if (which < 2) { ss += __shfl_xor(ss, 1); ss += __shfl_xor(ss, 2); ss += __shfl_xor(ss, 4); const float rr = __builtin_amdgcn_rsqf(ss + EPS) * (which == 0 ? 0.125f : 1.f);
#pragma unroll
            for (int e = 0; e < 8; ++e) acc[e] *= rr; }
        if (which == 0) *(LAS u32x4*)(L.Qb + i * BS + c8) = pack8(acc);
        else if (which == 1) { *(LAS u32x4*)(L.Kb + i * BS + c8) = pack8(acc);
            store_T8(L.KT, c8, i, C.tid & 7, pack8(acc));
            LAS float* dst = L.Ws + i * FS + c8; *(LAS f32x4*)dst = (f32x4){acc[0], acc[1], acc[2], acc[3]}; *(LAS f32x4*)(dst + 4) = (f32x4){acc[4], acc[5], acc[6], acc[7]}; }
        else { LAS float* dst = L.Us + i * FS + c8; *(LAS f32x4*)dst = (f32x4){acc[0], acc[1], acc[2], acc[3]}; *(LAS f32x4*)(dst + 4) = (f32x4){acc[4], acc[5], acc[6], acc[7]}; }
    }
    if (C.wave == 0) { L.bt[C.lane] = __builtin_amdgcn_rcpf(1.f + __expf(-R.sb));
        float v = a_neg * fsoftplus(R.sa + dtb);
#pragma unroll
        for (int o = 1; o < 64; o <<= 1) { const float tt = __shfl_up(v, o); if (C.lane >= o) v += tt; }
        L.gc[C.lane] = v; }
}
DI void dn_prepare(const Ctx& C, const DnLds& L, LAS bf16* Wb) {
    lds_sync();
    { const int i = C.tid >> 3, c8 = (C.tid & 7) * 8; const float b = L.bt[i], be = b * __expf(L.gc[i]);
#pragma unroll
        for (int e = 0; e < 8; ++e) { L.Us[i * FS + c8 + e] *= b; L.Ws[i * FS + c8 + e] *= be; } }
    { f32x4 c0 = Z4, c1 = Z4; mmb(c0, c1, L.Kb, L.Kb, C.wave, C.lane);
      MM_EPI(c0, c1, { L.As[row * FS + col] = col < row ? val * L.bt[row] * __expf(L.gc[row] - L.gc[col]) : 0.f; }); }
    lds_sync();
    tri_solve_blocked(C, L.As, L.Us, L.Ws, L.Dv, Wb);
}
DI void dn_phase1_item(const Ctx& C, int l, int item) {
    const DnLds L = dn_lds1(C.lds);
    const int v = item >> 3, h = (item >> 1) & 3, d = item & 1, b = v >> 4, tsc = v & 15;
    const bf16* pB = (const bf16*)(C.ws + WS_PB); const float* side = (const float*)(C.ws + WS_SIDE);
    const float* convw = C.in[16] + (size_t)l * 3 * 768; const float a_neg = -expf(C.in[17][l * 8 + d * 4 + h]), dtb = C.in[18][l * 8 + d * 4 + h];
    const int row0 = TC + b * 4096;
    LAS bf16* MtT = L.StT; LAS bf16* NtT = L.Qb;
    { const int i = C.tid >> 3, c8 = (C.tid & 7) * 8;
#pragma unroll
        for (int e = 0; e < 8; ++e) { const float mv = (i == c8 + e) ? 1.f : 0.f; L.Mt[i * LS + c8 + e] = mv; L.Nt[i * LS + c8 + e] = 0.f; MtT[(c8 + e) * BS + i] = tobf(mv); NtT[(c8 + e) * BS + i] = 0; } }
    dn_stage_cw(C, convw, h);
    DnRaw R = dn_fetch(C, pB, side, row0, 4096, tsc * 256 + 64 * (d ? 3 : 0), d, h, d, false);
    lds_sync();
#pragma unroll 1
    for (int cc = 0; cc < 4; ++cc) {
        dn_consume(C, L, R, a_neg, dtb, h, false);
        if (cc < 3) R = dn_fetch(C, pB, side, row0, 4096, tsc * 256 + 64 * (d ? 2 - cc : cc + 1), d, h, d, false);
        dn_prepare(C, L, L.Wb);
        const float glast = L.gc[63];
        { f32x4 c0 = Z4, c1 = Z4; mmb(c0, c1, L.Wb, MtT, C.wave, C.lane);
          MM_EPI(c0, c1, { L.VnT[col * BS + row] = tobf(-val * __expf(glast - L.gc[row])); }); }
        { f32x4 c0 = Z4, c1 = Z4; mmb(c0, c1, L.Wb, NtT, C.wave, C.lane);
          MM_EPI(c0, c1, { L.VnsT[col * BS + row] = tobf((L.Us[row * FS + col] - val) * __expf(glast - L.gc[row])); }); }
        lds_sync();
        const float eg = __expf(glast);
        { f32x4 c0 = Z4, c1 = Z4; mmb(c0, c1, L.KT, L.VnT, C.wave, C.lane);
          MM_EPI(c0, c1, { const float mn_ = L.Mt[row * LS + col] * eg + val; L.Mt[row * LS + col] = mn_; MtT[col * BS + row] = tobf(mn_); }); }
        { f32x4 c0 = Z4, c1 = Z4; mmb(c0, c1, L.KT, L.VnsT, C.wave, C.lane);
          MM_EPI(c0, c1, { const float nn_ = L.Nt[row * LS + col] * eg + val; L.Nt[row * LS + col] = nn_; NtT[col * BS + row] = tobf(nn_); }); }
        lds_sync();
    }
    float* mn = (float*)(C.ws + WS_MN) + (size_t)item * 8192;
    { const int i = C.tid >> 3, c8 = (C.tid & 7) * 8;
#pragma unroll
        for (int e = 0; e < 8; ++e) { mn[i * 64 + c8 + e] = L.Mt[i * LS + c8 + e]; mn[4096 + i * 64 + c8 + e] = L.Nt[i * LS + c8 + e]; } }
    __syncthreads();
}
DI void dn_scan_unit(const Ctx& C, int l, int unit) {
    LAS float* Ml = (LAS float*)C.lds; LAS float* Sl = Ml + 64 * LS;
    const int chain = unit >> 2, e0 = (unit & 3) * 16, b = chain >> 3, h = (chain >> 1) & 3, d = chain & 1;
    const float* s0 = C.in[3] + ((size_t)((b * 2 + l) * 2 + d) * 4 + h) * 4096;
    const int a = C.tid >> 3, e2 = (C.tid & 7) * 2, c8 = (C.tid & 7) * 8;
    float* base = (float*)(C.ws + WS_MN);
    Sl[a * 16 + e2] = s0[a * 64 + e0 + e2]; Sl[a * 16 + e2 + 1] = s0[a * 64 + e0 + e2 + 1];
    f32x4 m0, m1; float n0, n1;
    { const int tsc = d ? 15 : 0; const float* mg = base + (size_t)(((b * 16 + tsc) * 8) + h * 2 + d) * 8192;
      m0 = *(const f32x4*)(mg + a * 64 + c8); m1 = *(const f32x4*)(mg + a * 64 + c8 + 4); n0 = mg[4096 + a * 64 + e0 + e2]; n1 = mg[4096 + a * 64 + e0 + e2 + 1]; }
#pragma unroll 1
    for (int k = 0; k < 16; ++k) {
        const int tsc = d ? 15 - k : k; float* ng = base + (size_t)(((b * 16 + tsc) * 8) + h * 2 + d) * 8192 + 4096;
        *(LAS f32x4*)(Ml + a * LS + c8) = m0; *(LAS f32x4*)(Ml + a * LS + c8 + 4) = m1;
        float acc0 = n0, acc1 = n1;
        lds_sync();
        if (k < 15) { const int t2 = d ? 14 - k : k + 1; const float* mg = base + (size_t)(((b * 16 + t2) * 8) + h * 2 + d) * 8192;
            m0 = *(const f32x4*)(mg + a * 64 + c8); m1 = *(const f32x4*)(mg + a * 64 + c8 + 4); n0 = mg[4096 + a * 64 + e0 + e2]; n1 = mg[4096 + a * 64 + e0 + e2 + 1]; }
#pragma unroll 8
        for (int bb = 0; bb < 64; ++bb) { const float m = Ml[a * LS + bb]; acc0 += m * Sl[bb * 16 + e2]; acc1 += m * Sl[bb * 16 + e2 + 1]; }
        ng[a * 64 + e0 + e2] = Sl[a * 16 + e2]; ng[a * 64 + e0 + e2 + 1] = Sl[a * 16 + e2 + 1];
        lds_sync();
        Sl[a * 16 + e2] = acc0; Sl[a * 16 + e2 + 1] = acc1;
        lds_sync();
    }
    __syncthreads();
}
DI void dn_phase3_item(const Ctx& C, int l, int item) {
    const DnLds L = dn_lds3(C.lds);
    const int u = item >> 2, h = item & 3; const bool lat = u >= 32;
    const int v = u - 32, b = lat ? (v >> 4) : u, tsc = lat ? (v & 15) : 0;
    const int row0 = lat ? TC + b * 4096 : u * 256, seq_len = lat ? 4096 : 256, tbase = tsc * 256;
    const bf16* pB = (const bf16*)(C.ws + WS_PB); const float* side = (const float*)(C.ws + WS_SIDE); bf16* mix = (bf16*)(C.ws + WS_MIX); bf16* of = (bf16*)(C.ws + WS_XN);
    const float* convw = C.in[16] + (size_t)l * 3 * 768; const float* dnw = C.in[19] + l * 64;
    dn_stage_cw(C, convw, h);
    lds_sync();
#pragma unroll 1
    for (int d = 0; d < 2; ++d) {
        const float a_neg = -expf(C.in[17][l * 8 + d * 4 + h]), dtb = C.in[18][l * 8 + d * 4 + h];
        DnRaw R = dn_fetch(C, pB, side, row0, seq_len, tbase + 64 * (d ? 3 : 0), d, h, d, true);
        { const int i = C.tid >> 3, c8 = (C.tid & 7) * 8; const float* sin_ = lat ? (const float*)(C.ws + WS_MN) + (size_t)((v * 8) + h * 2 + d) * 8192 + 4096 : nullptr;
#pragma unroll
            for (int e = 0; e < 8; ++e) { const float sv = lat ? sin_[i * 64 + c8 + e] : 0.f; L.Ss[i * FS + c8 + e] = sv; L.StT[(c8 + e) * BS + i] = tobf(sv); } }
#pragma unroll 1
        for (int cc = 0; cc < 4; ++cc) {
            const int cloc = d ? 3 - cc : cc, t0 = tbase + 64 * cloc;
            u32x4 zr = {0u, 0u, 0u, 0u}, fv = {0u, 0u, 0u, 0u};
            if (d == 1) { const int i = C.tid >> 3, c8 = (C.tid & 7) * 8; const size_t grow = (size_t)row0 + t0 + 63 - i; zr = *(const u32x4*)(pB + grow * NB + 768 + h * 64 + c8);
                const unsigned* fp = (const unsigned*)(of + grow * 256 + h * 64 + c8);
                fv.x = __hip_atomic_load(fp, __ATOMIC_RELAXED, __HIP_MEMORY_SCOPE_AGENT); fv.y = __hip_atomic_load(fp + 1, __ATOMIC_RELAXED, __HIP_MEMORY_SCOPE_AGENT);
                fv.z = __hip_atomic_load(fp + 2, __ATOMIC_RELAXED, __HIP_MEMORY_SCOPE_AGENT); fv.w = __hip_atomic_load(fp + 3, __ATOMIC_RELAXED, __HIP_MEMORY_SCOPE_AGENT); }
            dn_consume(C, L, R, a_neg, dtb, h, true);
            if (cc < 3) R = dn_fetch(C, pB, side, row0, seq_len, tbase + 64 * (d ? 2 - cc : cc + 1), d, h, d, true);
            dn_prepare(C, L, L.Wb);
            const float glast = L.gc[63];
            f32x4 o0 = Z4, o1 = Z4;
            { f32x4 c0 = Z4, c1 = Z4; mmb(c0, c1, L.Wb, L.StT, C.wave, C.lane);
              MM_EPI(c0, c1, { const float vn = L.Us[row * FS + col] - val; L.VnT[col * BS + row] = tobf(vn); L.VnsT[col * BS + row] = tobf(vn * __expf(glast - L.gc[row])); }); }
            { f32x4 c0 = Z4, c1 = Z4; mmb(c0, c1, L.Qb, L.Kb, C.wave, C.lane);
              MM_EPI(c0, c1, { L.QKb[row * BS + col] = tobf(col <= row ? val * __expf(L.gc[row] - L.gc[col]) : 0.f); }); }
            { mmb(o0, o1, L.Qb, L.StT, C.wave, C.lane); const int q_ = C.lane >> 4, tr_ = C.wave >> 1;
#pragma unroll
              for (int j = 0; j < 4; ++j) { const float f = __expf(L.gc[tr_ * 16 + q_ * 4 + j]); o0[j] *= f; o1[j] *= f; } }
            lds_sync();
            { mmb(o0, o1, L.QKb, L.VnT, C.wave, C.lane);
              MM_EPI(o0, o1, { L.Us[row * FS + col] = val; }); }
            { f32x4 c0 = Z4, c1 = Z4; mmb(c0, c1, L.KT, L.VnsT, C.wave, C.lane); const float eg = __expf(glast);
              MM_EPI(c0, c1, { const float sn = L.Ss[row * FS + col] * eg + val; L.Ss[row * FS + col] = sn; L.StT[col * BS + row] = tobf(sn); }); }
            lds_sync();
            { const int i = C.tid >> 3, c8 = (C.tid & 7) * 8; float o[8];
#pragma unroll
              for (int e = 0; e < 8; ++e) o[e] = L.Us[i * FS + c8 + e];
              if (d == 0) { const size_t grow = (size_t)row0 + t0 + i; *(u32x4*)(of + grow * 256 + h * 64 + c8) = pack8(o); }
              else { const size_t grow = (size_t)row0 + t0 + 63 - i;
                  float f8[8]; unpack8(fv, f8); float ss = 0.f;
#pragma unroll
                  for (int e = 0; e < 8; ++e) { o[e] += f8[e]; ss += o[e] * o[e]; }
                  ss += __shfl_xor(ss, 1); ss += __shfl_xor(ss, 2); ss += __shfl_xor(ss, 4);
                  const float rstd = rsqrtf(ss * (1.f / 64) + EPS);
                  float z[8]; unpack8(zr, z);
#pragma unroll
                  for (int e = 0; e < 8; ++e) o[e] = o[e] * rstd * dnw[c8 + e] * fsilu(z[e]);
                  *(u32x4*)(mix + grow * D + h * 64 + c8) = pack8(o); } }
        }
        if (!lat) { float* o = C.out + O_SDN + ((size_t)((u * 2 + l) * 2 + d) * 4 + h) * 4096; const int i = C.tid >> 3, c8 = (C.tid & 7) * 8;
#pragma unroll
            for (int e = 0; e < 8; ++e) o[i * 64 + c8 + e] = L.Ss[i * FS + c8 + e]; }
        __syncthreads();
    }
}
struct SsLds { LAS float *Xs, *Hs, *ac, *dts, *gr; LAS bf16 *Cb, *Bb, *BT, *XT, *XfT, *Hb, *Scb, *Hb2; };
DI SsLds ss_lds(LAS unsigned char* l) { SsLds L; L.Xs = (LAS float*)l; L.Hs = (LAS float*)(l + FTB); LAS unsigned char* b = l + 2 * FTB;
    L.Cb = (LAS bf16*)b; L.Bb = (LAS bf16*)(b + BTB); L.BT = (LAS bf16*)(b + 2 * BTB); L.XT = (LAS bf16*)(b + 3 * BTB); L.XfT = (LAS bf16*)(b + 4 * BTB); L.Hb = (LAS bf16*)(b + 5 * BTB); L.Scb = (LAS bf16*)(b + 6 * BTB);
    L.Hb2 = (LAS bf16*)(b + 7 * BTB); L.ac = (LAS float*)(b + 8 * BTB); L.dts = L.ac + 64; L.gr = L.dts + 64; return L; }
struct SsRaw { u32x4 r[3][3]; float wa, wb, wc; float sd; };
DI SsRaw ss_fetch(const Ctx& C, const bf16* pB, const float* side, int row0, int seq_len, int t0, int rev, int h, int d, bool wantc) {
    SsRaw R; const int i = C.tid >> 3, c8 = (C.tid & 7) * 8; const int t = rev ? (t0 + 63 - i) : (t0 + i); const int g = h >> 1;
#pragma unroll
    for (int dd = 0; dd < 3; ++dd) { const int tt = t + dd - 1; const int tc = tt < 0 ? 0 : (tt >= seq_len ? seq_len - 1 : tt); { const float wv_ = (tt == tc) ? 1.f : 0.f; if (dd == 0) R.wa = wv_; else if (dd == 1) R.wb = wv_; else R.wc = wv_; }
        const bf16* rp = pB + (size_t)(row0 + tc) * NB + 1296 + c8;
        R.r[0][dd] = *(const u32x4*)(rp + h * 64); R.r[1][dd] = *(const u32x4*)(rp + 256 + g * 64); R.r[2][dd] = wantc ? *(const u32x4*)(rp + 384 + g * 64) : (u32x4){0u, 0u, 0u, 0u}; }
    R.sd = 0.f;
    if (C.wave == 0) { const int tw = rev ? (t0 + 63 - C.lane) : (t0 + C.lane); R.sd = side[(size_t)(row0 + tw) * 24 + 16 + d * 4 + h]; }
    return R;
}
DI void ss_stage_cw(const Ctx& C, const float* convw, const float* convb, int h) { LAS float* cw = (LAS float*)(C.lds + CW_OFF); const int g = h >> 1;
    for (int i = C.tid; i < 768; i += NTHR) { const int j = i < 576 ? i : i - 576, dw = j >> 6, c = j & 63, dd = dw / 3, which = i < 576 ? dw - dd * 3 : dw;
        const int ch = (which == 0 ? h * 64 : which == 1 ? 256 + g * 64 : 384 + g * 64) + c; cw[i] = i < 576 ? convw[dd * 512 + ch] : convb[ch]; } }
DI void ss_consume(const Ctx& C, const SsLds& L, const SsRaw& R, float a_neg, float dtb, int h, bool wantc) {
    const LAS float* cw = (const LAS float*)(C.lds + CW_OFF);
    const int i = C.tid >> 3, c8 = (C.tid & 7) * 8; const int g = h >> 1;
#pragma unroll
    for (int which = 0; which < 3; ++which) {
        if (which == 2 && !wantc) continue;
        const int ch = (which == 0 ? h * 64 : which == 1 ? 256 + g * 64 : 384 + g * 64) + c8; float acc[8];
        { const f32x4 b0 = *(const LAS f32x4*)(cw + 576 + which * 64 + c8), b1 = *(const LAS f32x4*)(cw + 576 + which * 64 + c8 + 4); acc[0] = b0.x; acc[1] = b0.y; acc[2] = b0.z; acc[3] = b0.w; acc[4] = b1.x; acc[5] = b1.y; acc[6] = b1.z; acc[7] = b1.w; }
#pragma unroll
        for (int dd = 0; dd < 3; ++dd) { float x[8]; unpack8(R.r[which][dd], x); const LAS float* w = cw + (dd * 3 + which) * 64 + c8;
            const float wzd = dd == 0 ? R.wa : (dd == 1 ? R.wb : R.wc); const f32x4 w0 = *(const LAS f32x4*)w * wzd, w1 = *(const LAS f32x4*)(w + 4) * wzd;
            acc[0] += w0.x * x[0]; acc[1] += w0.y * x[1]; acc[2] += w0.z * x[2]; acc[3] += w0.w * x[3]; acc[4] += w1.x * x[4]; acc[5] += w1.y * x[5]; acc[6] += w1.z * x[6]; acc[7] += w1.w * x[7]; }
#pragma unroll
        for (int e = 0; e < 8; ++e) acc[e] = fsilu(acc[e]);
        if (which == 0) { LAS float* dst = L.Xs + i * FS + c8; *(LAS f32x4*)dst = (f32x4){acc[0], acc[1], acc[2], acc[3]}; *(LAS f32x4*)(dst + 4) = (f32x4){acc[4], acc[5], acc[6], acc[7]};
            store_T8(L.XT, c8, i, C.tid & 7, pack8(acc)); }
        else if (which == 1) { *(LAS u32x4*)(L.Bb + i * BS + c8) = pack8(acc);
            store_T8(L.BT, c8, i, C.tid & 7, pack8(acc)); }
        else *(LAS u32x4*)(L.Cb + i * BS + c8) = pack8(acc);
    }
    if (C.wave == 0) { const float dtv = fsoftplus(R.sd + dtb); L.dts[C.lane] = dtv;
        float v = a_neg * dtv;
#pragma unroll
        for (int o = 1; o < 64; o <<= 1) { const float tt = __shfl_up(v, o); if (C.lane >= o) v += tt; }
        L.ac[C.lane] = v; }
}
DI void ss_make_xf(const Ctx& C, const SsLds& L) {
    const int i = C.tid >> 3, c8 = (C.tid & 7) * 8; const float f = L.dts[i] * __expf(L.ac[63] - L.ac[i]);
    float xf[8];
#pragma unroll
    for (int e = 0; e < 8; ++e) xf[e] = L.Xs[i * FS + c8 + e] * f;
    store_T8(L.XfT, c8, i, C.tid & 7, pack8(xf));
}
DI void ss_phase1_item(const Ctx& C, int l, int item) {
    const SsLds L = ss_lds(C.lds);
    const int v = item >> 3, h = (item >> 1) & 3, d = item & 1, b = v >> 4, tsc = v & 15;
    const bf16* pB = (const bf16*)(C.ws + WS_PB); const float* side = (const float*)(C.ws + WS_SIDE);
    const float* convw = C.in[24] + (size_t)l * 3 * 512; const float* convb = C.in[25] + l * 512;
    const float a_neg = -expf(C.in[26][l * 8 + d * 4 + h]), dtb = C.in[27][l * 8 + d * 4 + h];
    const int row0 = TC + b * 4096;
    { const int i = C.tid >> 3, c8 = (C.tid & 7) * 8;
#pragma unroll
        for (int e = 0; e < 8; ++e) L.Hs[i * FS + c8 + e] = 0.f; }
    float dec = 0.f;
    ss_stage_cw(C, convw, convb, h);
    SsRaw R = ss_fetch(C, pB, side, row0, 4096, tsc * 256 + 64 * (d ? 3 : 0), d, h, d, false);
    lds_sync();
#pragma unroll 1
    for (int cc = 0; cc < 4; ++cc) {
        ss_consume(C, L, R, a_neg, dtb, h, false);
        if (cc < 3) R = ss_fetch(C, pB, side, row0, 4096, tsc * 256 + 64 * (d ? 2 - cc : cc + 1), d, h, d, false);
        lds_sync();
        const float alast = L.ac[63]; dec += alast;
        ss_make_xf(C, L);
        lds_sync();
        { f32x4 c0 = Z4, c1 = Z4; mmb(c0, c1, L.XfT, L.BT, C.wave, C.lane); const float eg = __expf(alast);
          MM_EPI(c0, c1, { L.Hs[row * FS + col] = L.Hs[row * FS + col] * eg + val; }); }
        lds_sync();
    }
    float* cs = (float*)(C.ws + WS_CS) + (size_t)item * 4096;
    { const int i = C.tid >> 3, c8 = (C.tid & 7) * 8;
#pragma unroll
        for (int e = 0; e < 8; ++e) cs[i * 64 + c8 + e] = L.Hs[i * FS + c8 + e]; }
    if (C.tid == 0) ((float*)(C.ws + WS_CD))[item] = expf(dec);
    __syncthreads();
}
DI void ss_scan(const Ctx& C, int l) {
    const int gid = C.bid * NTHR + C.tid; if (gid >= 32 * 4096) return;
    const int chain = gid >> 12, e = gid & 4095, b = chain >> 3, h = (chain >> 1) & 3, d = chain & 1;
    float st = C.in[6][((size_t)((b * 2 + l) * 2 + d) * 4 + h) * 4096 + e];
    float* cs = (float*)(C.ws + WS_CS); const float* cd = (const float*)(C.ws + WS_CD);
    for (int k = 0; k < 16; ++k) { const int tsc = d ? 15 - k : k; const size_t slot = (size_t)((b * 16 + tsc) * 8) + h * 2 + d;
        const float c = cs[slot * 4096 + e]; cs[slot * 4096 + e] = st; st = st * cd[slot] + c; }
}
DI void ss_phase3_item(const Ctx& C, int l, int item) {
    const SsLds L = ss_lds(C.lds);
    const int u = item >> 2, h = item & 3; const bool lat = u >= 32;
    const int v = u - 32, b = lat ? (v >> 4) : u, tsc = lat ? (v & 15) : 0;
    const int row0 = lat ? TC + b * 4096 : u * 256, seq_len = lat ? 4096 : 256, tbase = tsc * 256;
    const bf16* pB = (const bf16*)(C.ws + WS_PB); const float* side = (const float*)(C.ws + WS_SIDE); bf16* mix = (bf16*)(C.ws + WS_MIX); float* ssq = (float*)(C.ws + WS_SSQ); bf16* yf = (bf16*)(C.ws + WS_XN) + (size_t)T * 256;
    const float* convw = C.in[24] + (size_t)l * 3 * 512; const float* convb = C.in[25] + l * 512; const float Dh = C.in[28][l * 4 + h];
    ss_stage_cw(C, convw, convb, h);
    lds_sync();
#pragma unroll 1
    for (int d = 0; d < 2; ++d) {
        const float a_neg = -expf(C.in[26][l * 8 + d * 4 + h]), dtb = C.in[27][l * 8 + d * 4 + h];
        SsRaw R = ss_fetch(C, pB, side, row0, seq_len, tbase + 64 * (d ? 3 : 0), d, h, d, true);
        { const int i = C.tid >> 3, c8 = (C.tid & 7) * 8; const float* sin_ = lat ? (const float*)(C.ws + WS_CS) + (size_t)((v * 8) + h * 2 + d) * 4096 : nullptr;
#pragma unroll
            for (int e = 0; e < 8; ++e) { const float sv = lat ? sin_[i * 64 + c8 + e] : 0.f; L.Hs[i * FS + c8 + e] = sv; L.Hb[i * BS + c8 + e] = tobf(sv); } }
#pragma unroll 1
        for (int cc = 0; cc < 4; ++cc) {
            LAS bf16* hb_cur = (cc & 1) ? L.Hb2 : L.Hb; LAS bf16* hb_nxt = (cc & 1) ? L.Hb : L.Hb2;
            const int cloc = d ? 3 - cc : cc, t0 = tbase + 64 * cloc;
            u32x4 zr = {0u, 0u, 0u, 0u}, fv = {0u, 0u, 0u, 0u};
            if (d == 1) { const int i = C.tid >> 3, c8 = (C.tid & 7) * 8; const size_t grow = (size_t)row0 + t0 + 63 - i; zr = *(const u32x4*)(pB + grow * NB + 1040 + h * 64 + c8);
                const unsigned* fp = (const unsigned*)(yf + grow * 256 + h * 64 + c8);
                fv.x = __hip_atomic_load(fp, __ATOMIC_RELAXED, __HIP_MEMORY_SCOPE_AGENT); fv.y = __hip_atomic_load(fp + 1, __ATOMIC_RELAXED, __HIP_MEMORY_SCOPE_AGENT);
                fv.z = __hip_atomic_load(fp + 2, __ATOMIC_RELAXED, __HIP_MEMORY_SCOPE_AGENT); fv.w = __hip_atomic_load(fp + 3, __ATOMIC_RELAXED, __HIP_MEMORY_SCOPE_AGENT); }
            ss_consume(C, L, R, a_neg, dtb, h, true);
            if (cc < 3) R = ss_fetch(C, pB, side, row0, seq_len, tbase + 64 * (d ? 2 - cc : cc + 1), d, h, d, true);
            lds_sync();
            const float alast = L.ac[63];
            ss_make_xf(C, L);
            { f32x4 c0 = Z4, c1 = Z4; mmb(c0, c1, L.Cb, L.Bb, C.wave, C.lane);
              MM_EPI(c0, c1, { L.Scb[row * BS + col] = tobf(col <= row ? val * __expf(L.ac[row] - L.ac[col]) * L.dts[col] : 0.f); }); }
            lds_sync();
            { f32x4 c0 = Z4, c1 = Z4; mmb(c0, c1, L.Cb, hb_cur, C.wave, C.lane);
              { const int q_ = C.lane >> 4, tr_ = C.wave >> 1;
#pragma unroll
                for (int j = 0; j < 4; ++j) { const float f = __expf(L.ac[tr_ * 16 + q_ * 4 + j]); c0[j] *= f; c1[j] *= f; } }
              mmb(c0, c1, L.Scb, L.XT, C.wave, C.lane);
              MM_EPI(c0, c1, { L.Xs[row * FS + col] = d == 0 ? val + Dh * L.Xs[row * FS + col] : val; }); }
            { f32x4 c0 = Z4, c1 = Z4; mmb(c0, c1, L.XfT, L.BT, C.wave, C.lane); const float eg = __expf(alast);
              MM_EPI(c0, c1, { const float hn = L.Hs[row * FS + col] * eg + val; L.Hs[row * FS + col] = hn; hb_nxt[row * BS + col] = tobf(hn); }); }
            lds_sync();
            { const int i = C.tid >> 3, c8 = (C.tid & 7) * 8; float o[8];
#pragma unroll
              for (int e = 0; e < 8; ++e) o[e] = L.Xs[i * FS + c8 + e];
              if (d == 0) { const size_t grow = (size_t)row0 + t0 + i; *(u32x4*)(yf + grow * 256 + h * 64 + c8) = pack8(o); }
              else { const size_t grow = (size_t)row0 + t0 + 63 - i;
                  float f8[8], z[8]; unpack8(fv, f8); unpack8(zr, z); float ss = 0.f;
#pragma unroll
                  for (int e = 0; e < 8; ++e) { o[e] = (o[e] + f8[e]) * fsilu(z[e]); ss += o[e] * o[e]; }
                  ss += __shfl_xor(ss, 1); ss += __shfl_xor(ss, 2); ss += __shfl_xor(ss, 4);
                  *(u32x4*)(mix + grow * D + 512 + h * 64 + c8) = pack8(o);
                  if ((C.tid & 7) == 0) ssq[grow * 4 + h] = ss; } }
        }
        if (!lat) { float* o = C.out + O_SSM + ((size_t)((u * 2 + l) * 2 + d) * 4 + h) * 4096; const int i = C.tid >> 3, c8 = (C.tid & 7) * 8;
#pragma unroll
            for (int e = 0; e < 8; ++e) o[i * 64 + c8 + e] = L.Hs[i * FS + c8 + e]; }
        __syncthreads();
    }
}
DI void ssd_fix_rows(const Ctx& C, int l, int r0, int nrows, int g_lo, int g_n) {
    bf16* mix = (bf16*)(C.ws + WS_MIX); const unsigned* ssq = (const unsigned*)(C.ws + WS_SSQ); const float* nw = C.in[29] + l * 256;
    const int per_row = g_n * 16, rstep = NTHR / per_row;
    const int cc = C.tid % per_row, g = g_lo + (cc >> 4), c8 = (g * 16 + (cc & 15)) * 8, iters = nrows / rstep;
    float w8[8];
#pragma unroll
    for (int e = 0; e < 8; ++e) w8[e] = nw[c8 + e];
    for (int k0 = 0; k0 < iters; k0 += 4) {
        unsigned s0[4], s1[4]; u32x4 v[4];
#pragma unroll
        for (int u = 0; u < 4; ++u) { const int row = r0 + C.tid / per_row + (k0 + u) * rstep; const unsigned* p = (const unsigned*)(mix + (size_t)row * D + 512 + c8);
            s0[u] = __hip_atomic_load(ssq + (size_t)row * 4 + 2 * g, __ATOMIC_RELAXED, __HIP_MEMORY_SCOPE_AGENT); s1[u] = __hip_atomic_load(ssq + (size_t)row * 4 + 2 * g + 1, __ATOMIC_RELAXED, __HIP_MEMORY_SCOPE_AGENT);
            v[u].x = __hip_atomic_load(p, __ATOMIC_RELAXED, __HIP_MEMORY_SCOPE_AGENT); v[u].y = __hip_atomic_load(p + 1, __ATOMIC_RELAXED, __HIP_MEMORY_SCOPE_AGENT);
            v[u].z = __hip_atomic_load(p + 2, __ATOMIC_RELAXED, __HIP_MEMORY_SCOPE_AGENT); v[u].w = __hip_atomic_load(p + 3, __ATOMIC_RELAXED, __HIP_MEMORY_SCOPE_AGENT); }
#pragma unroll
        for (int u = 0; u < 4; ++u) { const int row = r0 + C.tid / per_row + (k0 + u) * rstep;
            const float rstd = __builtin_amdgcn_rsqf((__builtin_bit_cast(float, s0[u]) + __builtin_bit_cast(float, s1[u])) * (1.f / 128) + EPS);
            float x[8]; unpack8(v[u], x);
#pragma unroll
            for (int e = 0; e < 8; ++e) x[e] *= rstd * w8[e];
            *(u32x4*)(mix + (size_t)row * D + 512 + c8) = pack8(x); }
    }
}
DI void phase_ssd_fix(const Ctx& C, int l) {
    bf16* mix = (bf16*)(C.ws + WS_MIX); const float* ssq = (const float*)(C.ws + WS_SSQ); const float* nw = C.in[29] + l * 256;
    const int gt = C.bid * NTHR + C.tid, NGT = C.G * NTHR;
    for (int i = gt; i < T * 32; i += NGT) { const int row = i >> 5, c8 = (i & 31) * 8, g = c8 >> 7;
        const float rstd = rsqrtf((ssq[(size_t)row * 4 + 2 * g] + ssq[(size_t)row * 4 + 2 * g + 1]) * (1.f / 128) + EPS);
        bf16* p = mix + (size_t)row * D + 512 + c8; float x[8]; ld8(p, x);
#pragma unroll
        for (int e = 0; e < 8; ++e) x[e] *= rstd * nw[c8 + e];
        *(u32x4*)p = pack8(x); }
}
struct KVSeg { const bf16* k; int ldk; const bf16* kr; int ldkr; const bf16* v; int ldv; int nkeys; int rope; int pos0; int win; };
constexpr int VSB = 136;
struct Stage { u32x4 k0, k1, v; };
template <int MODE> DI Stage kv_gload(const bf16* sk, int ldk, const bf16* skr, int ldkr, const bf16* sv, int ldv, int k0, int tid) {
    Stage st; const int key = tid >> 3, c = tid & 7;
    st.v = *(const u32x4*)(sv + (size_t)(k0 + key) * ldv + c * 8);
    st.k0 = *(const u32x4*)(sk + (size_t)(k0 + key) * ldk + c * 8);
    if (MODE == 0) { const int kk = (tid & 255) >> 2, j = tid & 3; st.k1 = *(const u32x4*)(skr + (size_t)(k0 + kk) * ldkr + j * 8); } else st.k1 = st.k0;
    return st;
}
template <int MODE> DI void kv_lstore(const Stage st, LAS unsigned char* Kl, LAS unsigned char* Vl, int KSB, int tid) {
    const int key = tid >> 3, c = tid & 7;
    { LAS bf16* vt = (LAS bf16*)Vl;
      vt[(c * 8 + 0) * (VSB / 2) + key] = (bf16)(st.v.x & 0xffffu); vt[(c * 8 + 1) * (VSB / 2) + key] = (bf16)(st.v.x >> 16);
      vt[(c * 8 + 2) * (VSB / 2) + key] = (bf16)(st.v.y & 0xffffu); vt[(c * 8 + 3) * (VSB / 2) + key] = (bf16)(st.v.y >> 16);
      vt[(c * 8 + 4) * (VSB / 2) + key] = (bf16)(st.v.z & 0xffffu); vt[(c * 8 + 5) * (VSB / 2) + key] = (bf16)(st.v.z >> 16);
      vt[(c * 8 + 6) * (VSB / 2) + key] = (bf16)(st.v.w & 0xffffu); vt[(c * 8 + 7) * (VSB / 2) + key] = (bf16)(st.v.w >> 16); }
    *(LAS u32x4*)(Kl + key * KSB + c * 16) = st.k0;
    if (MODE == 0) { if (tid < 256) { const int kk = tid >> 2, j = tid & 3; *(LAS u32x4*)(Kl + kk * KSB + 128 + j * 16) = st.k1; } }
}
template <int MODE>
DI void attn_unit(const Ctx& C, const bf16* qb0, const bf16* qb1, int ldq, int ro0, int ro1, int qrope, int qpos0, float qscale,
                  const KVSeg s0, const KVSeg s1, int nseg, float sink0, float sink1, bf16* ob0, bf16* ob1, int ldo, const float* cosT, const float* sinT) {
    constexpr int DQK = MODE == 0 ? 96 : 64, NKS = DQK / 32, KSB = (DQK + 8) * 2;
    constexpr int TILEB = 64 * KSB + 64 * VSB;
    LAS unsigned char* Kl0 = C.lds; LAS unsigned char* Vl0 = C.lds + 64 * KSB;
    const int lane = C.lane, r = lane & 15, quad = lane >> 4, tid = C.tid;
    bf16x8 qf[2][NKS]; int qpos[2];
#pragma unroll
    for (int sq = 0; sq < 2; ++sq) { const int row = (sq ? ro1 : ro0) + r; qpos[sq] = qpos0 + row; const bf16* qp = (sq ? qb1 : qb0) + (size_t)row * ldq;
#pragma unroll
        for (int ks = 0; ks < NKS; ++ks) { float x[8];
            if (MODE == 0) { if (ks < 2 || !qrope) ld8(qp + ks * 32 + quad * 8, x);
                else { float x1[8], x2[8]; ld8(qp + 64 + (quad & 1) * 8, x1); ld8(qp + 80 + (quad & 1) * 8, x2); const float* cs = cosT + qpos[sq] * 16 + (quad & 1) * 8; const float* sn = sinT + qpos[sq] * 16 + (quad & 1) * 8;
#pragma unroll
                    for (int e = 0; e < 8; ++e) x[e] = quad < 2 ? x1[e] * cs[e] - x2[e] * sn[e] : x1[e] * sn[e] + x2[e] * cs[e]; } }
            else { if (!qrope) ld8(qp + ks * 32 + quad * 8, x);
                else { float x1[8], x2[8]; ld8(qp + quad * 8, x1); ld8(qp + 32 + quad * 8, x2); const float* cs = cosT + qpos[sq] * 32 + quad * 8; const float* sn = sinT + qpos[sq] * 32 + quad * 8;
#pragma unroll
                    for (int e = 0; e < 8; ++e) x[e] = ks == 0 ? x1[e] * cs[e] - x2[e] * sn[e] : x1[e] * sn[e] + x2[e] * cs[e]; } }
#pragma unroll
            for (int e = 0; e < 8; ++e) x[e] *= qscale;
            qf[sq][ks] = __builtin_bit_cast(bf16x8, pack8(x)); } }
    f32x4 oacc[2][4]; float mrun[2], lrun[2];
#pragma unroll
    for (int sq = 0; sq < 2; ++sq) { mrun[sq] = -1e30f; lrun[sq] = 0.f;
#pragma unroll
        for (int dt = 0; dt < 4; ++dt) oacc[sq][dt] = Z4; }
    const int nt0 = s0.nkeys >> 6, ntt = nt0 + (nseg > 1 ? (s1.nkeys >> 6) : 0);
#define SEGSEL(ti_) const bool second_ = (ti_) >= nt0; const int k0_ = (second_ ? (ti_) - nt0 : (ti_)) * 64; \
        const bf16* sk_ = second_ ? s1.k : s0.k; const int ldk_ = second_ ? s1.ldk : s0.ldk; const bf16* skr_ = second_ ? s1.kr : s0.kr; const int ldkr_ = second_ ? s1.ldkr : s0.ldkr; \
        const bf16* sv_ = second_ ? s1.v : s0.v; const int ldv_ = second_ ? s1.ldv : s0.ldv; const int rope_ = second_ ? s1.rope : s0.rope; const int pos0_ = second_ ? s1.pos0 : s0.pos0; const int swin = second_ ? s1.win : s0.win;
    Stage stA, stB;
    { const int tn = 0; const bool sec2 = tn >= nt0; const int k02 = (sec2 ? tn - nt0 : tn) * 64; stA = kv_gload<MODE>(sec2 ? s1.k : s0.k, sec2 ? s1.ldk : s0.ldk, sec2 ? s1.kr : s0.kr, sec2 ? s1.ldkr : s0.ldkr, sec2 ? s1.v : s0.v, sec2 ? s1.ldv : s0.ldv, k02, tid); stB = stA; }
    kv_lstore<MODE>(stA, Kl0, Vl0, KSB, tid);
    { const int tn = 1; if (tn < ntt) { const bool sec2 = tn >= nt0; const int k02 = (sec2 ? tn - nt0 : tn) * 64; stA = kv_gload<MODE>(sec2 ? s1.k : s0.k, sec2 ? s1.ldk : s0.ldk, sec2 ? s1.kr : s0.kr, sec2 ? s1.ldkr : s0.ldkr, sec2 ? s1.v : s0.v, sec2 ? s1.ldv : s0.ldv, k02, tid); } }
    { const int tn = 2; if (tn < ntt) { const bool sec2 = tn >= nt0; const int k02 = (sec2 ? tn - nt0 : tn) * 64; stB = kv_gload<MODE>(sec2 ? s1.k : s0.k, sec2 ? s1.ldk : s0.ldk, sec2 ? s1.kr : s0.kr, sec2 ? s1.ldkr : s0.ldkr, sec2 ? s1.v : s0.v, sec2 ? s1.ldv : s0.ldv, k02, tid); } }
    lds_sync();
    for (int ti0 = 0; ti0 < ntt; ti0 += 2) {
        { const int ti = ti0;
        { if (ti + 1 < ntt) kv_lstore<MODE>(stA, Kl0 + ((ti + 1) & 1) * TILEB, Vl0 + ((ti + 1) & 1) * TILEB, KSB, tid);
        { const int tn = ti + 3; if (tn < ntt) { const bool sec2 = tn >= nt0; const int k02 = (sec2 ? tn - nt0 : tn) * 64; stA = kv_gload<MODE>(sec2 ? s1.k : s0.k, sec2 ? s1.ldk : s0.ldk, sec2 ? s1.kr : s0.kr, sec2 ? s1.ldkr : s0.ldkr, sec2 ? s1.v : s0.v, sec2 ? s1.ldv : s0.ldv, k02, tid); } }
        LAS unsigned char* Kl = Kl0 + (ti & 1) * TILEB; LAS unsigned char* Vl = Vl0 + (ti & 1) * TILEB;
        SEGSEL(ti)
        (void)sk_; (void)ldk_; (void)skr_; (void)ldkr_; (void)sv_; (void)ldv_; (void)rope_;
        const int kpos0 = pos0_ + k0_;
        f32x4 sacc[2][4];
#pragma unroll
        for (int sq = 0; sq < 2; ++sq)
#pragma unroll
            for (int nt = 0; nt < 4; ++nt) sacc[sq][nt] = Z4;
#pragma unroll
        for (int ks = 0; ks < NKS; ++ks)
#pragma unroll
            for (int nt = 0; nt < 4; ++nt) { const bf16x8 kf = *(const LAS bf16x8*)(Kl + (nt * 16 + r) * KSB + (ks * 32 + quad * 8) * 2);
                sacc[0][nt] = __builtin_amdgcn_mfma_f32_16x16x32_bf16(kf, qf[0][ks], sacc[0][nt], 0, 0, 0);
                sacc[1][nt] = __builtin_amdgcn_mfma_f32_16x16x32_bf16(kf, qf[1][ks], sacc[1][nt], 0, 0, 0); }
        bf16x8 pb[2][2];
#pragma unroll
        for (int sq = 0; sq < 2; ++sq) {
            float mx = -1e30f;
#pragma unroll
            for (int nt = 0; nt < 4; ++nt)
#pragma unroll
                for (int j = 0; j < 4; ++j) { float s = sacc[sq][nt][j];
                    if (swin) { const int dk = kpos0 + nt * 16 + quad * 4 + j - qpos[sq]; if (dk > 128 || dk < -128) s = -1e30f; sacc[sq][nt][j] = s; }
                    mx = fmaxf(mx, s); }
            mx = fmaxf(mx, __shfl_xor(mx, 16)); mx = fmaxf(mx, __shfl_xor(mx, 32));
            const float mnew = fmaxf(mrun[sq], mx), alpha = __builtin_amdgcn_exp2f(mrun[sq] - mnew); mrun[sq] = mnew;
            float ps = 0.f; float p[16];
#pragma unroll
            for (int nt = 0; nt < 4; ++nt)
#pragma unroll
                for (int j = 0; j < 4; ++j) { const float e = __builtin_amdgcn_exp2f(sacc[sq][nt][j] - mnew); p[nt * 4 + j] = e; ps += e; }
            lrun[sq] = lrun[sq] * alpha + ps;
#pragma unroll
            for (int dt = 0; dt < 4; ++dt) oacc[sq][dt] *= alpha;
            pb[sq][0] = __builtin_bit_cast(bf16x8, pack8(p)); pb[sq][1] = __builtin_bit_cast(bf16x8, pack8(p + 8));
        }
#pragma unroll
        for (int m2 = 0; m2 < 2; ++m2)
#pragma unroll
            for (int dt = 0; dt < 4; ++dt) { const LAS unsigned char* vp = Vl + (dt * 16 + r) * VSB + (32 * m2 + 4 * quad) * 2;
                const u32x2 lo = *(const LAS u32x2*)vp, hi = *(const LAS u32x2*)(vp + 32);
                const bf16x8 av = __builtin_bit_cast(bf16x8, (u32x4){lo.x, lo.y, hi.x, hi.y});
                oacc[0][dt] = __builtin_amdgcn_mfma_f32_16x16x32_bf16(av, pb[0][m2], oacc[0][dt], 0, 0, 0);
                oacc[1][dt] = __builtin_amdgcn_mfma_f32_16x16x32_bf16(av, pb[1][m2], oacc[1][dt], 0, 0, 0); }

        lds_sync(); }
        }
        if (ti0 + 1 < ntt) { const int ti = ti0 + 1;
        { if (ti + 1 < ntt) kv_lstore<MODE>(stB, Kl0 + ((ti + 1) & 1) * TILEB, Vl0 + ((ti + 1) & 1) * TILEB, KSB, tid);
        { const int tn = ti + 3; if (tn < ntt) { const bool sec2 = tn >= nt0; const int k02 = (sec2 ? tn - nt0 : tn) * 64; stB = kv_gload<MODE>(sec2 ? s1.k : s0.k, sec2 ? s1.ldk : s0.ldk, sec2 ? s1.kr : s0.kr, sec2 ? s1.ldkr : s0.ldkr, sec2 ? s1.v : s0.v, sec2 ? s1.ldv : s0.ldv, k02, tid); } }
        LAS unsigned char* Kl = Kl0 + (ti & 1) * TILEB; LAS unsigned char* Vl = Vl0 + (ti & 1) * TILEB;
        SEGSEL(ti)
        (void)sk_; (void)ldk_; (void)skr_; (void)ldkr_; (void)sv_; (void)ldv_; (void)rope_;
        const int kpos0 = pos0_ + k0_;
        f32x4 sacc[2][4];
#pragma unroll
        for (int sq = 0; sq < 2; ++sq)
#pragma unroll
            for (int nt = 0; nt < 4; ++nt) sacc[sq][nt] = Z4;
#pragma unroll
        for (int ks = 0; ks < NKS; ++ks)
#pragma unroll
            for (int nt = 0; nt < 4; ++nt) { const bf16x8 kf = *(const LAS bf16x8*)(Kl + (nt * 16 + r) * KSB + (ks * 32 + quad * 8) * 2);
                sacc[0][nt] = __builtin_amdgcn_mfma_f32_16x16x32_bf16(kf, qf[0][ks], sacc[0][nt], 0, 0, 0);
                sacc[1][nt] = __builtin_amdgcn_mfma_f32_16x16x32_bf16(kf, qf[1][ks], sacc[1][nt], 0, 0, 0); }
        bf16x8 pb[2][2];
#pragma unroll
        for (int sq = 0; sq < 2; ++sq) {
            float mx = -1e30f;
#pragma unroll
            for (int nt = 0; nt < 4; ++nt)
#pragma unroll
                for (int j = 0; j < 4; ++j) { float s = sacc[sq][nt][j];
                    if (swin) { const int dk = kpos0 + nt * 16 + quad * 4 + j - qpos[sq]; if (dk > 128 || dk < -128) s = -1e30f; sacc[sq][nt][j] = s; }
                    mx = fmaxf(mx, s); }
            mx = fmaxf(mx, __shfl_xor(mx, 16)); mx = fmaxf(mx, __shfl_xor(mx, 32));
            const float mnew = fmaxf(mrun[sq], mx), alpha = __builtin_amdgcn_exp2f(mrun[sq] - mnew); mrun[sq] = mnew;
            float ps = 0.f; float p[16];
#pragma unroll
            for (int nt = 0; nt < 4; ++nt)
#pragma unroll
                for (int j = 0; j < 4; ++j) { const float e = __builtin_amdgcn_exp2f(sacc[sq][nt][j] - mnew); p[nt * 4 + j] = e; ps += e; }
            lrun[sq] = lrun[sq] * alpha + ps;
#pragma unroll
            for (int dt = 0; dt < 4; ++dt) oacc[sq][dt] *= alpha;
            pb[sq][0] = __builtin_bit_cast(bf16x8, pack8(p)); pb[sq][1] = __builtin_bit_cast(bf16x8, pack8(p + 8));
        }
#pragma unroll
        for (int m2 = 0; m2 < 2; ++m2)
#pragma unroll
            for (int dt = 0; dt < 4; ++dt) { const LAS unsigned char* vp = Vl + (dt * 16 + r) * VSB + (32 * m2 + 4 * quad) * 2;
                const u32x2 lo = *(const LAS u32x2*)vp, hi = *(const LAS u32x2*)(vp + 32);
                const bf16x8 av = __builtin_bit_cast(bf16x8, (u32x4){lo.x, lo.y, hi.x, hi.y});
                oacc[0][dt] = __builtin_amdgcn_mfma_f32_16x16x32_bf16(av, pb[0][m2], oacc[0][dt], 0, 0, 0);
                oacc[1][dt] = __builtin_amdgcn_mfma_f32_16x16x32_bf16(av, pb[1][m2], oacc[1][dt], 0, 0, 0); }

        lds_sync(); }
        }
    }
#pragma unroll
    for (int sq = 0; sq < 2; ++sq) { float l = lrun[sq]; l += __shfl_xor(l, 16); l += __shfl_xor(l, 32);
        const float sk = sq ? sink1 : sink0; if (sk > -1e29f) l += __builtin_amdgcn_exp2f(sk - mrun[sq]);
        const float inv = __builtin_amdgcn_rcpf(l); bf16* op = (sq ? ob1 : ob0) + (size_t)((sq ? ro1 : ro0) + r) * ldo;
#pragma unroll
        for (int dt = 0; dt < 4; ++dt) { u32x2 o; o.x = pk2(oacc[sq][dt][0] * inv, oacc[sq][dt][1] * inv); o.y = pk2(oacc[sq][dt][2] * inv, oacc[sq][dt][3] * inv); *(u32x2*)(op + dt * 16 + quad * 4) = o; } }
    __syncthreads();
}

DI void attn_phase_unit(const Ctx& C, int l, int u) {
    const bf16* pA = (const bf16*)(C.ws + WS_PA); const bf16* kv16 = (const bf16*)(C.ws + WS_KV16); const bf16* qraw = (const bf16*)(C.ws + WS_QRAW);
    const bf16* kpec = (const bf16*)(C.ws + WS_KPEC); const bf16* skc = (const bf16*)(C.ws + WS_SWAKC); const bf16* svc = (const bf16*)(C.ws + WS_SWAVC);
    bf16* mix = (bf16*)(C.ws + WS_MIX); const float* rt = (const float*)(C.ws + WS_ROPE);
    const float mla_qs = 0.10206207261596577f * LOG2E, swa_qs = 0.125f * LOG2E;
    KVSeg s0{}, s1{};
    if (u < 384) {
        const bool lat = u < 256; int b, h, qrow0, qpos0;
        if (lat) { b = u >> 6; h = (u >> 4) & 3; const int qt = u & 15; qrow0 = TC + b * 4096 + qt * 256; qpos0 = qt * 256; } else { const int v = u - 256; b = v >> 2; h = v & 3; qrow0 = b * 256; qpos0 = 0; }
        const int ro0 = C.wave * 32, ro1 = ro0 + 16;
        const bf16* qb = qraw + (size_t)qrow0 * 384 + h * 96; bf16* ob = mix + (size_t)qrow0 * D + 256 + h * 64;
        if (lat) { const int cr = T + b * 256, lr = TC + b * 4096;
            s0 = KVSeg{kv16 + (size_t)cr * 512 + h * 128, 512, kpec + (size_t)(b * 256) * 32, 32, kv16 + (size_t)cr * 512 + h * 128 + 64, 512, 256, 0, 0, 0};
            s1 = KVSeg{kv16 + (size_t)lr * 512 + h * 128, 512, (const bf16*)(C.ws + WS_KPER) + (size_t)(b * 4096) * 32, 32, kv16 + (size_t)lr * 512 + h * 128 + 64, 512, 4096, 0, 0, 0};
            attn_unit<0>(C, qb, qb, 384, ro0, ro1, 1, qpos0, mla_qs, s0, s1, 2, -1e30f, -1e30f, ob, ob, D, rt, rt + 65536);
        } else { const int cr = b * 256;
            s0 = KVSeg{kv16 + (size_t)cr * 512 + h * 128, 512, pA + (size_t)cr * NA + 384, NA, kv16 + (size_t)cr * 512 + h * 128 + 64, 512, 256, 0, 0, 0};
            attn_unit<0>(C, qb, qb, 384, ro0, ro1, 0, qpos0, mla_qs, s0, s0, 1, -1e30f, -1e30f, ob, ob, D, rt, rt + 65536); }
    } else {
        const bool lat = u >= 512; int b, kvh, qrow0, qpos0;
        if (lat) { const int v = u - 512; b = v >> 6; kvh = (v >> 5) & 1; const int qbk = v & 31; qrow0 = TC + b * 4096 + qbk * 128; qpos0 = qbk * 128; }
        else { const int v = u - 384; b = v >> 2; kvh = (v >> 1) & 1; const int qt = v & 1; qrow0 = b * 256 + qt * 128; qpos0 = qt * 128; }
        const int ro = C.wave * 16; const int h0 = kvh * 2;
        const bf16* qb0 = pA + (size_t)qrow0 * NA + 416 + h0 * 64; const bf16* qb1 = qb0 + 64;
        bf16* ob0 = mix + (size_t)qrow0 * D + 768 + h0 * 64; bf16* ob1 = ob0 + 64;
        const float sk0 = C.in[30][l * 4 + h0] * LOG2E, sk1 = C.in[30][l * 4 + h0 + 1] * LOG2E;
        if (lat) { const int lr = TC + b * 4096; int klo = qpos0 - 128, khi = qpos0 + 256; if (klo < 0) klo = 0; if (khi > 4096) khi = 4096;
            s0 = KVSeg{skc + (size_t)(b * 256) * 128 + kvh * 64, 128, nullptr, 0, svc + (size_t)(b * 256) * 128 + kvh * 64, 128, 256, 0, 0, 0};
            s1 = KVSeg{(const bf16*)(C.ws + WS_KSR) + (size_t)(b * 4096 + klo) * 128 + kvh * 64, 128, nullptr, 0, pA + (size_t)(lr + klo) * NA + 800 + kvh * 64, NA, khi - klo, 0, klo, 1};
            attn_unit<1>(C, qb0, qb1, NA, ro, ro, 1, qpos0, swa_qs, s0, s1, 2, sk0, sk1, ob0, ob1, D, rt + 131072, rt + 262144);
        } else { const int cr = b * 256;
            s0 = KVSeg{pA + (size_t)cr * NA + 672 + kvh * 64, NA, nullptr, 0, pA + (size_t)cr * NA + 800 + kvh * 64, NA, 256, 0, 0, 0};
            attn_unit<1>(C, qb0, qb1, NA, ro, ro, 0, qpos0, swa_qs, s0, s0, 1, sk0, sk1, ob0, ob1, D, rt + 131072, rt + 262144); }
    }
}
struct Args { const float* in[34]; float* out; unsigned char* ws; int ph_lo, ph_hi; };
constexpr int NPHASES = 1 + 2 * 13 + 1;

__global__ void __launch_bounds__(NTHR) mk_fwd(Args args) {
    extern __shared__ __attribute__((aligned(16))) unsigned char lds_raw[];
    Ctx C; C.in = args.in; C.out = args.out; C.ws = args.ws; C.lds = (LAS unsigned char*)lds_raw;
    const int wave0 = __builtin_amdgcn_readfirstlane((int)threadIdx.x >> 6); C.tid = 0; C.lane = 0; C.wave = 0; C.bid = blockIdx.x; C.G = gridDim.x;
    unsigned char* ws = args.ws;
    volatile LAS unsigned* bst = (volatile LAS unsigned*)(C.lds + LDS_BYTES - 16);
    if (threadIdx.x < 4) bst[threadIdx.x] = 0u;
    __syncthreads();
    XcdBarrier xbar = xcd_barrier_post((unsigned*)ws, bst);
    int ph = 0;
#define PH_BEGIN if (ph >= args.ph_lo && ph < args.ph_hi) { { int w_ = wave0; asm volatile("" : "+s"(w_)); C.wave = w_; { int ln_; asm volatile("v_mbcnt_lo_u32_b32 %0, -1, 0\n\tv_mbcnt_hi_u32_b32 %0, -1, %0" : "=v"(ln_)); C.lane = ln_; } C.tid = C.wave * 64 + C.lane; }
#define PH_END } { const bool inside_ = (ph >= args.ph_lo && ph + 1 < args.ph_hi); ++ph; if (inside_) { if (args.ph_hi < 0) { __threadfence(); cg::this_grid().sync(); } else xcd_barrier(xbar); } }
    const float* ada_all = (const float*)(ws + WS_ADA);
    PH_BEGIN phase_ada_rope(C); PH_END
#pragma unroll 1
    for (int l = 0; l < 2; ++l) {
        asm volatile("" : "+s"(l));
        const float* ada = ada_all + (size_t)l * 5 * 6144;
        const float* xc = l == 0 ? args.in[0] : args.out; const float* xl = l == 0 ? args.in[1] : args.out + (size_t)TC * D;
        PH_BEGIN if (l == 0) { int g2_ = C.G; asm volatile("" : "+s"(g2_)); phase_weights(C, 0, 1, C.bid, g2_); } phase_norm(C, xc, xl, args.in[10] + l * D, ada, 0, (bf16*)(ws + WS_XN)); PH_END
        PH_BEGIN { pg8::Gemm g{(const pg8::bf16_t*)(ws + WS_XN), (const pg8::bf16_t*)(ws + WS_WIN), T, 1024, 1024, 1024, C.tid}; pg8::StaticOrder S; S.init(T, 1024, C.G, C.bid);
            EpiP E{(bf16*)(ws + WS_PA), NA, NA, 0, l, args.out, nullptr}; pg8::gemm_phase<EpiP, pg8::StaticOrder, true, true>(C.lds, g, S, E);
            if (C.bid >= 128) { Ctx C2 = C; asm volatile("" : "+v"(C2.tid), "+v"(C2.lane)); phase_weights(C2, l, l == 0 ? 6 : 2, C.bid - 128, 128); } } PH_END
        PH_BEGIN phase_mla_prep(C, l); PH_END
        PH_BEGIN { int kq_ = 256; asm volatile("" : "+s"(kq_)); const int half_ = __builtin_amdgcn_readfirstlane(C.bid >= 128 ? 1 : 0);
            const bool q_ = half_ == 0;
            pg8::Gemm g{(const pg8::bf16_t*)(ws + (q_ ? WS_QN16 : WS_CKV16)), (const pg8::bf16_t*)(ws + (q_ ? WS_WUQ : WS_WUKV)), q_ ? T : NKV, 512, kq_, kq_, C.tid};
            pg8::StaticOrder S; S.init(q_ ? T : NKV, 512, 128, C.bid & 127);
            EpiRS E{(bf16*)(ws + (q_ ? WS_QRAW : WS_KV16)), q_ ? 384 : 512, q_ ? 384 : 512}; pg8::gemm_phase<EpiRS, pg8::StaticOrder, true, true>(C.lds, g, S, E); } PH_END
        PH_BEGIN for (int u = (C.bid & 7) * 32 + (C.bid >> 3); u < 768; u += 256) { Ctx C2 = C;     asm volatile("" : "+v"(C2.tid), "+v"(C2.lane)); attn_phase_unit(C2, l, u); } PH_END
        PH_BEGIN { pg8::Gemm g{(const pg8::bf16_t*)(ws + WS_XN), (const pg8::bf16_t*)(ws + WS_WIN) + (size_t)1024 * 1024, T, 2048, 1024, 1024, C.tid}; pg8::StaticOrder S; S.init(T, 2048, C.G, C.bid);
            EpiP E{(bf16*)(ws + WS_PB), NB, NB, 1, l, args.out, (float*)(ws + WS_SIDE)}; pg8::gemm_phase<EpiP, pg8::StaticOrder, true, true>(C.lds, g, S, E); } PH_END
        PH_BEGIN for (int it = C.bid; it < 1024; it += C.G) { Ctx C2 = C; asm volatile("" : "+v"(C2.tid), "+v"(C2.lane)); if (it < 512) dn_phase1_item(C2, l, it); else ss_phase1_item(C2, l, it - 512); } PH_END
        PH_BEGIN ss_scan(C, l); if (C.bid < 128) dn_scan_unit(C, l, C.bid); else if (C.bid < 256) { Ctx C2 = C; asm volatile("" : "+v"(C2.tid), "+v"(C2.lane)); ss_phase3_item(C2, l, C.bid - 128); } PH_END
        PH_BEGIN for (int rnd = 0; rnd < 3; ++rnd) { Ctx C2 = C; asm volatile("" : "+v"(C2.tid), "+v"(C2.lane));
            if (C.bid < 128) { if (rnd == 0) dn_phase3_item(C2, l, C.bid); else if (rnd == 1) dn_phase3_item(C2, l, 256 + C.bid); else ssd_fix_rows(C2, l, C.bid * 64, 64, 0, 2); }
            else if (C.bid < 256) { const int it0 = 128 + (C.bid - 128) * 2; if (rnd == 0) dn_phase3_item(C2, l, C.bid); else ss_phase3_item(C2, l, it0 + (rnd - 1));
                if (rnd == 2) { const int v_ = (it0 >> 2) - 32; ssd_fix_rows(C2, l, TC + (v_ >> 4) * 4096 + (v_ & 15) * 256, 256, (it0 & 3) >> 1, 1); } } } PH_END
        PH_BEGIN { pg8::Gemm g{(const pg8::bf16_t*)(ws + WS_MIX), (const pg8::bf16_t*)(ws + WS_WOUT), T, 1024, 1024, 1024, C.tid}; pg8::StaticOrder S; S.init(T, 1024, C.G, C.bid);
            EpiRes E{xc, xl, args.out, ada, 2048}; pg8::gemm_phase<EpiRes, pg8::StaticOrder, true, true>(C.lds, g, S, E);
            if (l == 0 && C.bid >= 128) { Ctx C2 = C; asm volatile("" : "+v"(C2.tid), "+v"(C2.lane)); phase_weights(C2, 0, 8, C.bid - 128, 128); } } PH_END
        PH_BEGIN phase_norm(C, args.out, args.out + (size_t)TC * D, args.in[11] + l * D, ada, 1, (bf16*)(ws + WS_XN)); PH_END
        PH_BEGIN { pg8::Gemm g{(const pg8::bf16_t*)(ws + WS_XN), (const pg8::bf16_t*)(ws + WS_WGU), T, 5632, 1024, 1024, C.tid}; pg8::StaticOrder S; S.init(T, 5632, C.G, C.bid);
            EpiSwiglu E{(bf16*)(ws + WS_ACT)}; pg8::gemm_phase<EpiSwiglu, pg8::StaticOrder, true, true>(C.lds, g, S, E); } PH_END
        PH_BEGIN { pg8::Gemm g{(const pg8::bf16_t*)(ws + WS_ACT), (const pg8::bf16_t*)(ws + WS_WDN), T, 1024, 2816, 2816, C.tid}; pg8::StaticOrder S; S.init(T, 1024, C.G, C.bid);
            EpiRes E{args.out, args.out + (size_t)TC * D, args.out, ada, 5120}; pg8::gemm_phase<EpiRes, pg8::StaticOrder, true, true>(C.lds, g, S, E);
            if (l == 0 && C.bid >= 128) { Ctx C2 = C; asm volatile("" : "+v"(C2.tid), "+v"(C2.lane)); phase_weights(C2, 1, 13, C.bid - 128, 128); } } PH_END
    }
    PH_BEGIN phase_final_norm(C, args.in[33]); PH_END
}

extern "C" void kernel_launch(void* const* d_in, const int* in_sizes, int n_in, void* d_out, int out_size, void* d_ws, size_t ws_size, hipStream_t stream) {
    static int grid = 0;
    if (grid == 0) {
        if (n_in != 34 || out_size != 36175872 || ws_size < WS_END) { fprintf(stderr, "kernel_launch: unexpected problem (n_in %d out %d ws %zu)\n", n_in, out_size, ws_size); grid = -1; return; }
        int dev = 0, cus = 0, per_cu = 0;
        if (hipGetDevice(&dev) != hipSuccess || hipDeviceGetAttribute(&cus, hipDeviceAttributeMultiprocessorCount, dev) != hipSuccess) { grid = -1; return; }
        if (hipFuncSetAttribute((const void*)mk_fwd, hipFuncAttributeMaxDynamicSharedMemorySize, LDS_BYTES) != hipSuccess) { fprintf(stderr, "kernel_launch: hipFuncSetAttribute failed\n"); grid = -1; return; }
        if (hipOccupancyMaxActiveBlocksPerMultiprocessor(&per_cu, (const void*)mk_fwd, NTHR, LDS_BYTES) != hipSuccess || per_cu < 1) { fprintf(stderr, "kernel_launch: occupancy query says %d\n", per_cu); per_cu = 1; }
        (void)hipGetLastError();
        grid = cus * per_cu;
        if (grid >= 256) grid = 256;
        else { fprintf(stderr, "kernel_launch: needs 256 co-resident workgroups, device offers %d\n", grid); grid = -1; return; }
    }
    if (grid < 0) return;
    if (hipMemsetAsync(d_ws, 0, 16384, stream) != hipSuccess) { fprintf(stderr, "kernel_launch: memset failed\n"); return; }
    Args a{};
    for (int i = 0; i < 34; ++i) a.in[i] = (const float*)d_in[i];
    a.out = (float*)d_out; a.ws = (unsigned char*)d_ws;
#if MK_SINGLE
    a.ph_lo = 0; a.ph_hi = NPHASES;
    void* kargs[] = {&a};
    hipError_t e = hipLaunchCooperativeKernel((const void*)mk_fwd, dim3(grid), dim3(NTHR), kargs, LDS_BYTES, stream);
    if (e != hipSuccess) fprintf(stderr, "kernel_launch: cooperative launch failed: %s (grid %d)\n", hipGetErrorString(e), grid);
#else
    for (int p = 0; p < NPHASES; ++p) { a.ph_lo = p; a.ph_hi = p + 1; hipLaunchKernelGGL(mk_fwd, dim3(grid), dim3(NTHR), LDS_BYTES, stream, a); }
#endif
}
```

```cpp
#include <hip/hip_runtime.h>
#include <hip/hip_cooperative_groups.h>
#include <cstdio>
#include <cstdint>
namespace cg = cooperative_groups;
namespace pg8 {
#define PG8_LAS __attribute__((address_space(3)))
typedef unsigned short bf16_t;
typedef short bf16x8 __attribute__((ext_vector_type(8)));
typedef float f32x4 __attribute__((ext_vector_type(4)));
typedef unsigned u32x4 __attribute__((ext_vector_type(4)));
constexpr int BM = 256, BK = 64, HALF = 128, HTB = HALF * BK * 2  , STAGE_BYTES = 8 * HTB, NXCD = 8, WGM = 8;

__host__ __device__ __forceinline__ int lds_byte(int r, int c) { const int st = (r >> 4) * 2 + (c >> 5), rr = r & 15, cc = c & 31, ob = rr * 64 + cc * 2; return st * 1024 + (ob ^ (((ob >> 9) & 1) << 5)); }
__host__ __device__ __forceinline__ void stage_rc(int b, int& R, int& C) { const int st = b / 1024, sb = b % 1024, swz = sb ^ (((sb >> 9) & 1) << 5); R = (st >> 1) * 16 + swz / 64; C = (st & 1) * 32 + (swz % 64) / 2; }
__host__ __device__ __forceinline__ int perm32(int rho) { const int n = rho >> 4, i = rho & 15; return 8 * (i >> 2) + 4 * n + (i & 3); }

struct Unit { int pm, pn; };
struct Gemm { const bf16_t* A; const bf16_t* Bt; int M, N, K, lda; int tid; };
struct StaticOrder {
    int nM, nN, nwg, G, c;
    __host__ __device__ void init(int M, int N, int G_, int c_) { nM = M / BM; nN = N / BM; nwg = nM * nN; G = G_; c = c_; }
    __host__ __device__ bool next(int i, Unit& u) const {
        const long L = (long)i * G + c; if (L >= nwg) return false;
        int wgid = (int)L; { const int q = nwg / NXCD, r = nwg % NXCD, xcd = wgid % NXCD, off = wgid / NXCD; wgid = (xcd < r ? xcd * (q + 1) : r * (q + 1) + (xcd - r) * q) + off; }
        const int nig = WGM * nN, gid = wgid / nig, fm = gid * WGM, gsz = (nM - fm) < WGM ? (nM - fm) : WGM;
        u.pm = fm + ((wgid % nig) % gsz); u.pn = (wgid % nig) / gsz; return true;
    }
    __device__ __forceinline__ void a_ready(const Unit&) const {}
    __device__ __forceinline__ void done(const Unit&) const {}
};
__device__ __forceinline__ unsigned cvt_pk_bf16(float lo, float hi) { unsigned r; asm volatile("v_cvt_pk_bf16_f32 %0, %1, %2" : "=v"(r) : "v"(lo), "v"(hi)); return r; }
template <class Epi, class Sched, bool ALIGN_EPI = false, bool SP2 = false>
__device__ __forceinline__ void gemm_phase(PG8_LAS unsigned char* lds, const Gemm g, const Sched& S, const Epi& E) {
    const int tid = g.tid, wid = __builtin_amdgcn_readfirstlane(tid >> 6), lane = tid & 63, wr = wid >> 2, wc = wid & 3, fr = lane & 15, fq = lane >> 4;
    const int K = g.K, nt = K / BK;
    unsigned voffA[2], voffB[2];
#pragma unroll
    for (int i = 0; i < 2; ++i) { int R, C; stage_rc(tid * 16 + i * 8192, R, C); const int Rb = Epi::PERM ? ((R & ~31) + perm32(R & 31)) : R;
        voffA[i] = (unsigned)(R * g.lda + C) * 2u; voffB[i] = (unsigned)(Rb * K + C) * 2u; }
    const size_t kstep = (size_t)(BK * 2);
    const size_t hstep = (size_t)HALF * K * 2;
    const size_t tstep = 2 * hstep; const size_t hstepA = (size_t)HALF * g.lda * 2, tstepA = 2 * hstepA;
    const unsigned ldsw = (unsigned)wid * 1024u;
    const int aoff = lds_byte(wr * 64 + fr, fq * 8), boff = lds_byte(wc * 32 + fr, fq * 8);
#define PG8_SA(b, h) (((b) * 2 + (h)) * HTB)
#define PG8_SB(b, h) ((4 + (b) * 2 + (h)) * HTB)
#define PG8_STAGE(bufoff, gbase, voff) do { _Pragma("unroll") for (int _i = 0; _i < 2; ++_i) \
        __builtin_amdgcn_global_load_lds((const unsigned*)((const char*)(gbase) + (voff)[_i]), (PG8_LAS unsigned*)(lds + (bufoff) + ldsw + _i * 8192), 16, 0, 0); } while (0)
#define PG8_LDA(dst, b, h) do { _Pragma("unroll") for (int m = 0; m < 4; ++m) _Pragma("unroll") for (int k = 0; k < 2; ++k) dst[m][k] = *(const PG8_LAS bf16x8*)(lds + PG8_SA(b, h) + aoff + m * 2048 + k * 1024); } while (0)
#define PG8_LDB(dst, b, h) do { _Pragma("unroll") for (int n = 0; n < 2; ++n) _Pragma("unroll") for (int k = 0; k < 2; ++k) dst[n][k] = *(const PG8_LAS bf16x8*)(lds + PG8_SB(b, h) + boff + n * 2048 + k * 1024); } while (0)
#define PG8_MMA(ai, bj, At, Bt) do { __builtin_amdgcn_s_setprio(1); _Pragma("unroll") for (int m = 0; m < 4; ++m) _Pragma("unroll") for (int n = 0; n < 2; ++n) _Pragma("unroll") for (int k = 0; k < 2; ++k) \
        acc[ai][bj][m][n] = __builtin_amdgcn_mfma_f32_16x16x32_bf16(Bt[n][k], At[m][k], acc[ai][bj][m][n], 0, 0, 0); __builtin_amdgcn_s_setprio(0); } while (0)
#define PG8_WAIT_V(n) asm volatile("s_waitcnt vmcnt(" #n ")" ::: "memory")
#define PG8_WAIT_L(n) asm volatile("s_waitcnt lgkmcnt(" #n ")" ::: "memory")
#define PG8_BAR __builtin_amdgcn_s_barrier()
#define PG8_SCHED __builtin_amdgcn_sched_barrier(0)
    Unit cur, nxt; int ui = 0;
    if (!S.next(0, cur)) return;
    f32x4 acc[2][2][4][2];
#pragma unroll
    for (int a = 0; a < 2; ++a)
#pragma unroll
        for (int b = 0; b < 2; ++b)
#pragma unroll
            for (int m = 0; m < 4; ++m)
#pragma unroll
                for (int n = 0; n < 2; ++n) acc[a][b][m][n] = (f32x4){0.f, 0.f, 0.f, 0.f};
    bf16x8 At[4][2], B0[2][2], B1[2][2];
    const char* cA = (const char*)g.A + (size_t)cur.pm * tstepA; const char* cB = (const char*)g.Bt + (size_t)cur.pn * tstep;
    S.a_ready(cur);
    if constexpr (SP2) {
        PG8_STAGE(PG8_SB(0, 0), cB, voffB); PG8_STAGE(PG8_SB(0, 1), cB + hstep, voffB); PG8_STAGE(PG8_SA(0, 0), cA, voffA); PG8_STAGE(PG8_SA(0, 1), cA + hstepA, voffA);
        if (wr == 1) PG8_BAR;
        PG8_WAIT_V(2); PG8_BAR;
        PG8_STAGE(PG8_SB(1, 0), cB + kstep, voffB); PG8_STAGE(PG8_SA(1, 0), cA + kstep, voffA); PG8_STAGE(PG8_SB(1, 1), cB + hstep + kstep, voffB);
        PG8_WAIT_V(6); PG8_BAR;
    } else {
        PG8_STAGE(PG8_SB(0, 0), cB, voffB); PG8_STAGE(PG8_SA(0, 0), cA, voffA); PG8_STAGE(PG8_SB(0, 1), cB + hstep, voffB); PG8_STAGE(PG8_SA(0, 1), cA + hstepA, voffA);
        if (wr == 1) PG8_BAR;
        PG8_WAIT_V(4); PG8_BAR;
        PG8_STAGE(PG8_SB(1, 0), cB + kstep, voffB); PG8_STAGE(PG8_SA(1, 0), cA + kstep, voffA); PG8_STAGE(PG8_SB(1, 1), cB + hstep + kstep, voffB);
        PG8_WAIT_V(6); PG8_BAR;
    }
    for (;;) {
        const bool has_next = S.next(ui + 1, nxt);
        const char* nA = has_next ? (const char*)g.A + (size_t)nxt.pm * tstepA : cA; const char* nB = has_next ? (const char*)g.Bt + (size_t)nxt.pn * tstep : cB;
        for (int t = 0; t < nt; t += 2) {
            const bool last = (t == nt - 2);
            const char* a1 = cA + (size_t)(t + 1) * kstep;
            const char* a2 = last ? nA : cA + (size_t)(t + 2) * kstep; const char* b2 = last ? nB : cB + (size_t)(t + 2) * kstep;
            const char* a3 = a2 + kstep; const char* b3 = b2 + kstep;
            if (last && has_next) S.a_ready(nxt);
            if constexpr (SP2) {
            PG8_LDB(B0, 0, 0); PG8_LDB(B1, 0, 1); PG8_SCHED; PG8_LDA(At, 0, 0); PG8_STAGE(PG8_SA(1, 1), a1 + hstepA, voffA);
            PG8_WAIT_V(8); PG8_WAIT_L(0); PG8_BAR; PG8_MMA(0, 0, At, B0); PG8_MMA(0, 1, At, B1); PG8_BAR; PG8_SCHED;
            PG8_LDA(At, 0, 1); PG8_STAGE(PG8_SB(0, 0), b2, voffB); PG8_STAGE(PG8_SB(0, 1), b2 + hstep, voffB); PG8_STAGE(PG8_SA(0, 0), a2, voffA);
            PG8_WAIT_V(8); PG8_WAIT_L(0); PG8_BAR; PG8_MMA(1, 0, At, B0); PG8_MMA(1, 1, At, B1); PG8_BAR; PG8_SCHED;
            PG8_LDB(B0, 1, 0); PG8_LDB(B1, 1, 1); PG8_SCHED; PG8_LDA(At, 1, 0); PG8_STAGE(PG8_SA(0, 1), a2 + hstepA, voffA);
            PG8_WAIT_V(8); PG8_WAIT_L(0); PG8_BAR; PG8_MMA(0, 0, At, B0); PG8_MMA(0, 1, At, B1); PG8_BAR; PG8_SCHED;
            PG8_LDA(At, 1, 1); PG8_STAGE(PG8_SB(1, 0), b3, voffB); PG8_STAGE(PG8_SB(1, 1), b3 + hstep, voffB); PG8_STAGE(PG8_SA(1, 0), a3, voffA);
            PG8_WAIT_V(8); PG8_WAIT_L(0); PG8_BAR; PG8_MMA(1, 0, At, B0); PG8_MMA(1, 1, At, B1); PG8_BAR; PG8_SCHED;
            } else {
            PG8_LDB(B0, 0, 0); PG8_SCHED; PG8_LDA(At, 0, 0); PG8_STAGE(PG8_SA(1, 1), a1 + hstepA, voffA);
            PG8_WAIT_L(8); PG8_BAR; PG8_WAIT_L(0); PG8_MMA(0, 0, At, B0); PG8_BAR; PG8_SCHED;
            PG8_LDB(B1, 0, 1); PG8_STAGE(PG8_SB(0, 0), b2, voffB);
            PG8_BAR; PG8_WAIT_L(0); PG8_MMA(0, 1, At, B1); PG8_BAR;
            PG8_LDA(At, 0, 1); PG8_STAGE(PG8_SA(0, 0), a2, voffA);
            PG8_BAR; PG8_WAIT_L(0); PG8_MMA(1, 0, At, B0); PG8_BAR; PG8_SCHED;
            PG8_STAGE(PG8_SB(0, 1), b2 + hstep, voffB);
            PG8_WAIT_V(6); PG8_BAR; PG8_MMA(1, 1, At, B1); PG8_BAR;
            PG8_LDB(B0, 1, 0); PG8_SCHED; PG8_LDA(At, 1, 0); PG8_STAGE(PG8_SA(0, 1), a2 + hstepA, voffA);
            PG8_WAIT_L(8); PG8_BAR; PG8_WAIT_L(0); PG8_MMA(0, 0, At, B0); PG8_BAR; PG8_SCHED;
            PG8_LDB(B1, 1, 1); PG8_STAGE(PG8_SB(1, 0), b3, voffB);
            PG8_BAR; PG8_WAIT_L(0); PG8_MMA(0, 1, At, B1); PG8_BAR;
            PG8_LDA(At, 1, 1); PG8_STAGE(PG8_SA(1, 0), a3, voffA);
            PG8_BAR; PG8_WAIT_L(0); PG8_MMA(1, 0, At, B0); PG8_BAR; PG8_SCHED;
            PG8_STAGE(PG8_SB(1, 1), b3 + hstep, voffB);
            PG8_WAIT_V(6); PG8_BAR; PG8_MMA(1, 1, At, B1); PG8_BAR;
            }
        }
        if constexpr (ALIGN_EPI) { if (wr == 0) PG8_BAR; }
        if constexpr (!Epi::AFTER_DRAIN) { E(acc, cur, wr, wc, fr, fq); S.done(cur); }
        if (!has_next) break;
#pragma unroll
        for (int a = 0; a < 2; ++a)
#pragma unroll
            for (int b = 0; b < 2; ++b)
#pragma unroll
                for (int m = 0; m < 4; ++m)
#pragma unroll
                    for (int n = 0; n < 2; ++n) acc[a][b][m][n] = (f32x4){0.f, 0.f, 0.f, 0.f};
        cur = nxt; cA = nA; cB = nB; ++ui;
        if constexpr (ALIGN_EPI) { if (wr == 1) PG8_BAR; }
    }
    PG8_WAIT_V(0);
    if constexpr (!ALIGN_EPI) { if (wr == 0) PG8_BAR; }
    PG8_BAR;
    if constexpr (Epi::AFTER_DRAIN) { E.fused(acc, cur, wr, wc, fr, fq, lds, wid, lane); S.done(cur); }
#undef PG8_SA
#undef PG8_SB
#undef PG8_STAGE
#undef PG8_LDA
#undef PG8_LDB
#undef PG8_MMA
#undef PG8_WAIT_V
#undef PG8_WAIT_L
#undef PG8_BAR
#undef PG8_SCHED
}
}
#ifndef MK_SINGLE
#define MK_SINGLE 1
#endif
#define DI __device__ __forceinline__
#define LAS __attribute__((address_space(3)))
typedef unsigned short bf16;
typedef float f32x4 __attribute__((ext_vector_type(4)));
typedef short bf16x8 __attribute__((ext_vector_type(8)));
typedef unsigned u32x4 __attribute__((ext_vector_type(4)));
typedef unsigned u32x2 __attribute__((ext_vector_type(2)));

constexpr int T = 24576, TC = 8192, D = 1024, FF = 2816, NA = 928, NB = 1816, NKV = 25600;
constexpr int NWAVES = 8, NTHR = 512;
constexpr float EPS = 1e-6f;
constexpr float LOG2E = 1.4426950408889634f;
constexpr size_t O_Y = 0, O_SDN = 25165824, O_CKV = 27262976, O_KPE = 29360128, O_SSM = 29884416, O_SK = 31981568, O_SV = 34078720;
constexpr size_t MiB = 1u << 20, KiB = 1024;
constexpr size_t WS_ADA = 64 * KiB;
constexpr size_t WS_ROPE = 1 * MiB;
constexpr size_t WS_RS = 3 * MiB;
constexpr size_t WS_SSQ = 3 * MiB + 256 * KiB;
constexpr size_t WS_CKVC = 4 * MiB;
constexpr size_t WS_KPEC = 4 * MiB + 512 * KiB;
constexpr size_t WS_SWAKC = WS_KPEC + 64 * KiB;
constexpr size_t WS_SWAVC = WS_SWAKC + 256 * KiB;
constexpr size_t WS_WUQ = 5 * MiB + 256 * KiB;
constexpr size_t WS_WUKV = WS_WUQ + 256 * KiB;
constexpr size_t WS_WUKVC = WS_WUKV + 256 * KiB;
constexpr size_t WS_WIN = 6 * MiB;
constexpr size_t WS_WOUT = 12 * MiB;
constexpr size_t WS_WGU = 14 * MiB;
constexpr size_t WS_WDN = 25 * MiB;
constexpr size_t WS_XN = 31 * MiB;
constexpr size_t WS_MIX = 79 * MiB;
constexpr size_t WS_PA = 127 * MiB;
constexpr size_t WS_KV16 = 171 * MiB;
constexpr size_t WS_QRAW = 196 * MiB;
constexpr size_t WS_PB = 127 * MiB;
constexpr size_t WS_MN = 213 * MiB;
constexpr size_t WS_CS = 229 * MiB;
constexpr size_t WS_CD = 237 * MiB;
constexpr size_t WS_SIDE = 238 * MiB;
constexpr size_t WS_CKV16 = 214 * MiB;
constexpr size_t WS_QN16 = 227 * MiB;
constexpr size_t WS_ACT = 79 * MiB;
constexpr size_t WS_KPER = 239 * MiB;
constexpr size_t WS_KSR = 240 * MiB;
constexpr size_t WS_END = 244 * MiB;
constexpr int LDS_BYTES = 147456;

typedef float f32x2_t __attribute__((ext_vector_type(2)));
typedef __bf16 bf16x2_t __attribute__((ext_vector_type(2)));
DI unsigned pk2(float lo, float hi) { const f32x2_t v = {lo, hi}; const bf16x2_t b = __builtin_convertvector(v, bf16x2_t); return __builtin_bit_cast(unsigned, b); }
DI unsigned f2bf(float f) { return pk2(f, 0.f) & 0xffffu; }
DI float bflo(unsigned v) { return __builtin_bit_cast(float, v << 16); }
DI float bfhi(unsigned v) { return __builtin_bit_cast(float, v & 0xffff0000u); }
DI void unpack8(u32x4 v, float* f) { f[0] = bflo(v.x); f[1] = bfhi(v.x); f[2] = bflo(v.y); f[3] = bfhi(v.y); f[4] = bflo(v.z); f[5] = bfhi(v.z); f[6] = bflo(v.w); f[7] = bfhi(v.w); }
DI void ld8(const bf16* p, float* f) { unpack8(*(const u32x4*)p, f); }
DI u32x4 pack8(const float* f) { u32x4 o; o.x = pk2(f[0], f[1]); o.y = pk2(f[2], f[3]); o.z = pk2(f[4], f[5]); o.w = pk2(f[6], f[7]); return o; }
DI float wave_sum(float v) {
#pragma unroll
    for (int o = 32; o; o >>= 1) v += __shfl_xor(v, o);
    return v; }
DI float siluf(float x) { return x / (1.f + expf(-x)); }
DI float fsilu(float x) { return x * __builtin_amdgcn_rcpf(1.f + __expf(-x)); }
DI float softplusf(float x) { return x > 20.f ? x : log1pf(expf(x)); }
DI float fsoftplus(float x) { const float y = __expf(x); return x > 20.f ? x : (y < 1e-3f ? y * (1.f - 0.5f * y) : __logf(1.f + y)); }

struct EpiP {
    static constexpr bool PERM = true, AFTER_DRAIN = false;
    bf16* P; int ldc, ncols, mode, layer; float* out; float* side;
    DI void operator()(const pg8::f32x4 (&acc)[2][2][4][2], const pg8::Unit& u, int wr, int wc, int fr, int fq) const {
        const int row0 = u.pm * 256 + wr * 64 + fr, col0 = u.pn * 256 + wc * 32 + 8 * fq;
#pragma unroll
        for (int ai = 0; ai < 2; ++ai)
#pragma unroll
            for (int m = 0; m < 4; ++m) { const int row = row0 + ai * 128 + m * 16;
#pragma unroll
                for (int bj = 0; bj < 2; ++bj) { const int c = col0 + bj * 128; const pg8::f32x4 v0 = acc[ai][bj][m][0], v1 = acc[ai][bj][m][1];
                    if (c < ncols) { u32x4 w; w.x = pk2(v0[0], v0[1]); w.y = pk2(v0[2], v0[3]); w.z = pk2(v1[0], v1[1]); w.w = pk2(v1[2], v1[3]); *(u32x4*)(P + (size_t)row * ldc + c) = w; }
                    float* dst = nullptr;
                    if (mode == 0) { if (row < TC) { const size_t rb = (size_t)((row >> 8) * 2 + layer) * 256 + (row & 255);
                            if (c >= 256 && c < 384) dst = out + O_CKV + rb * 128 + (c - 256);
                            else if (c >= 384 && c < 416) dst = out + O_KPE + rb * 32 + (c - 384);
                            else if (c >= 672 && c < 800) dst = out + O_SK + rb * 128 + (c - 672);
                            else if (c >= 800 && c < 928) dst = out + O_SV + rb * 128 + (c - 800); } }
                    else { if (c >= 1024 && c < 1040) dst = side + (size_t)row * 24 + (c - 1024); else if (c >= 1808 && c < 1816) dst = side + (size_t)row * 24 + 16 + (c - 1808); }
                    if (dst) { *(pg8::f32x4*)dst = v0; *(pg8::f32x4*)(dst + 4) = v1; } } }
    }
};
struct EpiRS {
    static constexpr bool PERM = true, AFTER_DRAIN = false;
    bf16* O; int ldc, ncols;
    DI void operator()(const pg8::f32x4 (&acc)[2][2][4][2], const pg8::Unit& u, int wr, int wc, int fr, int fq) const {
        const int row0 = u.pm * 256 + wr * 64 + fr, col0 = u.pn * 256 + wc * 32 + 8 * fq;
#pragma unroll
        for (int ai = 0; ai < 2; ++ai)
#pragma unroll
            for (int m = 0; m < 4; ++m) { const int row = row0 + ai * 128 + m * 16;
#pragma unroll
                for (int bj = 0; bj < 2; ++bj) { const int c = col0 + bj * 128; const pg8::f32x4 v0 = acc[ai][bj][m][0], v1 = acc[ai][bj][m][1];
                    if (c < ncols) { u32x4 w; w.x = pk2(v0[0], v0[1]); w.y = pk2(v0[2], v0[3]); w.z = pk2(v1[0], v1[1]); w.w = pk2(v1[2], v1[3]); *(u32x4*)(O + (size_t)row * ldc + c) = w; } } }
    }
};
struct EpiRes {
    static constexpr bool PERM = false, AFTER_DRAIN = false;
    const float* src_c; const float* src_l; float* dst; const float* ada; int goff;
    DI void operator()(const pg8::f32x4 (&acc)[2][2][4][2], const pg8::Unit& u, int wr, int wc, int fr, int fq) const {
        const int row0 = u.pm * 256 + wr * 64 + fr, col0 = u.pn * 256 + wc * 32 + 4 * fq;
        const int rt = u.pm * 256; const int r = rt < TC ? 0 : 1 + ((rt - TC) >> 12);
        const float* g = ada + (size_t)r * 6144 + goff;
        pg8::f32x4 gv[2][2];
#pragma unroll
        for (int bj = 0; bj < 2; ++bj)
#pragma unroll
            for (int n = 0; n < 2; ++n) gv[bj][n] = *(const pg8::f32x4*)(g + col0 + bj * 128 + n * 16);
#pragma unroll
        for (int ai = 0; ai < 2; ++ai)
#pragma unroll
            for (int m = 0; m < 4; ++m) { const int row = row0 + ai * 128 + m * 16;
                const float* sp = (row < TC ? src_c + (size_t)row * D : src_l + (size_t)(row - TC) * D) + col0; float* dp = dst + (size_t)row * D + col0;
#pragma unroll
                for (int bj = 0; bj < 2; ++bj)
#pragma unroll
                    for (int n = 0; n < 2; ++n) { const pg8::f32x4 xo = *(const pg8::f32x4*)(sp + bj * 128 + n * 16); *(pg8::f32x4*)(dp + bj * 128 + n * 16) = xo + gv[bj][n] * acc[ai][bj][m][n]; } }
    }
};
struct EpiSwiglu {
    static constexpr bool PERM = true, AFTER_DRAIN = false;
    bf16* O;
    DI void operator()(const pg8::f32x4 (&acc)[2][2][4][2], const pg8::Unit& u, int wr, int wc, int fr, int fq) const {
        const int row0 = u.pm * 256 + wr * 64 + fr, col0 = u.pn * 128 + wc * 32 + 8 * fq;
#pragma unroll
        for (int ai = 0; ai < 2; ++ai)
#pragma unroll
            for (int m = 0; m < 4; ++m) { const int row = row0 + ai * 128 + m * 16; float o[8];
#pragma unroll
                for (int n = 0; n < 2; ++n)
#pragma unroll
                    for (int i = 0; i < 4; ++i) { const float gt = acc[ai][0][m][n][i], up = acc[ai][1][m][n][i]; o[n * 4 + i] = fsilu(gt) * up; }
                *(u32x4*)(O + (size_t)row * FF + col0) = pack8(o); }
    }
};
#define RLX_AGENT __ATOMIC_RELAXED, __HIP_MEMORY_SCOPE_AGENT
#define XB_TMO      128
#define XB_XCNT(j)  (256  + 64 * (j))
#define XB_XSUB(j)  (1280 + 64 * (j))
#define XB_XGEN(j)  (2304 + 64 * (j))
#define XB_TOP      3328
#define XB_TOPGEN   3392
#define XCD_BAR_WORDS 3456
#define XB_SPIN_CAP (1u << 18)

__device__ __forceinline__ unsigned xb_ld(unsigned* p)              { return __hip_atomic_load(p, __ATOMIC_RELAXED, __HIP_MEMORY_SCOPE_AGENT); }
__device__ __forceinline__ unsigned xb_add(unsigned* p, unsigned v) { return __hip_atomic_fetch_add(p, v, __ATOMIC_RELAXED, __HIP_MEMORY_SCOPE_AGENT); }
__device__ __forceinline__ unsigned xb_xcc_id() { return (unsigned)__builtin_amdgcn_s_getreg((3 << 11) | 20) & 0xFu; }
#define XB_SPIN(cond, bar) do { unsigned _sp = 0; while (cond) { __builtin_amdgcn_s_sleep(1); \
    if ((++_sp & 255u) == 0u) { if (xb_ld(&(bar)[XB_TMO])) break; if (_sp > XB_SPIN_CAP) { atomicAdd(&(bar)[XB_TMO], 1u); break; } } } } while (0)

struct XcdBarrier {
    unsigned* bar; unsigned x;
    volatile LAS unsigned* st;
};

__device__ __forceinline__ XcdBarrier xcd_barrier_post(unsigned* bar, volatile LAS unsigned* st) {
    XcdBarrier b; b.bar = bar; b.x = xb_xcc_id(); b.st = st;
    if (threadIdx.x == 0) (void)xb_add(&bar[XB_XCNT(b.x)], 1u);
    return b;
}
__device__ __forceinline__ void xcd_barrier_complete(unsigned* bar, unsigned x, unsigned& nloc, unsigned& nx) {
    const unsigned G = gridDim.x * gridDim.y * gridDim.z;
    unsigned sum, cnt, mine, sp = 0u;
    for (;;) {
        sum = 0u; cnt = 0u; mine = 0u;
#pragma unroll
        for (unsigned j = 0; j < 16; ++j) { const unsigned c = xb_ld(&bar[XB_XCNT(j)]); sum += c; cnt += (c > 0u) ? 1u : 0u; mine = (j == x) ? c : mine; }
        if (sum == G) break;
        __builtin_amdgcn_s_sleep(1);
        if ((++sp & 255u) == 0u) { if (xb_ld(&bar[XB_TMO])) break; if (sp > XB_SPIN_CAP) { atomicAdd(&bar[XB_TMO], 1u); break; } }
    }
    nloc = mine > 0u ? mine : 1u; nx = cnt > 0u ? cnt : 1u;
}

__device__ __forceinline__ void xcd_barrier(const XcdBarrier& b) {
    asm volatile("s_waitcnt vmcnt(0)" ::: "memory");
    __syncthreads();
    if (threadIdx.x == 0) {
        unsigned* bar = b.bar;
        __builtin_amdgcn_s_waitcnt(0);
        unsigned nloc = b.st[0], nx = b.st[1];
        if (nloc == 0u) { xcd_barrier_complete(bar, b.x, nloc, nx); b.st[0] = nloc; b.st[1] = nx; }
        const unsigned old = xb_add(&bar[XB_XSUB(b.x)], 1u);
        const unsigned gen = old / nloc;
        if (old + 1u == (gen + 1u) * nloc) {
            __builtin_amdgcn_fence(__ATOMIC_RELEASE, "agent");
            asm volatile("s_waitcnt vmcnt(0)" ::: "memory");
            const unsigned og = xb_add(&bar[XB_TOP], 1u);
            const unsigned tg = og / nx;
            if (og + 1u == (tg + 1u) * nx) xb_add(&bar[XB_TOPGEN], 1u);
            else XB_SPIN(xb_ld(&bar[XB_TOPGEN]) == tg, bar);
            __builtin_amdgcn_fence(__ATOMIC_ACQUIRE, "agent");
            xb_add(&bar[XB_XGEN(b.x)], 1u);
            asm volatile("s_waitcnt vmcnt(0)" ::: "memory");
        } else {
            XB_SPIN(xb_ld(&bar[XB_XGEN(b.x)]) == gen, bar);
            __builtin_amdgcn_fence(__ATOMIC_ACQUIRE, "agent");
            asm volatile("s_waitcnt vmcnt(0)" ::: "memory");
        }
    }
    __syncthreads();
}
DI int map_col(int id, int n, int nvalid) {
    if (id == 0) return n;
    if (id == 1) { if (n < 1024) { if (n < 416) return 1040 + n; if (n < 928) return 2232 + (n - 416); return -1; }
        const int b = n - 1024; if (b < 1040) return b; if (b < 1816) return 1456 + (b - 1040); return -1; }
    if (id == 2) { const int pn = n >> 8, bj = (n >> 7) & 1, cc = n & 127; return bj * FF + pn * 128 + cc; }
    return n < nvalid ? n : -1;
}
DI void transpose_item(const float* W, int ldw, int Ksrc, int mapid, int nvalid, const float* kscale, bf16* WT, int Kd, int nblk, LAS float* scr, int item, int lane) {
    const int kb = item / nblk, nb = item % nblk, k0 = 64 * kb, n0 = 32 * nb;
    const int n4 = (lane & 7) * 4; const int sc = map_col(mapid, n0 + n4, nvalid);
    (void)kscale;
#pragma unroll
    for (int i = 0; i < 8; ++i) { const int kk = 8 * i + (lane >> 3), k = k0 + kk; f32x4 v = {0.f, 0.f, 0.f, 0.f};
        if (sc >= 0 && k < Ksrc) v = *(const f32x4*)(W + (size_t)k * ldw + sc);
        LAS float* d = scr + kk * 33 + n4; d[0] = v.x; d[1] = v.y; d[2] = v.z; d[3] = v.w; }
    asm volatile("s_waitcnt lgkmcnt(0)" ::: "memory");
    const int c = lane & 7;
#pragma unroll
    for (int j = 0; j < 4; ++j) { const int n = (lane >> 3) + 8 * j; const LAS float* s = scr + (8 * c) * 33 + n;
        u32x4 o; o.x = pk2(s[0 * 33], s[1 * 33]); o.y = pk2(s[2 * 33], s[3 * 33]); o.z = pk2(s[4 * 33], s[5 * 33]); o.w = pk2(s[6 * 33], s[7 * 33]);
        *(u32x4*)(WT + (size_t)(n0 + n) * Kd + k0 + 8 * c) = o; }
    asm volatile("s_waitcnt lgkmcnt(0)" ::: "memory");
}

struct Ctx {
    const float* const* in; float* out; unsigned char* ws; LAS unsigned char* lds; int tid, lane, wave, bid, G;
};

DI void phase_weights(const Ctx& C, int l, int mask, int bid, int G) {
    LAS float* scr = (LAS float*)(C.lds + C.wave * 16384);
    const int gw = bid * NWAVES + C.wave, NGW = G * NWAVES;
    constexpr int I_IN = 16 * 96, I_OUT = 16 * 32, I_GU = 16 * 176, I_DN = 44 * 32, I_Q = 4 * 16, I_KV = 4 * 16;
    constexpr int NIT = I_IN + I_OUT + I_GU + I_DN + I_Q + I_KV;
    unsigned char* ws = C.ws;
    for (int it = gw; it < NIT; it += NGW) { int r = it;
        { const int cls = it < I_IN ? 0 : (it < I_IN + I_OUT ? 2 : (it < I_IN + I_OUT + I_GU ? 3 : (it < I_IN + I_OUT + I_GU + I_DN ? 1 : 0))); if (!((mask >> cls) & 1)) continue; }
        if (r < I_IN) { transpose_item(C.in[14] + (size_t)l * 1024 * 2744, 2744, 1024, 1, 0, nullptr, (bf16*)(ws + WS_WIN), 1024, 96, scr, r, C.lane); continue; } r -= I_IN;
        if (r < I_OUT) { transpose_item(C.in[15] + (size_t)l * 1024 * 1024, 1024, 1024, 0, 0, nullptr, (bf16*)(ws + WS_WOUT), 1024, 32, scr, r, C.lane); continue; } r -= I_OUT;
        if (r < I_GU) { transpose_item(C.in[31] + (size_t)l * 1024 * 5632, 5632, 1024, 2, 0, nullptr, (bf16*)(ws + WS_WGU), 1024, 176, scr, r, C.lane); continue; } r -= I_GU;
        if (r < I_DN) { transpose_item(C.in[32] + (size_t)l * 2816 * 1024, 1024, 2816, 0, 0, nullptr, (bf16*)(ws + WS_WDN), 2816, 32, scr, r, C.lane); continue; } r -= I_DN;
        if (r < I_Q) { transpose_item(C.in[21] + (size_t)l * 256 * 384, 384, 256, 3, 384, nullptr, (bf16*)(ws + WS_WUQ), 256, 16, scr, r, C.lane); continue; } r -= I_Q;
        transpose_item(C.in[23] + (size_t)l * 128 * 512, 512, 128, 3, 512, nullptr, (bf16*)(ws + WS_WUKV), 256, 16, scr, r, C.lane);
    }
    if (!(mask & 1)) return;
    const int gt = bid * NTHR + C.tid, NGT = G * NTHR;
    bf16* ckvc = (bf16*)(ws + WS_CKV16) + (size_t)T * 256; bf16* kpec = (bf16*)(ws + WS_KPEC); bf16* skc = (bf16*)(ws + WS_SWAKC); bf16* svc = (bf16*)(ws + WS_SWAVC);
    for (int i = gt; i < 1024 * 256; i += NGT) { const int row = i >> 8, c = i & 255, b = row >> 8, t = row & 255;
        ckvc[i] = c < 128 ? (bf16)f2bf(C.in[4][((size_t)(b * 2 + l) * 256 + t) * 128 + c]) : (bf16)0; }
    for (int i = gt; i < 1024 * 32; i += NGT) { const int row = i >> 5, c = i & 31, b = row >> 8, t = row & 255; kpec[i] = (bf16)f2bf(C.in[5][((size_t)(b * 2 + l) * 256 + t) * 32 + c]); }
    for (int i = gt; i < 1024 * 128; i += NGT) { const int row = i >> 7, c = i & 127, b = row >> 8, t = row & 255; const size_t s = ((size_t)(b * 2 + l) * 256 + t) * 128 + c;
        skc[i] = (bf16)f2bf(C.in[7][s]); svc[i] = (bf16)f2bf(C.in[8][s]); }
}

DI void phase_ada_rope(const Ctx& C) {
    LAS float* sc = (LAS float*)C.lds;
    LAS float* red = sc + 5 * 1024;
    for (int i = C.tid; i < 5 * 1024; i += NTHR) { const int r = i >> 10, k = i & 1023; const float v = r == 0 ? C.in[9][k] : C.in[2][(r - 1) * 1024 + k]; sc[i] = siluf(v); }
    __syncthreads();
    float* ada = (float*)(C.ws + WS_ADA);
    for (int it = C.bid; it < 192; it += C.G) { const int l = it / 96, n = (it % 96) * 64 + C.lane;
        const float* w = C.in[12] + (size_t)l * 1024 * 6144 + n; float a[5] = {0.f, 0.f, 0.f, 0.f, 0.f};
#pragma unroll 4
        for (int kk = 0; kk < 128; ++kk) { const int k = C.wave * 128 + kk; const float wv = w[(size_t)k * 6144];
#pragma unroll
            for (int r = 0; r < 5; ++r) a[r] += sc[r * 1024 + k] * wv; }
#pragma unroll
        for (int r = 0; r < 5; ++r) red[(C.wave * 5 + r) * 64 + C.lane] = a[r];
        __syncthreads();
        if (C.tid < 320) { const int r = C.tid >> 6, ln = C.tid & 63; float s = 0.f;
#pragma unroll
            for (int w8 = 0; w8 < 8; ++w8) s += red[(w8 * 5 + r) * 64 + ln];
            const int nn = (it % 96) * 64 + ln; ada[((size_t)l * 5 + r) * 6144 + nn] = s + C.in[13][l * 6144 + nn]; }
        __syncthreads();
    }
    float* rt = (float*)(C.ws + WS_ROPE);
    const int gt = C.bid * NTHR + C.tid, NGT = C.G * NTHR;
    for (int i = gt; i < 4096 * 16; i += NGT) { const int t = i >> 4, j = i & 15; const float pos = (float)(j < 8 ? (t >> 6) : (t & 63)); const int f = j & 7;
        const float inv = powf(10000.f, -(float)f / 8.f); const float ang = pos * inv; rt[i] = cosf(ang); rt[65536 + i] = sinf(ang); }
    for (int i = gt; i < 4096 * 32; i += NGT) { const int t = i >> 5, j = i & 31; const float pos = (float)(j < 16 ? (t >> 6) : (t & 63)); const int f = j & 15;
        const float inv = powf(10000.f, -(float)f / 16.f); const float ang = pos * inv; rt[131072 + i] = cosf(ang); rt[262144 + i] = sinf(ang); }
}

DI void phase_norm(const Ctx& C, const float* src_c, const float* src_l, const float* nw, const float* ada, int which, bf16* dst) {
    const int gw = C.bid * NWAVES + C.wave, NGW = C.G * NWAVES;
    for (int row0 = gw; row0 < T; row0 += 4 * NGW) {
        f32x4 v[4][4]; float s[4]; const float* shp[4]; int rows[4]; bool ok[4];
#pragma unroll
        for (int u = 0; u < 4; ++u) { const int row = row0 + u * NGW; rows[u] = row; ok[u] = row < T; const int rr = ok[u] ? row : row0;
            const float* x = rr < TC ? src_c + (size_t)rr * D : src_l + (size_t)(rr - TC) * D;
            const int r = rr < TC ? 0 : 1 + ((rr - TC) >> 12); shp[u] = ada + (size_t)r * 6144 + which * 3072; s[u] = 0.f;
#pragma unroll
            for (int j = 0; j < 4; ++j) { v[u][j] = *(const f32x4*)(x + 256 * j + 4 * C.lane); s[u] += v[u][j].x * v[u][j].x + v[u][j].y * v[u][j].y + v[u][j].z * v[u][j].z + v[u][j].w * v[u][j].w; } }
#pragma unroll
        for (int u = 0; u < 4; ++u) { const float rstd = rsqrtf(wave_sum(s[u]) * (1.f / D) + EPS); const float* sh = shp[u]; const float* scl = sh + 1024;
            if (ok[u]) {
#pragma unroll
                for (int j = 0; j < 4; ++j) { const int c = 256 * j + 4 * C.lane; const f32x4 w = *(const f32x4*)(nw + c), a = *(const f32x4*)(scl + c), b = *(const f32x4*)(sh + c);
                    const f32x4 y = v[u][j] * rstd * w * (a + 1.f) + b; u32x2 o; o.x = pk2(y.x, y.y); o.y = pk2(y.z, y.w); *(u32x2*)(dst + (size_t)rows[u] * D + c) = o; } } }
    }
}
DI void phase_final_norm(const Ctx& C, const float* nw) {
    const int gw = C.bid * NWAVES + C.wave, NGW = C.G * NWAVES;
    for (int row0 = gw; row0 < T; row0 += 4 * NGW) {
        f32x4 v[4][4]; float s[4];
#pragma unroll
        for (int u = 0; u < 4; ++u) { const int row = row0 + u * NGW; const float* x = C.out + (size_t)(row < T ? row : row0) * D; s[u] = 0.f;
#pragma unroll
            for (int j = 0; j < 4; ++j) { v[u][j] = *(const f32x4*)(x + 256 * j + 4 * C.lane); s[u] += v[u][j].x * v[u][j].x + v[u][j].y * v[u][j].y + v[u][j].z * v[u][j].z + v[u][j].w * v[u][j].w; } }
#pragma unroll
        for (int u = 0; u < 4; ++u) { const int row = row0 + u * NGW; const float rstd = rsqrtf(wave_sum(s[u]) * (1.f / D) + EPS);
            if (row < T) { float* x = C.out + (size_t)row * D;
#pragma unroll
                for (int j = 0; j < 4; ++j) { const int c = 256 * j + 4 * C.lane; *(f32x4*)(x + c) = v[u][j] * rstd * *(const f32x4*)(nw + c); } } }
    }
}
DI void phase_mla_prep(const Ctx& C, int l) {
    const int gw = C.bid * NWAVES + C.wave, NGW = C.G * NWAVES;
    const bf16* pA = (const bf16*)(C.ws + WS_PA); bf16* qn = (bf16*)(C.ws + WS_QN16); bf16* ckv = (bf16*)(C.ws + WS_CKV16);
    const float* wq = C.in[20] + l * 256; const float* wkv = C.in[22] + l * 128; const float* rt = (const float*)(C.ws + WS_ROPE);
    for (int row0 = gw; row0 < T; row0 += 2 * NGW) {
        unsigned qa[2], qb[2]; float ka[2], kb[2]; float* op[2]; unsigned kpe1[2], kpe2[2], sk1[2], sk2[2];
#pragma unroll
        for (int u = 0; u < 2; ++u) { const int row = row0 + u * NGW; const bf16* p = pA + (size_t)row * NA;
            const unsigned* pq = (const unsigned*)p + 2 * C.lane; qa[u] = pq[0]; qb[u] = pq[1]; op[u] = nullptr; kpe1[u] = kpe2[u] = sk1[u] = sk2[u] = 0u;
            if (row < TC) { float* o = C.out + O_CKV + ((size_t)((row >> 8) * 2 + l) * 256 + (row & 255)) * 128; op[u] = o; ka[u] = o[2 * C.lane]; kb[u] = o[2 * C.lane + 1]; }
            else { const unsigned vv = ((const unsigned*)(p + 256))[C.lane]; ka[u] = bflo(vv); kb[u] = bfhi(vv);
                const int i16 = C.lane & 15, kvh = C.lane >> 5, i32 = C.lane & 31;
                kpe1[u] = p[384 + i16]; kpe2[u] = p[400 + i16]; sk1[u] = p[672 + kvh * 64 + i32]; sk2[u] = p[672 + kvh * 64 + 32 + i32]; } }
#pragma unroll
        for (int u = 0; u < 2; ++u) { const int row = row0 + u * NGW;
            { const float x0 = bflo(qa[u]), x1 = bfhi(qa[u]), x2 = bflo(qb[u]), x3 = bfhi(qb[u]);
              const float r = rsqrtf(wave_sum(x0 * x0 + x1 * x1 + x2 * x2 + x3 * x3) * (1.f / 256) + EPS); const f32x4 w = *(const f32x4*)(wq + 4 * C.lane);
              u32x2 o; o.x = pk2(x0 * r * w.x, x1 * r * w.y); o.y = pk2(x2 * r * w.z, x3 * r * w.w); *(u32x2*)(qn + (size_t)row * 256 + 4 * C.lane) = o; }
            const float r = rsqrtf(wave_sum(ka[u] * ka[u] + kb[u] * kb[u]) * (1.f / 128) + EPS); const float a = ka[u] * r * wkv[2 * C.lane], b = kb[u] * r * wkv[2 * C.lane + 1];
            if (op[u]) { op[u][2 * C.lane] = a; op[u][2 * C.lane + 1] = b; }
            unsigned* co = (unsigned*)(ckv + (size_t)row * 256); co[C.lane] = pk2(a, b); co[64 + C.lane] = 0u;
            if (row >= TC) { const int lr = row - TC, t = lr & 4095;
                bf16* kper = (bf16*)(C.ws + WS_KPER) + (size_t)lr * 32; bf16* ksr = (bf16*)(C.ws + WS_KSR) + (size_t)lr * 128;
                if (C.lane < 16) { const int i = C.lane; const float x1 = bflo(kpe1[u]), x2 = bflo(kpe2[u]), c = rt[t * 16 + i], s = rt[65536 + t * 16 + i];
                    kper[i] = (bf16)f2bf(x1 * c - x2 * s); kper[16 + i] = (bf16)f2bf(x1 * s + x2 * c); }
                { const int kvh = C.lane >> 5, i = C.lane & 31; const float x1 = bflo(sk1[u]), x2 = bflo(sk2[u]), c = rt[131072 + t * 32 + i], s = rt[262144 + t * 32 + i];
                    ksr[kvh * 64 + i] = (bf16)f2bf(x1 * c - x2 * s); ksr[kvh * 64 + 32 + i] = (bf16)f2bf(x1 * s + x2 * c); } }
        }
    }
}
DI void mm64(f32x4& c0, f32x4& c1, const LAS float* A, int sai, int sak, const LAS float* B, int sbk, int sbj, int wave, int lane) {
    const int r = lane & 15, q = lane >> 4, tr = wave >> 1, tc = (wave & 1) * 2;
    const LAS float* ap = A + (tr * 16 + r) * sai + q * sak;
    const LAS float* bp = B + q * sbk + (tc * 16 + r) * sbj;
#pragma unroll
    for (int s0 = 0; s0 < 16; s0 += 8) { float av[8], b0v[8], b1v[8];
#pragma unroll
        for (int s = 0; s < 8; ++s) { av[s] = ap[4 * (s0 + s) * sak]; b0v[s] = bp[4 * (s0 + s) * sbk]; b1v[s] = bp[4 * (s0 + s) * sbk + 16 * sbj]; }
        __builtin_amdgcn_sched_barrier(0);
#pragma unroll
        for (int s = 0; s < 8; ++s) { c0 = __builtin_amdgcn_mfma_f32_16x16x4f32(av[s], b0v[s], c0, 0, 0, 0); c1 = __builtin_amdgcn_mfma_f32_16x16x4f32(av[s], b1v[s], c1, 0, 0, 0); } }
}
DI void lds_sync() { asm volatile("s_waitcnt lgkmcnt(0)" ::: "memory"); __builtin_amdgcn_s_barrier(); asm volatile("" ::: "memory"); }
constexpr int BS = 72;
constexpr int BTB = 64 * BS * 2;
DI void mmb(f32x4& c0, f32x4& c1, const LAS bf16* A, const LAS bf16* B, int wave, int lane) {
    const int r = lane & 15, q = lane >> 4, tr = wave >> 1, tc = (wave & 1) * 2;
    const LAS bf16* ap = A + (tr * 16 + r) * BS + q * 8; const LAS bf16* bp = B + (tc * 16 + r) * BS + q * 8;
#pragma unroll
    for (int ks = 0; ks < 2; ++ks) {
        const bf16x8 a = *(const LAS bf16x8*)(ap + ks * 32), b0 = *(const LAS bf16x8*)(bp + ks * 32), b1 = *(const LAS bf16x8*)(bp + 16 * BS + ks * 32);
        c0 = __builtin_amdgcn_mfma_f32_16x16x32_bf16(a, b0, c0, 0, 0, 0);
        c1 = __builtin_amdgcn_mfma_f32_16x16x32_bf16(a, b1, c1, 0, 0, 0);
    }
}
#define MM_EPI(c0, c1, body) do { const int r_ = C.lane & 15, q_ = C.lane >> 4, tr_ = C.wave >> 1, tc_ = (C.wave & 1) * 2; \
    _Pragma("unroll") for (int j_ = 0; j_ < 4; ++j_) { const int row = tr_ * 16 + q_ * 4 + j_; { const int col = tc_ * 16 + r_; const float val = c0[j_]; body } { const int col = tc_ * 16 + 16 + r_; const float val = c1[j_]; body } } } while (0)
constexpr int FS = 68;
constexpr int FTB = 18432;
constexpr int LS = 68;
constexpr f32x4 Z4 = {0.f, 0.f, 0.f, 0.f};
DI bf16 tobf(float x) { return (bf16)f2bf(x); }

DI void tri_solve_blocked(const Ctx& C, const LAS float* As, LAS float* Us, LAS float* Ws, LAS float* Dv, LAS bf16* Wb) {
    if (C.wave == 0) { const int b = C.lane >> 4, c = C.lane & 15; float x[16];
#pragma unroll
        for (int i = 0; i < 16; ++i) { float v = (i == c) ? 1.f : 0.f;
#pragma unroll
            for (int j4 = 0; j4 < (i + 3) / 4; ++j4) { const f32x4 a = *(const LAS f32x4*)(As + (16 * b + i) * FS + 16 * b + 4 * j4);
                if (4 * j4 + 0 < i) v -= a.x * x[4 * j4 + 0];
                if (4 * j4 + 1 < i) v -= a.y * x[4 * j4 + 1];
                if (4 * j4 + 2 < i) v -= a.z * x[4 * j4 + 2];
                if (4 * j4 + 3 < i) v -= a.w * x[4 * j4 + 3]; }
            x[i] = v; Dv[(b * 16 + i) * 16 + c] = v; } }
    lds_sync();
    { LAS float* X = (C.wave < 4 ? Us : Ws) + (C.wave & 3) * 16; const int r = C.lane & 15, q = C.lane >> 4;
#pragma unroll
      for (int bi = 0; bi < 4; ++bi) {
          f32x4 c, c2 = Z4;
#pragma unroll
          for (int j = 0; j < 4; ++j) c[j] = X[(16 * bi + 4 * q + j) * FS + r];
          if (bi > 0) { float av[12], bv[12];
#pragma unroll
              for (int s = 0; s < 4 * bi; ++s) { av[s] = -As[(16 * bi + r) * FS + 4 * s + q]; bv[s] = X[(4 * s + q) * FS + r]; }
              __builtin_amdgcn_sched_barrier(0);
#pragma unroll
              for (int s = 0; s < 4 * bi; s += 2) { c = __builtin_amdgcn_mfma_f32_16x16x4f32(av[s], bv[s], c, 0, 0, 0); c2 = __builtin_amdgcn_mfma_f32_16x16x4f32(av[s + 1], bv[s + 1], c2, 0, 0, 0); }
              c += c2;
#pragma unroll
              for (int j = 0; j < 4; ++j) X[(16 * bi + 4 * q + j) * FS + r] = c[j]; }
          f32x4 dd = Z4, d2 = Z4; float dv[4], xv[4];
#pragma unroll
          for (int s = 0; s < 4; ++s) { dv[s] = Dv[(bi * 16 + r) * 16 + 4 * s + q]; xv[s] = X[(16 * bi + 4 * s + q) * FS + r]; }
          __builtin_amdgcn_sched_barrier(0);
          dd = __builtin_amdgcn_mfma_f32_16x16x4f32(dv[0], xv[0], dd, 0, 0, 0); d2 = __builtin_amdgcn_mfma_f32_16x16x4f32(dv[1], xv[1], d2, 0, 0, 0);
          dd = __builtin_amdgcn_mfma_f32_16x16x4f32(dv[2], xv[2], dd, 0, 0, 0); d2 = __builtin_amdgcn_mfma_f32_16x16x4f32(dv[3], xv[3], d2, 0, 0, 0);
          dd += d2;
#pragma unroll
          for (int j = 0; j < 4; ++j) X[(16 * bi + 4 * q + j) * FS + r] = dd[j];
          if (Wb && C.wave >= 4) {
#pragma unroll
              for (int j = 0; j < 4; ++j) Wb[(16 * bi + 4 * q + j) * BS + (C.wave & 3) * 16 + r] = tobf(dd[j]); }
      } }
    lds_sync();
}
DI void wave_cumsum(const LAS float* src, LAS float* dst, int lane) {
    float v = src[lane];
#pragma unroll
    for (int o = 1; o < 64; o <<= 1) { const float t = __shfl_up(v, o); if (lane >= o) v += t; }
    dst[lane] = v;
}

DI void store_T8(LAS bf16* T, int c8, int i, int j, u32x4 w) {
    unsigned a0 = w.x, a1 = w.y, a2 = w.z, a3 = w.w;
    { const bool on = (j & 1) != 0; const unsigned b0 = __builtin_amdgcn_alignbit(a1, a0, 16), b1 = __builtin_amdgcn_alignbit(a2, a1, 16), b2 = __builtin_amdgcn_alignbit(a3, a2, 16), b3 = __builtin_amdgcn_alignbit(a0, a3, 16);
      a0 = on ? b0 : a0; a1 = on ? b1 : a1; a2 = on ? b2 : a2; a3 = on ? b3 : a3; }
    { const bool on = (j & 2) != 0; const unsigned b0 = a1, b1 = a2, b2 = a3, b3 = a0; a0 = on ? b0 : a0; a1 = on ? b1 : a1; a2 = on ? b2 : a2; a3 = on ? b3 : a3; }
    { const bool on = (j & 4) != 0; const unsigned b0 = a2, b1 = a3, b2 = a0, b3 = a1; a0 = on ? b0 : a0; a1 = on ? b1 : a1; a2 = on ? b2 : a2; a3 = on ? b3 : a3; }
    LAS bf16* t = T + i;
    t[(c8 + ((0 + j) & 7)) * BS] = (bf16)(a0 & 0xffffu); t[(c8 + ((1 + j) & 7)) * BS] = (bf16)(a0 >> 16);
    t[(c8 + ((2 + j) & 7)) * BS] = (bf16)(a1 & 0xffffu); t[(c8 + ((3 + j) & 7)) * BS] = (bf16)(a1 >> 16);
    t[(c8 + ((4 + j) & 7)) * BS] = (bf16)(a2 & 0xffffu); t[(c8 + ((5 + j) & 7)) * BS] = (bf16)(a2 >> 16);
    t[(c8 + ((6 + j) & 7)) * BS] = (bf16)(a3 & 0xffffu); t[(c8 + ((7 + j) & 7)) * BS] = (bf16)(a3 >> 16);
}
struct DnLds { LAS float *As, *Us, *Ws, *Ss, *gc, *bt, *gr, *Dv; LAS bf16 *Kb, *KT, *Qb, *StT, *QKb, *Wb, *VnT, *VnsT, *oacc; LAS float *Mt, *Nt, *Mc, *Nc; LAS bf16 *WfT, *UfT; };
DI DnLds dn_lds3(LAS unsigned char* l) { DnLds L{};
    L.As = (LAS float*)l; L.Us = (LAS float*)(l + FTB); L.Ws = (LAS float*)(l + 2 * FTB); L.Ss = (LAS float*)(l + 3 * FTB);
    LAS unsigned char* b = l + 4 * FTB; L.Kb = (LAS bf16*)b; L.KT = (LAS bf16*)(b + BTB); L.Qb = (LAS bf16*)(b + 2 * BTB); L.StT = (LAS bf16*)(b + 3 * BTB); L.Wb = (LAS bf16*)(b + 4 * BTB);
    L.gc = (LAS float*)(b + 5 * BTB); L.bt = L.gc + 64; L.gr = L.bt + 64; L.Dv = (LAS float*)(b + 5 * BTB + 768);
    L.QKb = (LAS bf16*)l; L.VnT = (LAS bf16*)(l + 2 * FTB); L.VnsT = (LAS bf16*)(l + 2 * FTB + BTB); return L; }
DI DnLds dn_lds1(LAS unsigned char* l) { DnLds L{};
    L.As = (LAS float*)l; L.Us = (LAS float*)(l + FTB); L.Ws = (LAS float*)(l + 2 * FTB);
    LAS unsigned char* m = l + 3 * FTB; L.Mt = (LAS float*)m; L.Nt = (LAS float*)(m + 17408);
    LAS unsigned char* b = m + 2 * 17408; L.Kb = (LAS bf16*)b; L.KT = (LAS bf16*)(b + BTB); L.Wb = (LAS bf16*)(b + 2 * BTB); L.StT = (LAS bf16*)(b + 3 * BTB); L.Qb = (LAS bf16*)(b + 4 * BTB);
    L.gc = (LAS float*)(b + 5 * BTB); L.bt = L.gc + 64; L.gr = L.bt + 64; L.Dv = (LAS float*)(b + 5 * BTB + 768);
    L.VnT = (LAS bf16*)(l + 2 * FTB); L.VnsT = (LAS bf16*)(l + 2 * FTB + BTB); return L; }

struct DnRaw { u32x4 r[3][3]; float wa, wb, wc; float sb, sa; };
DI DnRaw dn_fetch(const Ctx& C, const bf16* pB, const float* side, int row0, int seq_len, int t0, int rev, int h, int d, bool wantq) {
    DnRaw R; const int i = C.tid >> 3, c8 = (C.tid & 7) * 8; const int t = rev ? (t0 + 63 - i) : (t0 + i);
#pragma unroll
    for (int dd = 0; dd < 3; ++dd) { const int tt = t + dd - 1; const int tc = tt < 0 ? 0 : (tt >= seq_len ? seq_len - 1 : tt); { const float wv_ = (tt == tc) ? 1.f : 0.f; if (dd == 0) R.wa = wv_; else if (dd == 1) R.wb = wv_; else R.wc = wv_; }
        const bf16* rp = pB + (size_t)(row0 + tc) * NB + h * 64 + c8;
        R.r[0][dd] = wantq ? *(const u32x4*)rp : (u32x4){0u, 0u, 0u, 0u}; R.r[1][dd] = *(const u32x4*)(rp + 256); R.r[2][dd] = *(const u32x4*)(rp + 512); }
    R.sb = 0.f; R.sa = 0.f;
    if (C.wave == 0) { const int tw = rev ? (t0 + 63 - C.lane) : (t0 + C.lane); const float* s = side + (size_t)(row0 + tw) * 24; R.sb = s[d * 4 + h]; R.sa = s[8 + d * 4 + h]; }
    return R;
}
constexpr int CW_OFF = 143360;
DI void dn_stage_cw(const Ctx& C, const float* convw, int h) { LAS float* cw = (LAS float*)(C.lds + CW_OFF);
    for (int i = C.tid; i < 576; i += NTHR) { const int dw = i >> 6, c = i & 63, dd = dw / 3, which = dw - dd * 3; cw[i] = convw[dd * 768 + which * 256 + h * 64 + c]; } }
DI void dn_consume(const Ctx& C, const DnLds& L, const DnRaw& R, float a_neg, float dtb, int h, bool wantq) {
    const LAS float* cw = (const LAS float*)(C.lds + CW_OFF);
    const int i = C.tid >> 3, c8 = (C.tid & 7) * 8;
#pragma unroll
    for (int which = 0; which < 3; ++which) {
        if (which == 0 && !wantq) continue;
        const int col = which * 256 + h * 64 + c8; float acc[8];
#pragma unroll
        for (int e = 0; e < 8; ++e) acc[e] = 0.f;
#pragma unroll
        for (int dd = 0; dd < 3; ++dd) { float x[8]; unpack8(R.r[which][dd], x); const LAS float* w = cw + (dd * 3 + which) * 64 + c8;
            const float wzd = dd == 0 ? R.wa : (dd == 1 ? R.wb : R.wc); const f32x4 w0 = *(const LAS f32x4*)w * wzd, w1 = *(const LAS f32x4*)(w + 4) * wzd;
            acc[0] += w0.x * x[0]; acc[1] += w0.y * x[1]; acc[2] += w0.z * x[2]; acc[3] += w0.w * x[3]; acc[4] += w1.x * x[4]; acc[5] += w1.y * x[5]; acc[6] += w1.z * x[6]; acc[7] += w1.w * x[7]; }
        float ss = 0.f;
#pragma unroll
        for (int e = 0; e < 8; ++e) { acc[e] = fsilu(acc[e]); ss += acc[e] * acc[e]; }
        if (which < 2) { ss += __shfl_xor(ss, 1); ss += __shfl_xor(ss, 2); ss += __shfl_xor(ss, 4); const float rr = __builtin_amdgcn_rsqf(ss + EPS) * (which == 0 ? 0.125f : 1.f);
#pragma unroll
            for (int e = 0; e < 8; ++e) acc[e] *= rr; }
        if (which == 0) *(LAS u32x4*)(L.Qb + i * BS + c8) = pack8(acc);
        else if (which == 1) { *(LAS u32x4*)(L.Kb + i * BS + c8) = pack8(acc);
            store_T8(L.KT, c8, i, C.tid & 7, pack8(acc));
            LAS float* dst = L.Ws + i * FS + c8; *(LAS f32x4*)dst = (f32x4){acc[0], acc[1], acc[2], acc[3]}; *(LAS f32x4*)(dst + 4) = (f32x4){acc[4], acc[5], acc[6], acc[7]}; }
        else { LAS float* dst = L.Us + i * FS + c8; *(LAS f32x4*)dst = (f32x4){acc[0], acc[1], acc[2], acc[3]}; *(LAS f32x4*)(dst + 4) = (f32x4){acc[4], acc[5], acc[6], acc[7]}; }
    }
    if (C.wave == 0) { L.bt[C.lane] = __builtin_amdgcn_rcpf(1.f + __expf(-R.sb));
        float v = a_neg * fsoftplus(R.sa + dtb);
#pragma unroll
        for (int o = 1; o < 64; o <<= 1) { const float tt = __shfl_up(v, o); if (C.lane >= o) v += tt; }
        L.gc[C.lane] = v; }
}
DI void dn_prepare(const Ctx& C, const DnLds& L, LAS bf16* Wb) {
    lds_sync();
    { const int i = C.tid >> 3, c8 = (C.tid & 7) * 8; const float b = L.bt[i], be = b * __expf(L.gc[i]);
#pragma unroll
        for (int e = 0; e < 8; ++e) { L.Us[i * FS + c8 + e] *= b; L.Ws[i * FS + c8 + e] *= be; } }
    { f32x4 c0 = Z4, c1 = Z4; mmb(c0, c1, L.Kb, L.Kb, C.wave, C.lane);
      MM_EPI(c0, c1, { L.As[row * FS + col] = col < row ? val * L.bt[row] * __expf(L.gc[row] - L.gc[col]) : 0.f; }); }
    lds_sync();
    tri_solve_blocked(C, L.As, L.Us, L.Ws, L.Dv, Wb);
}
DI void dn_phase1_item(const Ctx& C, int l, int item) {
    const DnLds L = dn_lds1(C.lds);
    const int v = item >> 3, h = (item >> 1) & 3, d = item & 1, b = v >> 4, tsc = v & 15;
    const bf16* pB = (const bf16*)(C.ws + WS_PB); const float* side = (const float*)(C.ws + WS_SIDE);
    const float* convw = C.in[16] + (size_t)l * 3 * 768; const float a_neg = -expf(C.in[17][l * 8 + d * 4 + h]), dtb = C.in[18][l * 8 + d * 4 + h];
    const int row0 = TC + b * 4096;
    LAS bf16* MtT = L.StT; LAS bf16* NtT = L.Qb;
    { const int i = C.tid >> 3, c8 = (C.tid & 7) * 8;
#pragma unroll
        for (int e = 0; e < 8; ++e) { const float mv = (i == c8 + e) ? 1.f : 0.f; L.Mt[i * LS + c8 + e] = mv; L.Nt[i * LS + c8 + e] = 0.f; MtT[(c8 + e) * BS + i] = tobf(mv); NtT[(c8 + e) * BS + i] = 0; } }
    dn_stage_cw(C, convw, h);
    DnRaw R = dn_fetch(C, pB, side, row0, 4096, tsc * 256 + 64 * (d ? 3 : 0), d, h, d, false);
    lds_sync();
#pragma unroll 1
    for (int cc = 0; cc < 4; ++cc) {
        dn_consume(C, L, R, a_neg, dtb, h, false);
        if (cc < 3) R = dn_fetch(C, pB, side, row0, 4096, tsc * 256 + 64 * (d ? 2 - cc : cc + 1), d, h, d, false);
        dn_prepare(C, L, L.Wb);
        const float glast = L.gc[63];
        { f32x4 c0 = Z4, c1 = Z4; mmb(c0, c1, L.Wb, MtT, C.wave, C.lane);
          MM_EPI(c0, c1, { L.VnT[col * BS + row] = tobf(-val * __expf(glast - L.gc[row])); }); }
        { f32x4 c0 = Z4, c1 = Z4; mmb(c0, c1, L.Wb, NtT, C.wave, C.lane);
          MM_EPI(c0, c1, { L.VnsT[col * BS + row] = tobf((L.Us[row * FS + col] - val) * __expf(glast - L.gc[row])); }); }
        lds_sync();
        const float eg = __expf(glast);
        { f32x4 c0 = Z4, c1 = Z4; mmb(c0, c1, L.KT, L.VnT, C.wave, C.lane);
          MM_EPI(c0, c1, { const float mn_ = L.Mt[row * LS + col] * eg + val; L.Mt[row * LS + col] = mn_; MtT[col * BS + row] = tobf(mn_); }); }
        { f32x4 c0 = Z4, c1 = Z4; mmb(c0, c1, L.KT, L.VnsT, C.wave, C.lane);
          MM_EPI(c0, c1, { const float nn_ = L.Nt[row * LS + col] * eg + val; L.Nt[row * LS + col] = nn_; NtT[col * BS + row] = tobf(nn_); }); }
        lds_sync();
    }
    float* mn = (float*)(C.ws + WS_MN) + (size_t)item * 8192;
    { const int i = C.tid >> 3, c8 = (C.tid & 7) * 8;
#pragma unroll
        for (int e = 0; e < 8; ++e) { mn[i * 64 + c8 + e] = L.Mt[i * LS + c8 + e]; mn[4096 + i * 64 + c8 + e] = L.Nt[i * LS + c8 + e]; } }
    __syncthreads();
}
DI void dn_scan_unit(const Ctx& C, int l, int unit) {
    LAS float* Ml = (LAS float*)C.lds; LAS float* Sl = Ml + 64 * LS;
    const int chain = unit >> 2, e0 = (unit & 3) * 16, b = chain >> 3, h = (chain >> 1) & 3, d = chain & 1;
    const float* s0 = C.in[3] + ((size_t)((b * 2 + l) * 2 + d) * 4 + h) * 4096;
    const int a = C.tid >> 3, e2 = (C.tid & 7) * 2, c8 = (C.tid & 7) * 8;
    float* base = (float*)(C.ws + WS_MN);
    Sl[a * 16 + e2] = s0[a * 64 + e0 + e2]; Sl[a * 16 + e2 + 1] = s0[a * 64 + e0 + e2 + 1];
    f32x4 m0, m1; float n0, n1;
    { const int tsc = d ? 15 : 0; const float* mg = base + (size_t)(((b * 16 + tsc) * 8) + h * 2 + d) * 8192;
      m0 = *(const f32x4*)(mg + a * 64 + c8); m1 = *(const f32x4*)(mg + a * 64 + c8 + 4); n0 = mg[4096 + a * 64 + e0 + e2]; n1 = mg[4096 + a * 64 + e0 + e2 + 1]; }
#pragma unroll 1
    for (int k = 0; k < 16; ++k) {
        const int tsc = d ? 15 - k : k; float* ng = base + (size_t)(((b * 16 + tsc) * 8) + h * 2 + d) * 8192 + 4096;
        *(LAS f32x4*)(Ml + a * LS + c8) = m0; *(LAS f32x4*)(Ml + a * LS + c8 + 4) = m1;
        float acc0 = n0, acc1 = n1;
        lds_sync();
        if (k < 15) { const int t2 = d ? 14 - k : k + 1; const float* mg = base + (size_t)(((b * 16 + t2) * 8) + h * 2 + d) * 8192;
            m0 = *(const f32x4*)(mg + a * 64 + c8); m1 = *(const f32x4*)(mg + a * 64 + c8 + 4); n0 = mg[4096 + a * 64 + e0 + e2]; n1 = mg[4096 + a * 64 + e0 + e2 + 1]; }
#pragma unroll 8
        for (int bb = 0; bb < 64; ++bb) { const float m = Ml[a * LS + bb]; acc0 += m * Sl[bb * 16 + e2]; acc1 += m * Sl[bb * 16 + e2 + 1]; }
        ng[a * 64 + e0 + e2] = Sl[a * 16 + e2]; ng[a * 64 + e0 + e2 + 1] = Sl[a * 16 + e2 + 1];
        lds_sync();
        Sl[a * 16 + e2] = acc0; Sl[a * 16 + e2 + 1] = acc1;
        lds_sync();
    }
    __syncthreads();
}
DI void dn_phase3_item(const Ctx& C, int l, int item) {
    const DnLds L = dn_lds3(C.lds);
    const int u = item >> 2, h = item & 3; const bool lat = u >= 32;
    const int v = u - 32, b = lat ? (v >> 4) : u, tsc = lat ? (v & 15) : 0;
    const int row0 = lat ? TC + b * 4096 : u * 256, seq_len = lat ? 4096 : 256, tbase = tsc * 256;
    const bf16* pB = (const bf16*)(C.ws + WS_PB); const float* side = (const float*)(C.ws + WS_SIDE); bf16* mix = (bf16*)(C.ws + WS_MIX); bf16* of = (bf16*)(C.ws + WS_XN);
    const float* convw = C.in[16] + (size_t)l * 3 * 768; const float* dnw = C.in[19] + l * 64;
    dn_stage_cw(C, convw, h);
    lds_sync();
#pragma unroll 1
    for (int d = 0; d < 2; ++d) {
        const float a_neg = -expf(C.in[17][l * 8 + d * 4 + h]), dtb = C.in[18][l * 8 + d * 4 + h];
        DnRaw R = dn_fetch(C, pB, side, row0, seq_len, tbase + 64 * (d ? 3 : 0), d, h, d, true);
        { const int i = C.tid >> 3, c8 = (C.tid & 7) * 8; const float* sin_ = lat ? (const float*)(C.ws + WS_MN) + (size_t)((v * 8) + h * 2 + d) * 8192 + 4096 : nullptr;
#pragma unroll
            for (int e = 0; e < 8; ++e) { const float sv = lat ? sin_[i * 64 + c8 + e] : 0.f; L.Ss[i * FS + c8 + e] = sv; L.StT[(c8 + e) * BS + i] = tobf(sv); } }
#pragma unroll 1
        for (int cc = 0; cc < 4; ++cc) {
            const int cloc = d ? 3 - cc : cc, t0 = tbase + 64 * cloc;
            u32x4 zr = {0u, 0u, 0u, 0u}, fv = {0u, 0u, 0u, 0u};
            if (d == 1) { const int i = C.tid >> 3, c8 = (C.tid & 7) * 8; const size_t grow = (size_t)row0 + t0 + 63 - i; zr = *(const u32x4*)(pB + grow * NB + 768 + h * 64 + c8);
                const unsigned* fp = (const unsigned*)(of + grow * 256 + h * 64 + c8);
                fv.x = __hip_atomic_load(fp, __ATOMIC_RELAXED, __HIP_MEMORY_SCOPE_AGENT); fv.y = __hip_atomic_load(fp + 1, __ATOMIC_RELAXED, __HIP_MEMORY_SCOPE_AGENT);
                fv.z = __hip_atomic_load(fp + 2, __ATOMIC_RELAXED, __HIP_MEMORY_SCOPE_AGENT); fv.w = __hip_atomic_load(fp + 3, __ATOMIC_RELAXED, __HIP_MEMORY_SCOPE_AGENT); }
            dn_consume(C, L, R, a_neg, dtb, h, true);
            if (cc < 3) R = dn_fetch(C, pB, side, row0, seq_len, tbase + 64 * (d ? 2 - cc : cc + 1), d, h, d, true);
            dn_prepare(C, L, L.Wb);
            const float glast = L.gc[63];
            f32x4 o0 = Z4, o1 = Z4;
            { f32x4 c0 = Z4, c1 = Z4; mmb(c0, c1, L.Wb, L.StT, C.wave, C.lane);
              MM_EPI(c0, c1, { const float vn = L.Us[row * FS + col] - val; L.VnT[col * BS + row] = tobf(vn); L.VnsT[col * BS + row] = tobf(vn * __expf(glast - L.gc[row])); }); }
            { f32x4 c0 = Z4, c1 = Z4; mmb(c0, c1, L.Qb, L.Kb, C.wave, C.lane);
              MM_EPI(c0, c1, { L.QKb[row * BS + col] = tobf(col <= row ? val * __expf(L.gc[row] - L.gc[col]) : 0.f); }); }
            { mmb(o0, o1, L.Qb, L.StT, C.wave, C.lane); const int q_ = C.lane >> 4, tr_ = C.wave >> 1;
#pragma unroll
              for (int j = 0; j < 4; ++j) { const float f = __expf(L.gc[tr_ * 16 + q_ * 4 + j]); o0[j] *= f; o1[j] *= f; } }
            lds_sync();
            { mmb(o0, o1, L.QKb, L.VnT, C.wave, C.lane);
              MM_EPI(o0, o1, { L.Us[row * FS + col] = val; }); }
            { f32x4 c0 = Z4, c1 = Z4; mmb(c0, c1, L.KT, L.VnsT, C.wave, C.lane); const float eg = __expf(glast);
              MM_EPI(c0, c1, { const float sn = L.Ss[row * FS + col] * eg + val; L.Ss[row * FS + col] = sn; L.StT[col * BS + row] = tobf(sn); }); }
            lds_sync();
            { const int i = C.tid >> 3, c8 = (C.tid & 7) * 8; float o[8];
#pragma unroll
              for (int e = 0; e < 8; ++e) o[e] = L.Us[i * FS + c8 + e];
              if (d == 0) { const size_t grow = (size_t)row0 + t0 + i; *(u32x4*)(of + grow * 256 + h * 64 + c8) = pack8(o); }
              else { const size_t grow = (size_t)row0 + t0 + 63 - i;
                  float f8[8]; unpack8(fv, f8); float ss = 0.f;
#pragma unroll
                  for (int e = 0; e < 8; ++e) { o[e] += f8[e]; ss += o[e] * o[e]; }
                  ss += __shfl_xor(ss, 1); ss += __shfl_xor(ss, 2); ss += __shfl_xor(ss, 4);
                  const float rstd = rsqrtf(ss * (1.f / 64) + EPS);
                  float z[8]; unpack8(zr, z);
#pragma unroll
                  for (int e = 0; e < 8; ++e) o[e] = o[e] * rstd * dnw[c8 + e] * fsilu(z[e]);
                  *(u32x4*)(mix + grow * D + h * 64 + c8) = pack8(o); } }
        }
        if (!lat) { float* o = C.out + O_SDN + ((size_t)((u * 2 + l) * 2 + d) * 4 + h) * 4096; const int i = C.tid >> 3, c8 = (C.tid & 7) * 8;
#pragma unroll
            for (int e = 0; e < 8; ++e) o[i * 64 + c8 + e] = L.Ss[i * FS + c8 + e]; }
        __syncthreads();
    }
}
struct SsLds { LAS float *Xs, *Hs, *ac, *dts, *gr; LAS bf16 *Cb, *Bb, *BT, *XT, *XfT, *Hb, *Scb, *Hb2; };
DI SsLds ss_lds(LAS unsigned char* l) { SsLds L; L.Xs = (LAS float*)l; L.Hs = (LAS float*)(l + FTB); LAS unsigned char* b = l + 2 * FTB;
    L.Cb = (LAS bf16*)b; L.Bb = (LAS bf16*)(b + BTB); L.BT = (LAS bf16*)(b + 2 * BTB); L.XT = (LAS bf16*)(b + 3 * BTB); L.XfT = (LAS bf16*)(b + 4 * BTB); L.Hb = (LAS bf16*)(b + 5 * BTB); L.Scb = (LAS bf16*)(b + 6 * BTB);
    L.Hb2 = (LAS bf16*)(b + 7 * BTB); L.ac = (LAS float*)(b + 8 * BTB); L.dts = L.ac + 64; L.gr = L.dts + 64; return L; }
struct SsRaw { u32x4 r[3][3]; float wa, wb, wc; float sd; };
DI SsRaw ss_fetch(const Ctx& C, const bf16* pB, const float* side, int row0, int seq_len, int t0, int rev, int h, int d, bool wantc) {
    SsRaw R; const int i = C.tid >> 3, c8 = (C.tid & 7) * 8; const int t = rev ? (t0 + 63 - i) : (t0 + i); const int g = h >> 1;
#pragma unroll
    for (int dd = 0; dd < 3; ++dd) { const int tt = t + dd - 1; const int tc = tt < 0 ? 0 : (tt >= seq_len ? seq_len - 1 : tt); { const float wv_ = (tt == tc) ? 1.f : 0.f; if (dd == 0) R.wa = wv_; else if (dd == 1) R.wb = wv_; else R.wc = wv_; }
        const bf16* rp = pB + (size_t)(row0 + tc) * NB + 1296 + c8;
        R.r[0][dd] = *(const u32x4*)(rp + h * 64); R.r[1][dd] = *(const u32x4*)(rp + 256 + g * 64); R.r[2][dd] = wantc ? *(const u32x4*)(rp + 384 + g * 64) : (u32x4){0u, 0u, 0u, 0u}; }
    R.sd = 0.f;
    if (C.wave == 0) { const int tw = rev ? (t0 + 63 - C.lane) : (t0 + C.lane); R.sd = side[(size_t)(row0 + tw) * 24 + 16 + d * 4 + h]; }
    return R;
}
DI void ss_stage_cw(const Ctx& C, const float* convw, const float* convb, int h) { LAS float* cw = (LAS float*)(C.lds + CW_OFF); const int g = h >> 1;
    for (int i = C.tid; i < 768; i += NTHR) { const int j = i < 576 ? i : i - 576, dw = j >> 6, c = j & 63, dd = dw / 3, which = i < 576 ? dw - dd * 3 : dw;
        const int ch = (which == 0 ? h * 64 : which == 1 ? 256 + g * 64 : 384 + g * 64) + c; cw[i] = i < 576 ? convw[dd * 512 + ch] : convb[ch]; } }
DI void ss_consume(const Ctx& C, const SsLds& L, const SsRaw& R, float a_neg, float dtb, int h, bool wantc) {
    const LAS float* cw = (const LAS float*)(C.lds + CW_OFF);
    const int i = C.tid >> 3, c8 = (C.tid & 7) * 8; const int g = h >> 1;
#pragma unroll
    for (int which = 0; which < 3; ++which) {
        if (which == 2 && !wantc) continue;
        const int ch = (which == 0 ? h * 64 : which == 1 ? 256 + g * 64 : 384 + g * 64) + c8; float acc[8];
        { const f32x4 b0 = *(const LAS f32x4*)(cw + 576 + which * 64 + c8), b1 = *(const LAS f32x4*)(cw + 576 + which * 64 + c8 + 4); acc[0] = b0.x; acc[1] = b0.y; acc[2] = b0.z; acc[3] = b0.w; acc[4] = b1.x; acc[5] = b1.y; acc[6] = b1.z; acc[7] = b1.w; }
#pragma unroll
        for (int dd = 0; dd < 3; ++dd) { float x[8]; unpack8(R.r[which][dd], x); const LAS float* w = cw + (dd * 3 + which) * 64 + c8;
            const float wzd = dd == 0 ? R.wa : (dd == 1 ? R.wb : R.wc); const f32x4 w0 = *(const LAS f32x4*)w * wzd, w1 = *(const LAS f32x4*)(w + 4) * wzd;
            acc[0] += w0.x * x[0]; acc[1] += w0.y * x[1]; acc[2] += w0.z * x[2]; acc[3] += w0.w * x[3]; acc[4] += w1.x * x[4]; acc[5] += w1.y * x[5]; acc[6] += w1.z * x[6]; acc[7] += w1.w * x[7]; }
#pragma unroll
        for (int e = 0; e < 8; ++e) acc[e] = fsilu(acc[e]);
        if (which == 0) { LAS float* dst = L.Xs + i * FS + c8; *(LAS f32x4*)dst = (f32x4){acc[0], acc[1], acc[2], acc[3]}; *(LAS f32x4*)(dst + 4) = (f32x4){acc[4], acc[5], acc[6], acc[7]};
            store_T8(L.XT, c8, i, C.tid & 7, pack8(acc)); }
        else if (which == 1) { *(LAS u32x4*)(L.Bb + i * BS + c8) = pack8(acc);
            store_T8(L.BT, c8, i, C.tid & 7, pack8(acc)); }
        else *(LAS u32x4*)(L.Cb + i * BS + c8) = pack8(acc);
    }
    if (C.wave == 0) { const float dtv = fsoftplus(R.sd + dtb); L.dts[C.lane] = dtv;
        float v = a_neg * dtv;
#pragma unroll
        for (int o = 1; o < 64; o <<= 1) { const float tt = __shfl_up(v, o); if (C.lane >= o) v += tt; }
        L.ac[C.lane] = v; }
}
DI void ss_make_xf(const Ctx& C, const SsLds& L) {
    const int i = C.tid >> 3, c8 = (C.tid & 7) * 8; const float f = L.dts[i] * __expf(L.ac[63] - L.ac[i]);
    float xf[8];
#pragma unroll
    for (int e = 0; e < 8; ++e) xf[e] = L.Xs[i * FS + c8 + e] * f;
    store_T8(L.XfT, c8, i, C.tid & 7, pack8(xf));
}
DI void ss_phase1_item(const Ctx& C, int l, int item) {
    const SsLds L = ss_lds(C.lds);
    const int v = item >> 3, h = (item >> 1) & 3, d = item & 1, b = v >> 4, tsc = v & 15;
    const bf16* pB = (const bf16*)(C.ws + WS_PB); const float* side = (const float*)(C.ws + WS_SIDE);
    const float* convw = C.in[24] + (size_t)l * 3 * 512; const float* convb = C.in[25] + l * 512;
    const float a_neg = -expf(C.in[26][l * 8 + d * 4 + h]), dtb = C.in[27][l * 8 + d * 4 + h];
    const int row0 = TC + b * 4096;
    { const int i = C.tid >> 3, c8 = (C.tid & 7) * 8;
#pragma unroll
        for (int e = 0; e < 8; ++e) L.Hs[i * FS + c8 + e] = 0.f; }
    float dec = 0.f;
    ss_stage_cw(C, convw, convb, h);
    SsRaw R = ss_fetch(C, pB, side, row0, 4096, tsc * 256 + 64 * (d ? 3 : 0), d, h, d, false);
    lds_sync();
#pragma unroll 1
    for (int cc = 0; cc < 4; ++cc) {
        ss_consume(C, L, R, a_neg, dtb, h, false);
        if (cc < 3) R = ss_fetch(C, pB, side, row0, 4096, tsc * 256 + 64 * (d ? 2 - cc : cc + 1), d, h, d, false);
        lds_sync();
        const float alast = L.ac[63]; dec += alast;
        ss_make_xf(C, L);
        lds_sync();
        { f32x4 c0 = Z4, c1 = Z4; mmb(c0, c1, L.XfT, L.BT, C.wave, C.lane); const float eg = __expf(alast);
          MM_EPI(c0, c1, { L.Hs[row * FS + col] = L.Hs[row * FS + col] * eg + val; }); }
        lds_sync();
    }
    float* cs = (float*)(C.ws + WS_CS) + (size_t)item * 4096;
    { const int i = C.tid >> 3, c8 = (C.tid & 7) * 8;
#pragma unroll
        for (int e = 0; e < 8; ++e) cs[i * 64 + c8 + e] = L.Hs[i * FS + c8 + e]; }
    if (C.tid == 0) ((float*)(C.ws + WS_CD))[item] = expf(dec);
    __syncthreads();
}
DI void ss_scan(const Ctx& C, int l) {
    const int gid = C.bid * NTHR + C.tid; if (gid >= 32 * 4096) return;
    const int chain = gid >> 12, e = gid & 4095, b = chain >> 3, h = (chain >> 1) & 3, d = chain & 1;
    float st = C.in[6][((size_t)((b * 2 + l) * 2 + d) * 4 + h) * 4096 + e];
    float* cs = (float*)(C.ws + WS_CS); const float* cd = (const float*)(C.ws + WS_CD);
    for (int k = 0; k < 16; ++k) { const int tsc = d ? 15 - k : k; const size_t slot = (size_t)((b * 16 + tsc) * 8) + h * 2 + d;
        const float c = cs[slot * 4096 + e]; cs[slot * 4096 + e] = st; st = st * cd[slot] + c; }
}
DI void ss_phase3_item(const Ctx& C, int l, int item) {
    const SsLds L = ss_lds(C.lds);
    const int u = item >> 2, h = item & 3; const bool lat = u >= 32;
    const int v = u - 32, b = lat ? (v >> 4) : u, tsc = lat ? (v & 15) : 0;
    const int row0 = lat ? TC + b * 4096 : u * 256, seq_len = lat ? 4096 : 256, tbase = tsc * 256;
    const bf16* pB = (const bf16*)(C.ws + WS_PB); const float* side = (const float*)(C.ws + WS_SIDE); bf16* mix = (bf16*)(C.ws + WS_MIX); float* ssq = (float*)(C.ws + WS_SSQ); bf16* yf = (bf16*)(C.ws + WS_XN) + (size_t)T * 256;
    const float* convw = C.in[24] + (size_t)l * 3 * 512; const float* convb = C.in[25] + l * 512; const float Dh = C.in[28][l * 4 + h];
    ss_stage_cw(C, convw, convb, h);
    lds_sync();
#pragma unroll 1
    for (int d = 0; d < 2; ++d) {
        const float a_neg = -expf(C.in[26][l * 8 + d * 4 + h]), dtb = C.in[27][l * 8 + d * 4 + h];
        SsRaw R = ss_fetch(C, pB, side, row0, seq_len, tbase + 64 * (d ? 3 : 0), d, h, d, true);
        { const int i = C.tid >> 3, c8 = (C.tid & 7) * 8; const float* sin_ = lat ? (const float*)(C.ws + WS_CS) + (size_t)((v * 8) + h * 2 + d) * 4096 : nullptr;
#pragma unroll
            for (int e = 0; e < 8; ++e) { const float sv = lat ? sin_[i * 64 + c8 + e] : 0.f; L.Hs[i * FS + c8 + e] = sv; L.Hb[i * BS + c8 + e] = tobf(sv); } }
#pragma unroll 1
        for (int cc = 0; cc < 4; ++cc) {
            LAS bf16* hb_cur = (cc & 1) ? L.Hb2 : L.Hb; LAS bf16* hb_nxt = (cc & 1) ? L.Hb : L.Hb2;
            const int cloc = d ? 3 - cc : cc, t0 = tbase + 64 * cloc;
            u32x4 zr = {0u, 0u, 0u, 0u}, fv = {0u, 0u, 0u, 0u};
            if (d == 1) { const int i = C.tid >> 3, c8 = (C.tid & 7) * 8; const size_t grow = (size_t)row0 + t0 + 63 - i; zr = *(const u32x4*)(pB + grow * NB + 1040 + h * 64 + c8);
                const unsigned* fp = (const unsigned*)(yf + grow * 256 + h * 64 + c8);
                fv.x = __hip_atomic_load(fp, __ATOMIC_RELAXED, __HIP_MEMORY_SCOPE_AGENT); fv.y = __hip_atomic_load(fp + 1, __ATOMIC_RELAXED, __HIP_MEMORY_SCOPE_AGENT);
                fv.z = __hip_atomic_load(fp + 2, __ATOMIC_RELAXED, __HIP_MEMORY_SCOPE_AGENT); fv.w = __hip_atomic_load(fp + 3, __ATOMIC_RELAXED, __HIP_MEMORY_SCOPE_AGENT); }
            ss_consume(C, L, R, a_neg, dtb, h, true);
            if (cc < 3) R = ss_fetch(C, pB, side, row0, seq_len, tbase + 64 * (d ? 2 - cc : cc + 1), d, h, d, true);
            lds_sync();
            const float alast = L.ac[63];
            ss_make_xf(C, L);
            { f32x4 c0 = Z4, c1 = Z4; mmb(c0, c1, L.Cb, L.Bb, C.wave, C.lane);
              MM_EPI(c0, c1, { L.Scb[row * BS + col] = tobf(col <= row ? val * __expf(L.ac[row] - L.ac[col]) * L.dts[col] : 0.f); }); }
            lds_sync();
            { f32x4 c0 = Z4, c1 = Z4; mmb(c0, c1, L.Cb, hb_cur, C.wave, C.lane);
              { const int q_ = C.lane >> 4, tr_ = C.wave >> 1;
#pragma unroll
                for (int j = 0; j < 4; ++j) { const float f = __expf(L.ac[tr_ * 16 + q_ * 4 + j]); c0[j] *= f; c1[j] *= f; } }
              mmb(c0, c1, L.Scb, L.XT, C.wave, C.lane);
              MM_EPI(c0, c1, { L.Xs[row * FS + col] = d == 0 ? val + Dh * L.Xs[row * FS + col] : val; }); }
            { f32x4 c0 = Z4, c1 = Z4; mmb(c0, c1, L.XfT, L.BT, C.wave, C.lane); const float eg = __expf(alast);
              MM_EPI(c0, c1, { const float hn = L.Hs[row * FS + col] * eg + val; L.Hs[row * FS + col] = hn; hb_nxt[row * BS + col] = tobf(hn); }); }
            lds_sync();
            { const int i = C.tid >> 3, c8 = (C.tid & 7) * 8; float o[8];
#pragma unroll
              for (int e = 0; e < 8; ++e) o[e] = L.Xs[i * FS + c8 + e];
              if (d == 0) { const size_t grow = (size_t)row0 + t0 + i; *(u32x4*)(yf + grow * 256 + h * 64 + c8) = pack8(o); }
              else { const size_t grow = (size_t)row0 + t0 + 63 - i;
                  float f8[8], z[8]; unpack8(fv, f8); unpack8(zr, z); float ss = 0.f;
#pragma unroll
                  for (int e = 0; e < 8; ++e) { o[e] = (o[e] + f8[e]) * fsilu(z[e]); ss += o[e] * o[e]; }
                  ss += __shfl_xor(ss, 1); ss += __shfl_xor(ss, 2); ss += __shfl_xor(ss, 4);
                  *(u32x4*)(mix + grow * D + 512 + h * 64 + c8) = pack8(o);
                  if ((C.tid & 7) == 0) ssq[grow * 4 + h] = ss; } }
        }
        if (!lat) { float* o = C.out + O_SSM + ((size_t)((u * 2 + l) * 2 + d) * 4 + h) * 4096; const int i = C.tid >> 3, c8 = (C.tid & 7) * 8;
#pragma unroll
            for (int e = 0; e < 8; ++e) o[i * 64 + c8 + e] = L.Hs[i * FS + c8 + e]; }
        __syncthreads();
    }
}
DI void ssd_fix_rows(const Ctx& C, int l, int r0, int nrows, int g_lo, int g_n) {
    bf16* mix = (bf16*)(C.ws + WS_MIX); const unsigned* ssq = (const unsigned*)(C.ws + WS_SSQ); const float* nw = C.in[29] + l * 256;
    const int per_row = g_n * 16;
    for (int i = C.tid; i < nrows * per_row; i += NTHR) { const int row = r0 + i / per_row, cc = i % per_row, g = g_lo + (cc >> 4), c8 = (g * 16 + (cc & 15)) * 8;
        const float s0 = __builtin_bit_cast(float, __hip_atomic_load(ssq + (size_t)row * 4 + 2 * g, __ATOMIC_RELAXED, __HIP_MEMORY_SCOPE_AGENT));
        const float s1 = __builtin_bit_cast(float, __hip_atomic_load(ssq + (size_t)row * 4 + 2 * g + 1, __ATOMIC_RELAXED, __HIP_MEMORY_SCOPE_AGENT));
        const float rstd = rsqrtf((s0 + s1) * (1.f / 128) + EPS);
        unsigned* p = (unsigned*)(mix + (size_t)row * D + 512 + c8); u32x4 v;
        v.x = __hip_atomic_load(p, __ATOMIC_RELAXED, __HIP_MEMORY_SCOPE_AGENT); v.y = __hip_atomic_load(p + 1, __ATOMIC_RELAXED, __HIP_MEMORY_SCOPE_AGENT);
        v.z = __hip_atomic_load(p + 2, __ATOMIC_RELAXED, __HIP_MEMORY_SCOPE_AGENT); v.w = __hip_atomic_load(p + 3, __ATOMIC_RELAXED, __HIP_MEMORY_SCOPE_AGENT);
        float x[8]; unpack8(v, x);
#pragma unroll
        for (int e = 0; e < 8; ++e) x[e] *= rstd * nw[c8 + e];
        *(u32x4*)p = pack8(x); }
}
DI void phase_ssd_fix(const Ctx& C, int l) {
    bf16* mix = (bf16*)(C.ws + WS_MIX); const float* ssq = (const float*)(C.ws + WS_SSQ); const float* nw = C.in[29] + l * 256;
    const int gt = C.bid * NTHR + C.tid, NGT = C.G * NTHR;
    for (int i = gt; i < T * 32; i += NGT) { const int row = i >> 5, c8 = (i & 31) * 8, g = c8 >> 7;
        const float rstd = rsqrtf((ssq[(size_t)row * 4 + 2 * g] + ssq[(size_t)row * 4 + 2 * g + 1]) * (1.f / 128) + EPS);
        bf16* p = mix + (size_t)row * D + 512 + c8; float x[8]; ld8(p, x);
#pragma unroll
        for (int e = 0; e < 8; ++e) x[e] *= rstd * nw[c8 + e];
        *(u32x4*)p = pack8(x); }
}
struct KVSeg { const bf16* k; int ldk; const bf16* kr; int ldkr; const bf16* v; int ldv; int nkeys; int rope; int pos0; int win; };
constexpr int VSB = 136;
struct Stage { u32x4 k0, k1, v; };
template <int MODE> DI Stage kv_gload(const bf16* sk, int ldk, const bf16* skr, int ldkr, const bf16* sv, int ldv, int k0, int tid) {
    Stage st; const int key = tid >> 3, c = tid & 7;
    st.v = *(const u32x4*)(sv + (size_t)(k0 + key) * ldv + c * 8);
    st.k0 = *(const u32x4*)(sk + (size_t)(k0 + key) * ldk + c * 8);
    if (MODE == 0) { const int kk = (tid & 255) >> 2, j = tid & 3; st.k1 = *(const u32x4*)(skr + (size_t)(k0 + kk) * ldkr + j * 8); } else st.k1 = st.k0;
    return st;
}
template <int MODE> DI void kv_lstore(const Stage st, LAS unsigned char* Kl, LAS unsigned char* Vl, int KSB, int tid) {
    const int key = tid >> 3, c = tid & 7;
    { LAS bf16* vt = (LAS bf16*)Vl;
      vt[(c * 8 + 0) * (VSB / 2) + key] = (bf16)(st.v.x & 0xffffu); vt[(c * 8 + 1) * (VSB / 2) + key] = (bf16)(st.v.x >> 16);
      vt[(c * 8 + 2) * (VSB / 2) + key] = (bf16)(st.v.y & 0xffffu); vt[(c * 8 + 3) * (VSB / 2) + key] = (bf16)(st.v.y >> 16);
      vt[(c * 8 + 4) * (VSB / 2) + key] = (bf16)(st.v.z & 0xffffu); vt[(c * 8 + 5) * (VSB / 2) + key] = (bf16)(st.v.z >> 16);
      vt[(c * 8 + 6) * (VSB / 2) + key] = (bf16)(st.v.w & 0xffffu); vt[(c * 8 + 7) * (VSB / 2) + key] = (bf16)(st.v.w >> 16); }
    *(LAS u32x4*)(Kl + key * KSB + c * 16) = st.k0;
    if (MODE == 0) { if (tid < 256) { const int kk = tid >> 2, j = tid & 3; *(LAS u32x4*)(Kl + kk * KSB + 128 + j * 16) = st.k1; } }
}
template <int MODE>
DI void attn_unit(const Ctx& C, const bf16* qb0, const bf16* qb1, int ldq, int ro0, int ro1, int qrope, int qpos0, float qscale,
                  const KVSeg s0, const KVSeg s1, int nseg, float sink0, float sink1, bf16* ob0, bf16* ob1, int ldo, const float* cosT, const float* sinT) {
    constexpr int DQK = MODE == 0 ? 96 : 64, NKS = DQK / 32, KSB = (DQK + 8) * 2;
    constexpr int TILEB = 64 * KSB + 64 * VSB;
    LAS unsigned char* Kl0 = C.lds; LAS unsigned char* Vl0 = C.lds + 64 * KSB;
    const int lane = C.lane, r = lane & 15, quad = lane >> 4, tid = C.tid;
    bf16x8 qf[2][NKS]; int qpos[2];
#pragma unroll
    for (int sq = 0; sq < 2; ++sq) { const int row = (sq ? ro1 : ro0) + r; qpos[sq] = qpos0 + row; const bf16* qp = (sq ? qb1 : qb0) + (size_t)row * ldq;
#pragma unroll
        for (int ks = 0; ks < NKS; ++ks) { float x[8];
            if (MODE == 0) { if (ks < 2 || !qrope) ld8(qp + ks * 32 + quad * 8, x);
                else { float x1[8], x2[8]; ld8(qp + 64 + (quad & 1) * 8, x1); ld8(qp + 80 + (quad & 1) * 8, x2); const float* cs = cosT + qpos[sq] * 16 + (quad & 1) * 8; const float* sn = sinT + qpos[sq] * 16 + (quad & 1) * 8;
#pragma unroll
                    for (int e = 0; e < 8; ++e) x[e] = quad < 2 ? x1[e] * cs[e] - x2[e] * sn[e] : x1[e] * sn[e] + x2[e] * cs[e]; } }
            else { if (!qrope) ld8(qp + ks * 32 + quad * 8, x);
                else { float x1[8], x2[8]; ld8(qp + quad * 8, x1); ld8(qp + 32 + quad * 8, x2); const float* cs = cosT + qpos[sq] * 32 + quad * 8; const float* sn = sinT + qpos[sq] * 32 + quad * 8;
#pragma unroll
                    for (int e = 0; e < 8; ++e) x[e] = ks == 0 ? x1[e] * cs[e] - x2[e] * sn[e] : x1[e] * sn[e] + x2[e] * cs[e]; } }
#pragma unroll
            for (int e = 0; e < 8; ++e) x[e] *= qscale;
            qf[sq][ks] = __builtin_bit_cast(bf16x8, pack8(x)); } }
    f32x4 oacc[2][4]; float mrun[2], lrun[2];
#pragma unroll
    for (int sq = 0; sq < 2; ++sq) { mrun[sq] = -1e30f; lrun[sq] = 0.f;
#pragma unroll
        for (int dt = 0; dt < 4; ++dt) oacc[sq][dt] = Z4; }
    const int nt0 = s0.nkeys >> 6, ntt = nt0 + (nseg > 1 ? (s1.nkeys >> 6) : 0);
#define SEGSEL(ti_) const bool second_ = (ti_) >= nt0; const int k0_ = (second_ ? (ti_) - nt0 : (ti_)) * 64; \
        const bf16* sk_ = second_ ? s1.k : s0.k; const int ldk_ = second_ ? s1.ldk : s0.ldk; const bf16* skr_ = second_ ? s1.kr : s0.kr; const int ldkr_ = second_ ? s1.ldkr : s0.ldkr; \
        const bf16* sv_ = second_ ? s1.v : s0.v; const int ldv_ = second_ ? s1.ldv : s0.ldv; const int rope_ = second_ ? s1.rope : s0.rope; const int pos0_ = second_ ? s1.pos0 : s0.pos0; const int swin = second_ ? s1.win : s0.win;
    Stage stA, stB;
    { const int tn = 0; const bool sec2 = tn >= nt0; const int k02 = (sec2 ? tn - nt0 : tn) * 64; stA = kv_gload<MODE>(sec2 ? s1.k : s0.k, sec2 ? s1.ldk : s0.ldk, sec2 ? s1.kr : s0.kr, sec2 ? s1.ldkr : s0.ldkr, sec2 ? s1.v : s0.v, sec2 ? s1.ldv : s0.ldv, k02, tid); stB = stA; }
    kv_lstore<MODE>(stA, Kl0, Vl0, KSB, tid);
    { const int tn = 1; if (tn < ntt) { const bool sec2 = tn >= nt0; const int k02 = (sec2 ? tn - nt0 : tn) * 64; stA = kv_gload<MODE>(sec2 ? s1.k : s0.k, sec2 ? s1.ldk : s0.ldk, sec2 ? s1.kr : s0.kr, sec2 ? s1.ldkr : s0.ldkr, sec2 ? s1.v : s0.v, sec2 ? s1.ldv : s0.ldv, k02, tid); } }
    { const int tn = 2; if (tn < ntt) { const bool sec2 = tn >= nt0; const int k02 = (sec2 ? tn - nt0 : tn) * 64; stB = kv_gload<MODE>(sec2 ? s1.k : s0.k, sec2 ? s1.ldk : s0.ldk, sec2 ? s1.kr : s0.kr, sec2 ? s1.ldkr : s0.ldkr, sec2 ? s1.v : s0.v, sec2 ? s1.ldv : s0.ldv, k02, tid); } }
    lds_sync();
    for (int ti0 = 0; ti0 < ntt; ti0 += 2) {
        { const int ti = ti0;
        { if (ti + 1 < ntt) kv_lstore<MODE>(stA, Kl0 + ((ti + 1) & 1) * TILEB, Vl0 + ((ti + 1) & 1) * TILEB, KSB, tid);
        { const int tn = ti + 3; if (tn < ntt) { const bool sec2 = tn >= nt0; const int k02 = (sec2 ? tn - nt0 : tn) * 64; stA = kv_gload<MODE>(sec2 ? s1.k : s0.k, sec2 ? s1.ldk : s0.ldk, sec2 ? s1.kr : s0.kr, sec2 ? s1.ldkr : s0.ldkr, sec2 ? s1.v : s0.v, sec2 ? s1.ldv : s0.ldv, k02, tid); } }
        LAS unsigned char* Kl = Kl0 + (ti & 1) * TILEB; LAS unsigned char* Vl = Vl0 + (ti & 1) * TILEB;
        SEGSEL(ti)
        (void)sk_; (void)ldk_; (void)skr_; (void)ldkr_; (void)sv_; (void)ldv_; (void)rope_;
        const int kpos0 = pos0_ + k0_;
        f32x4 sacc[2][4];
#pragma unroll
        for (int sq = 0; sq < 2; ++sq)
#pragma unroll
            for (int nt = 0; nt < 4; ++nt) sacc[sq][nt] = Z4;
#pragma unroll
        for (int ks = 0; ks < NKS; ++ks)
#pragma unroll
            for (int nt = 0; nt < 4; ++nt) { const bf16x8 kf = *(const LAS bf16x8*)(Kl + (nt * 16 + r) * KSB + (ks * 32 + quad * 8) * 2);
                sacc[0][nt] = __builtin_amdgcn_mfma_f32_16x16x32_bf16(kf, qf[0][ks], sacc[0][nt], 0, 0, 0);
                sacc[1][nt] = __builtin_amdgcn_mfma_f32_16x16x32_bf16(kf, qf[1][ks], sacc[1][nt], 0, 0, 0); }
        bf16x8 pb[2][2];
#pragma unroll
        for (int sq = 0; sq < 2; ++sq) {
            float mx = -1e30f;
#pragma unroll
            for (int nt = 0; nt < 4; ++nt)
#pragma unroll
                for (int j = 0; j < 4; ++j) { float s = sacc[sq][nt][j];
                    if (swin) { const int dk = kpos0 + nt * 16 + quad * 4 + j - qpos[sq]; if (dk > 128 || dk < -128) s = -1e30f; sacc[sq][nt][j] = s; }
                    mx = fmaxf(mx, s); }
            mx = fmaxf(mx, __shfl_xor(mx, 16)); mx = fmaxf(mx, __shfl_xor(mx, 32));
            const float mnew = fmaxf(mrun[sq], mx), alpha = __builtin_amdgcn_exp2f(mrun[sq] - mnew); mrun[sq] = mnew;
            float ps = 0.f; float p[16];
#pragma unroll
            for (int nt = 0; nt < 4; ++nt)
#pragma unroll
                for (int j = 0; j < 4; ++j) { const float e = __builtin_amdgcn_exp2f(sacc[sq][nt][j] - mnew); p[nt * 4 + j] = e; ps += e; }
            lrun[sq] = lrun[sq] * alpha + ps;
#pragma unroll
            for (int dt = 0; dt < 4; ++dt) oacc[sq][dt] *= alpha;
            pb[sq][0] = __builtin_bit_cast(bf16x8, pack8(p)); pb[sq][1] = __builtin_bit_cast(bf16x8, pack8(p + 8));
        }
#pragma unroll
        for (int m2 = 0; m2 < 2; ++m2)
#pragma unroll
            for (int dt = 0; dt < 4; ++dt) { const LAS unsigned char* vp = Vl + (dt * 16 + r) * VSB + (32 * m2 + 4 * quad) * 2;
                const u32x2 lo = *(const LAS u32x2*)vp, hi = *(const LAS u32x2*)(vp + 32);
                const bf16x8 av = __builtin_bit_cast(bf16x8, (u32x4){lo.x, lo.y, hi.x, hi.y});
                oacc[0][dt] = __builtin_amdgcn_mfma_f32_16x16x32_bf16(av, pb[0][m2], oacc[0][dt], 0, 0, 0);
                oacc[1][dt] = __builtin_amdgcn_mfma_f32_16x16x32_bf16(av, pb[1][m2], oacc[1][dt], 0, 0, 0); }

        lds_sync(); }
        }
        if (ti0 + 1 < ntt) { const int ti = ti0 + 1;
        { if (ti + 1 < ntt) kv_lstore<MODE>(stB, Kl0 + ((ti + 1) & 1) * TILEB, Vl0 + ((ti + 1) & 1) * TILEB, KSB, tid);
        { const int tn = ti + 3; if (tn < ntt) { const bool sec2 = tn >= nt0; const int k02 = (sec2 ? tn - nt0 : tn) * 64; stB = kv_gload<MODE>(sec2 ? s1.k : s0.k, sec2 ? s1.ldk : s0.ldk, sec2 ? s1.kr : s0.kr, sec2 ? s1.ldkr : s0.ldkr, sec2 ? s1.v : s0.v, sec2 ? s1.ldv : s0.ldv, k02, tid); } }
        LAS unsigned char* Kl = Kl0 + (ti & 1) * TILEB; LAS unsigned char* Vl = Vl0 + (ti & 1) * TILEB;
        SEGSEL(ti)
        (void)sk_; (void)ldk_; (void)skr_; (void)ldkr_; (void)sv_; (void)ldv_; (void)rope_;
        const int kpos0 = pos0_ + k0_;
        f32x4 sacc[2][4];
#pragma unroll
        for (int sq = 0; sq < 2; ++sq)
#pragma unroll
            for (int nt = 0; nt < 4; ++nt) sacc[sq][nt] = Z4;
#pragma unroll
        for (int ks = 0; ks < NKS; ++ks)
#pragma unroll
            for (int nt = 0; nt < 4; ++nt) { const bf16x8 kf = *(const LAS bf16x8*)(Kl + (nt * 16 + r) * KSB + (ks * 32 + quad * 8) * 2);
                sacc[0][nt] = __builtin_amdgcn_mfma_f32_16x16x32_bf16(kf, qf[0][ks], sacc[0][nt], 0, 0, 0);
                sacc[1][nt] = __builtin_amdgcn_mfma_f32_16x16x32_bf16(kf, qf[1][ks], sacc[1][nt], 0, 0, 0); }
        bf16x8 pb[2][2];
#pragma unroll
        for (int sq = 0; sq < 2; ++sq) {
            float mx = -1e30f;
#pragma unroll
            for (int nt = 0; nt < 4; ++nt)
#pragma unroll
                for (int j = 0; j < 4; ++j) { float s = sacc[sq][nt][j];
                    if (swin) { const int dk = kpos0 + nt * 16 + quad * 4 + j - qpos[sq]; if (dk > 128 || dk < -128) s = -1e30f; sacc[sq][nt][j] = s; }
                    mx = fmaxf(mx, s); }
            mx = fmaxf(mx, __shfl_xor(mx, 16)); mx = fmaxf(mx, __shfl_xor(mx, 32));
            const float mnew = fmaxf(mrun[sq], mx), alpha = __builtin_amdgcn_exp2f(mrun[sq] - mnew); mrun[sq] = mnew;
            float ps = 0.f; float p[16];
#pragma unroll
            for (int nt = 0; nt < 4; ++nt)
#pragma unroll
                for (int j = 0; j < 4; ++j) { const float e = __builtin_amdgcn_exp2f(sacc[sq][nt][j] - mnew); p[nt * 4 + j] = e; ps += e; }
            lrun[sq] = lrun[sq] * alpha + ps;
#pragma unroll
            for (int dt = 0; dt < 4; ++dt) oacc[sq][dt] *= alpha;
            pb[sq][0] = __builtin_bit_cast(bf16x8, pack8(p)); pb[sq][1] = __builtin_bit_cast(bf16x8, pack8(p + 8));
        }
#pragma unroll
        for (int m2 = 0; m2 < 2; ++m2)
#pragma unroll
            for (int dt = 0; dt < 4; ++dt) { const LAS unsigned char* vp = Vl + (dt * 16 + r) * VSB + (32 * m2 + 4 * quad) * 2;
                const u32x2 lo = *(const LAS u32x2*)vp, hi = *(const LAS u32x2*)(vp + 32);
                const bf16x8 av = __builtin_bit_cast(bf16x8, (u32x4){lo.x, lo.y, hi.x, hi.y});
                oacc[0][dt] = __builtin_amdgcn_mfma_f32_16x16x32_bf16(av, pb[0][m2], oacc[0][dt], 0, 0, 0);
                oacc[1][dt] = __builtin_amdgcn_mfma_f32_16x16x32_bf16(av, pb[1][m2], oacc[1][dt], 0, 0, 0); }

        lds_sync(); }
        }
    }
#pragma unroll
    for (int sq = 0; sq < 2; ++sq) { float l = lrun[sq]; l += __shfl_xor(l, 16); l += __shfl_xor(l, 32);
        const float sk = sq ? sink1 : sink0; if (sk > -1e29f) l += __builtin_amdgcn_exp2f(sk - mrun[sq]);
        const float inv = __builtin_amdgcn_rcpf(l); bf16* op = (sq ? ob1 : ob0) + (size_t)((sq ? ro1 : ro0) + r) * ldo;
#pragma unroll
        for (int dt = 0; dt < 4; ++dt) { u32x2 o; o.x = pk2(oacc[sq][dt][0] * inv, oacc[sq][dt][1] * inv); o.y = pk2(oacc[sq][dt][2] * inv, oacc[sq][dt][3] * inv); *(u32x2*)(op + dt * 16 + quad * 4) = o; } }
    __syncthreads();
}

DI void attn_phase_unit(const Ctx& C, int l, int u) {
    const bf16* pA = (const bf16*)(C.ws + WS_PA); const bf16* kv16 = (const bf16*)(C.ws + WS_KV16); const bf16* qraw = (const bf16*)(C.ws + WS_QRAW);
    const bf16* kpec = (const bf16*)(C.ws + WS_KPEC); const bf16* skc = (const bf16*)(C.ws + WS_SWAKC); const bf16* svc = (const bf16*)(C.ws + WS_SWAVC);
    bf16* mix = (bf16*)(C.ws + WS_MIX); const float* rt = (const float*)(C.ws + WS_ROPE);
    const float mla_qs = 0.10206207261596577f * LOG2E, swa_qs = 0.125f * LOG2E;
    KVSeg s0{}, s1{};
    if (u < 384) {
        const bool lat = u < 256; int b, h, qrow0, qpos0;
        if (lat) { b = u >> 6; h = (u >> 4) & 3; const int qt = u & 15; qrow0 = TC + b * 4096 + qt * 256; qpos0 = qt * 256; } else { const int v = u - 256; b = v >> 2; h = v & 3; qrow0 = b * 256; qpos0 = 0; }
        const int ro0 = C.wave * 32, ro1 = ro0 + 16;
        const bf16* qb = qraw + (size_t)qrow0 * 384 + h * 96; bf16* ob = mix + (size_t)qrow0 * D + 256 + h * 64;
        if (lat) { const int cr = T + b * 256, lr = TC + b * 4096;
            s0 = KVSeg{kv16 + (size_t)cr * 512 + h * 128, 512, kpec + (size_t)(b * 256) * 32, 32, kv16 + (size_t)cr * 512 + h * 128 + 64, 512, 256, 0, 0, 0};
            s1 = KVSeg{kv16 + (size_t)lr * 512 + h * 128, 512, (const bf16*)(C.ws + WS_KPER) + (size_t)(b * 4096) * 32, 32, kv16 + (size_t)lr * 512 + h * 128 + 64, 512, 4096, 0, 0, 0};
            attn_unit<0>(C, qb, qb, 384, ro0, ro1, 1, qpos0, mla_qs, s0, s1, 2, -1e30f, -1e30f, ob, ob, D, rt, rt + 65536);
        } else { const int cr = b * 256;
            s0 = KVSeg{kv16 + (size_t)cr * 512 + h * 128, 512, pA + (size_t)cr * NA + 384, NA, kv16 + (size_t)cr * 512 + h * 128 + 64, 512, 256, 0, 0, 0};
            attn_unit<0>(C, qb, qb, 384, ro0, ro1, 0, qpos0, mla_qs, s0, s0, 1, -1e30f, -1e30f, ob, ob, D, rt, rt + 65536); }
    } else {
        const bool lat = u >= 512; int b, kvh, qrow0, qpos0;
        if (lat) { const int v = u - 512; b = v >> 6; kvh = (v >> 5) & 1; const int qbk = v & 31; qrow0 = TC + b * 4096 + qbk * 128; qpos0 = qbk * 128; }
        else { const int v = u - 384; b = v >> 2; kvh = (v >> 1) & 1; const int qt = v & 1; qrow0 = b * 256 + qt * 128; qpos0 = qt * 128; }
        const int ro = C.wave * 16; const int h0 = kvh * 2;
        const bf16* qb0 = pA + (size_t)qrow0 * NA + 416 + h0 * 64; const bf16* qb1 = qb0 + 64;
        bf16* ob0 = mix + (size_t)qrow0 * D + 768 + h0 * 64; bf16* ob1 = ob0 + 64;
        const float sk0 = C.in[30][l * 4 + h0] * LOG2E, sk1 = C.in[30][l * 4 + h0 + 1] * LOG2E;
        if (lat) { const int lr = TC + b * 4096; int klo = qpos0 - 128, khi = qpos0 + 256; if (klo < 0) klo = 0; if (khi > 4096) khi = 4096;
            s0 = KVSeg{skc + (size_t)(b * 256) * 128 + kvh * 64, 128, nullptr, 0, svc + (size_t)(b * 256) * 128 + kvh * 64, 128, 256, 0, 0, 0};
            s1 = KVSeg{(const bf16*)(C.ws + WS_KSR) + (size_t)(b * 4096 + klo) * 128 + kvh * 64, 128, nullptr, 0, pA + (size_t)(lr + klo) * NA + 800 + kvh * 64, NA, khi - klo, 0, klo, 1};
            attn_unit<1>(C, qb0, qb1, NA, ro, ro, 1, qpos0, swa_qs, s0, s1, 2, sk0, sk1, ob0, ob1, D, rt + 131072, rt + 262144);
        } else { const int cr = b * 256;
            s0 = KVSeg{pA + (size_t)cr * NA + 672 + kvh * 64, NA, nullptr, 0, pA + (size_t)cr * NA + 800 + kvh * 64, NA, 256, 0, 0, 0};
            attn_unit<1>(C, qb0, qb1, NA, ro, ro, 0, qpos0, swa_qs, s0, s0, 1, sk0, sk1, ob0, ob1, D, rt + 131072, rt + 262144); }
    }
}
struct Args { const float* in[34]; float* out; unsigned char* ws; int ph_lo, ph_hi; };
constexpr int NPHASES = 1 + 2 * 13 + 1;

__global__ void __launch_bounds__(NTHR) mk_fwd(Args args) {
    extern __shared__ __attribute__((aligned(16))) unsigned char lds_raw[];
    Ctx C; C.in = args.in; C.out = args.out; C.ws = args.ws; C.lds = (LAS unsigned char*)lds_raw;
    const int wave0 = __builtin_amdgcn_readfirstlane((int)threadIdx.x >> 6); C.tid = 0; C.lane = 0; C.wave = 0; C.bid = blockIdx.x; C.G = gridDim.x;
    unsigned char* ws = args.ws;
    volatile LAS unsigned* bst = (volatile LAS unsigned*)(C.lds + LDS_BYTES - 16);
    if (threadIdx.x < 4) bst[threadIdx.x] = 0u;
    __syncthreads();
    XcdBarrier xbar = xcd_barrier_post((unsigned*)ws, bst);
    int ph = 0;
#define PH_BEGIN if (ph >= args.ph_lo && ph < args.ph_hi) { { int w_ = wave0; asm volatile("" : "+s"(w_)); C.wave = w_; { int ln_; asm volatile("v_mbcnt_lo_u32_b32 %0, -1, 0\n\tv_mbcnt_hi_u32_b32 %0, -1, %0" : "=v"(ln_)); C.lane = ln_; } C.tid = C.wave * 64 + C.lane; }
#define PH_END } { const bool inside_ = (ph >= args.ph_lo && ph + 1 < args.ph_hi); ++ph; if (inside_) { if (args.ph_hi < 0) { __threadfence(); cg::this_grid().sync(); } else xcd_barrier(xbar); } }
    const float* ada_all = (const float*)(ws + WS_ADA);
    PH_BEGIN phase_ada_rope(C); PH_END
#pragma unroll 1
    for (int l = 0; l < 2; ++l) {
        asm volatile("" : "+s"(l));
        const float* ada = ada_all + (size_t)l * 5 * 6144;
        const float* xc = l == 0 ? args.in[0] : args.out; const float* xl = l == 0 ? args.in[1] : args.out + (size_t)TC * D;
        PH_BEGIN if (l == 0) { int g2_ = C.G; asm volatile("" : "+s"(g2_)); phase_weights(C, 0, 1, C.bid, g2_); } phase_norm(C, xc, xl, args.in[10] + l * D, ada, 0, (bf16*)(ws + WS_XN)); PH_END
        PH_BEGIN { pg8::Gemm g{(const pg8::bf16_t*)(ws + WS_XN), (const pg8::bf16_t*)(ws + WS_WIN), T, 1024, 1024, 1024, C.tid}; pg8::StaticOrder S; S.init(T, 1024, C.G, C.bid);
            EpiP E{(bf16*)(ws + WS_PA), NA, NA, 0, l, args.out, nullptr}; pg8::gemm_phase<EpiP, pg8::StaticOrder, true, true>(C.lds, g, S, E);
            if (C.bid >= 128) { Ctx C2 = C; asm volatile("" : "+v"(C2.tid), "+v"(C2.lane)); phase_weights(C2, l, l == 0 ? 6 : 2, C.bid - 128, 128); } } PH_END
        PH_BEGIN phase_mla_prep(C, l); PH_END
        PH_BEGIN { int kq_ = 256; asm volatile("" : "+s"(kq_)); const int half_ = __builtin_amdgcn_readfirstlane(C.bid >= 128 ? 1 : 0);
            const bool q_ = half_ == 0;
            pg8::Gemm g{(const pg8::bf16_t*)(ws + (q_ ? WS_QN16 : WS_CKV16)), (const pg8::bf16_t*)(ws + (q_ ? WS_WUQ : WS_WUKV)), q_ ? T : NKV, 512, kq_, kq_, C.tid};
            pg8::StaticOrder S; S.init(q_ ? T : NKV, 512, 128, C.bid & 127);
            EpiRS E{(bf16*)(ws + (q_ ? WS_QRAW : WS_KV16)), q_ ? 384 : 512, q_ ? 384 : 512}; pg8::gemm_phase<EpiRS, pg8::StaticOrder, true, true>(C.lds, g, S, E); } PH_END
        PH_BEGIN for (int u = (C.bid & 7) * 32 + (C.bid >> 3); u < 768; u += 256) { Ctx C2 = C;     asm volatile("" : "+v"(C2.tid), "+v"(C2.lane)); attn_phase_unit(C2, l, u); } PH_END
        PH_BEGIN { pg8::Gemm g{(const pg8::bf16_t*)(ws + WS_XN), (const pg8::bf16_t*)(ws + WS_WIN) + (size_t)1024 * 1024, T, 2048, 1024, 1024, C.tid}; pg8::StaticOrder S; S.init(T, 2048, C.G, C.bid);
            EpiP E{(bf16*)(ws + WS_PB), NB, NB, 1, l, args.out, (float*)(ws + WS_SIDE)}; pg8::gemm_phase<EpiP, pg8::StaticOrder, true, true>(C.lds, g, S, E); } PH_END
        PH_BEGIN for (int it = C.bid; it < 1024; it += C.G) { Ctx C2 = C; asm volatile("" : "+v"(C2.tid), "+v"(C2.lane)); if (it < 512) dn_phase1_item(C2, l, it); else ss_phase1_item(C2, l, it - 512); } PH_END
        PH_BEGIN ss_scan(C, l); if (C.bid < 128) dn_scan_unit(C, l, C.bid); else if (C.bid < 256) { Ctx C2 = C; asm volatile("" : "+v"(C2.tid), "+v"(C2.lane)); ss_phase3_item(C2, l, C.bid - 128); } PH_END
        PH_BEGIN for (int rnd = 0; rnd < 3; ++rnd) { Ctx C2 = C; asm volatile("" : "+v"(C2.tid), "+v"(C2.lane));
            if (C.bid < 128) { if (rnd == 0) dn_phase3_item(C2, l, C.bid); else if (rnd == 1) dn_phase3_item(C2, l, 256 + C.bid); else ssd_fix_rows(C2, l, C.bid * 64, 64, 0, 2); }
            else if (C.bid < 256) { const int it0 = 128 + (C.bid - 128) * 2; if (rnd == 0) dn_phase3_item(C2, l, C.bid); else ss_phase3_item(C2, l, it0 + (rnd - 1));
                if (rnd == 2) { const int v_ = (it0 >> 2) - 32; ssd_fix_rows(C2, l, TC + (v_ >> 4) * 4096 + (v_ & 15) * 256, 256, (it0 & 3) >> 1, 1); } } } PH_END
        PH_BEGIN { pg8::Gemm g{(const pg8::bf16_t*)(ws + WS_MIX), (const pg8::bf16_t*)(ws + WS_WOUT), T, 1024, 1024, 1024, C.tid}; pg8::StaticOrder S; S.init(T, 1024, C.G, C.bid);
            EpiRes E{xc, xl, args.out, ada, 2048}; pg8::gemm_phase<EpiRes, pg8::StaticOrder, true, true>(C.lds, g, S, E);
            if (l == 0 && C.bid >= 128) { Ctx C2 = C; asm volatile("" : "+v"(C2.tid), "+v"(C2.lane)); phase_weights(C2, 0, 8, C.bid - 128, 128); } } PH_END
        PH_BEGIN phase_norm(C, args.out, args.out + (size_t)TC * D, args.in[11] + l * D, ada, 1, (bf16*)(ws + WS_XN)); PH_END
        PH_BEGIN { pg8::Gemm g{(const pg8::bf16_t*)(ws + WS_XN), (const pg8::bf16_t*)(ws + WS_WGU), T, 5632, 1024, 1024, C.tid}; pg8::StaticOrder S; S.init(T, 5632, C.G, C.bid);
            EpiSwiglu E{(bf16*)(ws + WS_ACT)}; pg8::gemm_phase<EpiSwiglu, pg8::StaticOrder, true, true>(C.lds, g, S, E); } PH_END
        PH_BEGIN { pg8::Gemm g{(const pg8::bf16_t*)(ws + WS_ACT), (const pg8::bf16_t*)(ws + WS_WDN), T, 1024, 2816, 2816, C.tid}; pg8::StaticOrder S; S.init(T, 1024, C.G, C.bid);
            EpiRes E{args.out, args.out + (size_t)TC * D, args.out, ada, 5120}; pg8::gemm_phase<EpiRes, pg8::StaticOrder, true, true>(C.lds, g, S, E);
            if (l == 0 && C.bid >= 128) { Ctx C2 = C; asm volatile("" : "+v"(C2.tid), "+v"(C2.lane)); phase_weights(C2, 1, 13, C.bid - 128, 128); } } PH_END
    }
    PH_BEGIN phase_final_norm(C, args.in[33]); PH_END
}

extern "C" void kernel_launch(void* const* d_in, const int* in_sizes, int n_in, void* d_out, int out_size, void* d_ws, size_t ws_size, hipStream_t stream) {
    static int grid = 0;
    if (grid == 0) {
        if (n_in != 34 || out_size != 36175872 || ws_size < WS_END) { fprintf(stderr, "kernel_launch: unexpected problem (n_in %d out %d ws %zu)\n", n_in, out_size, ws_size); grid = -1; return; }
        int dev = 0, cus = 0, per_cu = 0;
        if (hipGetDevice(&dev) != hipSuccess || hipDeviceGetAttribute(&cus, hipDeviceAttributeMultiprocessorCount, dev) != hipSuccess) { grid = -1; return; }
        if (hipFuncSetAttribute((const void*)mk_fwd, hipFuncAttributeMaxDynamicSharedMemorySize, LDS_BYTES) != hipSuccess) { fprintf(stderr, "kernel_launch: hipFuncSetAttribute failed\n"); grid = -1; return; }
        if (hipOccupancyMaxActiveBlocksPerMultiprocessor(&per_cu, (const void*)mk_fwd, NTHR, LDS_BYTES) != hipSuccess || per_cu < 1) { fprintf(stderr, "kernel_launch: occupancy query says %d\n", per_cu); per_cu = 1; }
        (void)hipGetLastError();
        grid = cus * per_cu;
        if (grid >= 256) grid = 256;
        else { fprintf(stderr, "kernel_launch: needs 256 co-resident workgroups, device offers %d\n", grid); grid = -1; return; }
    }
    if (grid < 0) return;
    if (hipMemsetAsync(d_ws, 0, 16384, stream) != hipSuccess) { fprintf(stderr, "kernel_launch: memset failed\n"); return; }
    Args a{};
    for (int i = 0; i < 34; ++i) a.in[i] = (const float*)d_in[i];
    a.out = (float*)d_out; a.ws = (unsigned char*)d_ws;
#if MK_SINGLE
    a.ph_lo = 0; a.ph_hi = NPHASES;
    void* kargs[] = {&a};
    hipError_t e = hipLaunchCooperativeKernel((const void*)mk_fwd, dim3(grid), dim3(NTHR), kargs, LDS_BYTES, stream);
    if (e != hipSuccess) fprintf(stderr, "kernel_launch: cooperative launch failed: %s (grid %d)\n", hipGetErrorString(e), grid);
#else
    for (int p = 0; p < NPHASES; ++p) { a.ph_lo = p; a.ph_hi = p + 1; hipLaunchKernelGGL(mk_fwd, dim3(grid), dim3(NTHR), LDS_BYTES, stream, a); }
#endif
}
```

```cpp
#include <hip/hip_runtime.h>
#include <hip/hip_cooperative_groups.h>
#include <cstdio>
#include <cstdint>
namespace cg = cooperative_groups;
namespace pg8 {
#define PG8_LAS __attribute__((address_space(3)))
typedef unsigned short bf16_t;
typedef short bf16x8 __attribute__((ext_vector_type(8)));
typedef float f32x4 __attribute__((ext_vector_type(4)));
typedef unsigned u32x4 __attribute__((ext_vector_type(4)));
constexpr int BM = 256, BK = 64, HALF = 128, HTB = HALF * BK * 2  , STAGE_BYTES = 8 * HTB, NXCD = 8, WGM = 8;

__host__ __device__ __forceinline__ int lds_byte(int r, int c) { const int st = (r >> 4) * 2 + (c >> 5), rr = r & 15, cc = c & 31, ob = rr * 64 + cc * 2; return st * 1024 + (ob ^ (((ob >> 9) & 1) << 5)); }
__host__ __device__ __forceinline__ void stage_rc(int b, int& R, int& C) { const int st = b / 1024, sb = b % 1024, swz = sb ^ (((sb >> 9) & 1) << 5); R = (st >> 1) * 16 + swz / 64; C = (st & 1) * 32 + (swz % 64) / 2; }
__host__ __device__ __forceinline__ int perm32(int rho) { const int n = rho >> 4, i = rho & 15; return 8 * (i >> 2) + 4 * n + (i & 3); }

struct Unit { int pm, pn; };
struct Gemm { const bf16_t* A; const bf16_t* Bt; int M, N, K, lda; int tid; };
struct StaticOrder {
    int nM, nN, nwg, G, c;
    __host__ __device__ void init(int M, int N, int G_, int c_) { nM = M / BM; nN = N / BM; nwg = nM * nN; G = G_; c = c_; }
    __host__ __device__ bool next(int i, Unit& u) const {
        const long L = (long)i * G + c; if (L >= nwg) return false;
        int wgid = (int)L; { const int q = nwg / NXCD, r = nwg % NXCD, xcd = wgid % NXCD, off = wgid / NXCD; wgid = (xcd < r ? xcd * (q + 1) : r * (q + 1) + (xcd - r) * q) + off; }
        const int nig = WGM * nN, gid = wgid / nig, fm = gid * WGM, gsz = (nM - fm) < WGM ? (nM - fm) : WGM;
        u.pm = fm + ((wgid % nig) % gsz); u.pn = (wgid % nig) / gsz; return true;
    }
    __device__ __forceinline__ void a_ready(const Unit&) const {}
    __device__ __forceinline__ void done(const Unit&) const {}
};
__device__ __forceinline__ unsigned cvt_pk_bf16(float lo, float hi) { unsigned r; asm volatile("v_cvt_pk_bf16_f32 %0, %1, %2" : "=v"(r) : "v"(lo), "v"(hi)); return r; }
template <class Epi, class Sched, bool ALIGN_EPI = false, bool SP2 = false>
__device__ __forceinline__ void gemm_phase(PG8_LAS unsigned char* lds, const Gemm g, const Sched& S, const Epi& E) {
    const int tid = g.tid, wid = __builtin_amdgcn_readfirstlane(tid >> 6), lane = tid & 63, wr = wid >> 2, wc = wid & 3, fr = lane & 15, fq = lane >> 4;
    const int K = g.K, nt = K / BK;
    unsigned voffA[2], voffB[2];
#pragma unroll
    for (int i = 0; i < 2; ++i) { int R, C; stage_rc(tid * 16 + i * 8192, R, C); const int Rb = Epi::PERM ? ((R & ~31) + perm32(R & 31)) : R;
        voffA[i] = (unsigned)(R * g.lda + C) * 2u; voffB[i] = (unsigned)(Rb * K + C) * 2u; }
    const size_t kstep = (size_t)(BK * 2);
    const size_t hstep = (size_t)HALF * K * 2;
    const size_t tstep = 2 * hstep; const size_t hstepA = (size_t)HALF * g.lda * 2, tstepA = 2 * hstepA;
    const unsigned ldsw = (unsigned)wid * 1024u;
    const int aoff = lds_byte(wr * 64 + fr, fq * 8), boff = lds_byte(wc * 32 + fr, fq * 8);
#define PG8_SA(b, h) (((b) * 2 + (h)) * HTB)
#define PG8_SB(b, h) ((4 + (b) * 2 + (h)) * HTB)
#define PG8_STAGE(bufoff, gbase, voff) do { _Pragma("unroll") for (int _i = 0; _i < 2; ++_i) \
        __builtin_amdgcn_global_load_lds((const unsigned*)((const char*)(gbase) + (voff)[_i]), (PG8_LAS unsigned*)(lds + (bufoff) + ldsw + _i * 8192), 16, 0, 0); } while (0)
#define PG8_LDA(dst, b, h) do { _Pragma("unroll") for (int m = 0; m < 4; ++m) _Pragma("unroll") for (int k = 0; k < 2; ++k) dst[m][k] = *(const PG8_LAS bf16x8*)(lds + PG8_SA(b, h) + aoff + m * 2048 + k * 1024); } while (0)
#define PG8_LDB(dst, b, h) do { _Pragma("unroll") for (int n = 0; n < 2; ++n) _Pragma("unroll") for (int k = 0; k < 2; ++k) dst[n][k] = *(const PG8_LAS bf16x8*)(lds + PG8_SB(b, h) + boff + n * 2048 + k * 1024); } while (0)
#define PG8_MMA(ai, bj, At, Bt) do { __builtin_amdgcn_s_setprio(1); _Pragma("unroll") for (int m = 0; m < 4; ++m) _Pragma("unroll") for (int n = 0; n < 2; ++n) _Pragma("unroll") for (int k = 0; k < 2; ++k) \
        acc[ai][bj][m][n] = __builtin_amdgcn_mfma_f32_16x16x32_bf16(Bt[n][k], At[m][k], acc[ai][bj][m][n], 0, 0, 0); __builtin_amdgcn_s_setprio(0); } while (0)
#define PG8_WAIT_V(n) asm volatile("s_waitcnt vmcnt(" #n ")" ::: "memory")
#define PG8_WAIT_L(n) asm volatile("s_waitcnt lgkmcnt(" #n ")" ::: "memory")
#define PG8_BAR __builtin_amdgcn_s_barrier()
#define PG8_SCHED __builtin_amdgcn_sched_barrier(0)
    Unit cur, nxt; int ui = 0;
    if (!S.next(0, cur)) return;
    f32x4 acc[2][2][4][2];
#pragma unroll
    for (int a = 0; a < 2; ++a)
#pragma unroll
        for (int b = 0; b < 2; ++b)
#pragma unroll
            for (int m = 0; m < 4; ++m)
#pragma unroll
                for (int n = 0; n < 2; ++n) acc[a][b][m][n] = (f32x4){0.f, 0.f, 0.f, 0.f};
    bf16x8 At[4][2], B0[2][2], B1[2][2];
    const char* cA = (const char*)g.A + (size_t)cur.pm * tstepA; const char* cB = (const char*)g.Bt + (size_t)cur.pn * tstep;
    S.a_ready(cur);
    if constexpr (SP2) {
        PG8_STAGE(PG8_SB(0, 0), cB, voffB); PG8_STAGE(PG8_SB(0, 1), cB + hstep, voffB); PG8_STAGE(PG8_SA(0, 0), cA, voffA); PG8_STAGE(PG8_SA(0, 1), cA + hstepA, voffA);
        if (wr == 1) PG8_BAR;
        PG8_WAIT_V(2); PG8_BAR;
        PG8_STAGE(PG8_SB(1, 0), cB + kstep, voffB); PG8_STAGE(PG8_SA(1, 0), cA + kstep, voffA); PG8_STAGE(PG8_SB(1, 1), cB + hstep + kstep, voffB);
        PG8_WAIT_V(6); PG8_BAR;
    } else {
        PG8_STAGE(PG8_SB(0, 0), cB, voffB); PG8_STAGE(PG8_SA(0, 0), cA, voffA); PG8_STAGE(PG8_SB(0, 1), cB + hstep, voffB); PG8_STAGE(PG8_SA(0, 1), cA + hstepA, voffA);
        if (wr == 1) PG8_BAR;
        PG8_WAIT_V(4); PG8_BAR;
        PG8_STAGE(PG8_SB(1, 0), cB + kstep, voffB); PG8_STAGE(PG8_SA(1, 0), cA + kstep, voffA); PG8_STAGE(PG8_SB(1, 1), cB + hstep + kstep, voffB);
        PG8_WAIT_V(6); PG8_BAR;
    }
    for (;;) {
        const bool has_next = S.next(ui + 1, nxt);
        const char* nA = has_next ? (const char*)g.A + (size_t)nxt.pm * tstepA : cA; const char* nB = has_next ? (const char*)g.Bt + (size_t)nxt.pn * tstep : cB;
        for (int t = 0; t < nt; t += 2) {
            const bool last = (t == nt - 2);
            const char* a1 = cA + (size_t)(t + 1) * kstep;
            const char* a2 = last ? nA : cA + (size_t)(t + 2) * kstep; const char* b2 = last ? nB : cB + (size_t)(t + 2) * kstep;
            const char* a3 = a2 + kstep; const char* b3 = b2 + kstep;
            if (last && has_next) S.a_ready(nxt);
            if constexpr (SP2) {
            PG8_LDB(B0, 0, 0); PG8_LDB(B1, 0, 1); PG8_SCHED; PG8_LDA(At, 0, 0); PG8_STAGE(PG8_SA(1, 1), a1 + hstepA, voffA);
            PG8_WAIT_V(8); PG8_WAIT_L(0); PG8_BAR; PG8_MMA(0, 0, At, B0); PG8_MMA(0, 1, At, B1); PG8_BAR; PG8_SCHED;
            PG8_LDA(At, 0, 1); PG8_STAGE(PG8_SB(0, 0), b2, voffB); PG8_STAGE(PG8_SB(0, 1), b2 + hstep, voffB); PG8_STAGE(PG8_SA(0, 0), a2, voffA);
            PG8_WAIT_V(8); PG8_WAIT_L(0); PG8_BAR; PG8_MMA(1, 0, At, B0); PG8_MMA(1, 1, At, B1); PG8_BAR; PG8_SCHED;
            PG8_LDB(B0, 1, 0); PG8_LDB(B1, 1, 1); PG8_SCHED; PG8_LDA(At, 1, 0); PG8_STAGE(PG8_SA(0, 1), a2 + hstepA, voffA);
            PG8_WAIT_V(8); PG8_WAIT_L(0); PG8_BAR; PG8_MMA(0, 0, At, B0); PG8_MMA(0, 1, At, B1); PG8_BAR; PG8_SCHED;
            PG8_LDA(At, 1, 1); PG8_STAGE(PG8_SB(1, 0), b3, voffB); PG8_STAGE(PG8_SB(1, 1), b3 + hstep, voffB); PG8_STAGE(PG8_SA(1, 0), a3, voffA);
            PG8_WAIT_V(8); PG8_WAIT_L(0); PG8_BAR; PG8_MMA(1, 0, At, B0); PG8_MMA(1, 1, At, B1); PG8_BAR; PG8_SCHED;
            } else {
            PG8_LDB(B0, 0, 0); PG8_SCHED; PG8_LDA(At, 0, 0); PG8_STAGE(PG8_SA(1, 1), a1 + hstepA, voffA);
            PG8_WAIT_L(8); PG8_BAR; PG8_WAIT_L(0); PG8_MMA(0, 0, At, B0); PG8_BAR; PG8_SCHED;
            PG8_LDB(B1, 0, 1); PG8_STAGE(PG8_SB(0, 0), b2, voffB);
            PG8_BAR; PG8_WAIT_L(0); PG8_MMA(0, 1, At, B1); PG8_BAR;
            PG8_LDA(At, 0, 1); PG8_STAGE(PG8_SA(0, 0), a2, voffA);
            PG8_BAR; PG8_WAIT_L(0); PG8_MMA(1, 0, At, B0); PG8_BAR; PG8_SCHED;
            PG8_STAGE(PG8_SB(0, 1), b2 + hstep, voffB);
            PG8_WAIT_V(6); PG8_BAR; PG8_MMA(1, 1, At, B1); PG8_BAR;
            PG8_LDB(B0, 1, 0); PG8_SCHED; PG8_LDA(At, 1, 0); PG8_STAGE(PG8_SA(0, 1), a2 + hstepA, voffA);
            PG8_WAIT_L(8); PG8_BAR; PG8_WAIT_L(0); PG8_MMA(0, 0, At, B0); PG8_BAR; PG8_SCHED;
            PG8_LDB(B1, 1, 1); PG8_STAGE(PG8_SB(1, 0), b3, voffB);
            PG8_BAR; PG8_WAIT_L(0); PG8_MMA(0, 1, At, B1); PG8_BAR;
            PG8_LDA(At, 1, 1); PG8_STAGE(PG8_SA(1, 0), a3, voffA);
            PG8_BAR; PG8_WAIT_L(0); PG8_MMA(1, 0, At, B0); PG8_BAR; PG8_SCHED;
            PG8_STAGE(PG8_SB(1, 1), b3 + hstep, voffB);
            PG8_WAIT_V(6); PG8_BAR; PG8_MMA(1, 1, At, B1); PG8_BAR;
            }
        }
        if constexpr (ALIGN_EPI) { if (wr == 0) PG8_BAR; }
        if constexpr (!Epi::AFTER_DRAIN) { E(acc, cur, wr, wc, fr, fq); S.done(cur); }
        if (!has_next) break;
#pragma unroll
        for (int a = 0; a < 2; ++a)
#pragma unroll
            for (int b = 0; b < 2; ++b)
#pragma unroll
                for (int m = 0; m < 4; ++m)
#pragma unroll
                    for (int n = 0; n < 2; ++n) acc[a][b][m][n] = (f32x4){0.f, 0.f, 0.f, 0.f};
        cur = nxt; cA = nA; cB = nB; ++ui;
        if constexpr (ALIGN_EPI) { if (wr == 1) PG8_BAR; }
    }
    PG8_WAIT_V(0);
    if constexpr (!ALIGN_EPI) { if (wr == 0) PG8_BAR; }
    PG8_BAR;
    if constexpr (Epi::AFTER_DRAIN) { E.fused(acc, cur, wr, wc, fr, fq, lds, wid, lane); S.done(cur); }
#undef PG8_SA
#undef PG8_SB
#undef PG8_STAGE
#undef PG8_LDA
#undef PG8_LDB
#undef PG8_MMA
#undef PG8_WAIT_V
#undef PG8_WAIT_L
#undef PG8_BAR
#undef PG8_SCHED
}
}
#ifndef MK_SINGLE
#define MK_SINGLE 1
#endif
#define DI __device__ __forceinline__
#define LAS __attribute__((address_space(3)))
typedef unsigned short bf16;
typedef float f32x4 __attribute__((ext_vector_type(4)));
typedef short bf16x8 __attribute__((ext_vector_type(8)));
typedef unsigned u32x4 __attribute__((ext_vector_type(4)));
typedef unsigned u32x2 __attribute__((ext_vector_type(2)));

constexpr int T = 24576, TC = 8192, D = 1024, FF = 2816, NA = 928, NB = 1816, NKV = 25600;
constexpr int NWAVES = 8, NTHR = 512;
constexpr float EPS = 1e-6f;
constexpr float LOG2E = 1.4426950408889634f;
constexpr size_t O_Y = 0, O_SDN = 25165824, O_CKV = 27262976, O_KPE = 29360128, O_SSM = 29884416, O_SK = 31981568, O_SV = 34078720;
constexpr size_t MiB = 1u << 20, KiB = 1024;
constexpr size_t WS_ADA = 64 * KiB;
constexpr size_t WS_ROPE = 1 * MiB;
constexpr size_t WS_RS = 3 * MiB;
constexpr size_t WS_SSQ = 3 * MiB + 256 * KiB;
constexpr size_t WS_CKVC = 4 * MiB;
constexpr size_t WS_KPEC = 4 * MiB + 512 * KiB;
constexpr size_t WS_SWAKC = WS_KPEC + 64 * KiB;
constexpr size_t WS_SWAVC = WS_SWAKC + 256 * KiB;
constexpr size_t WS_WUQ = 5 * MiB + 256 * KiB;
constexpr size_t WS_WUKV = WS_WUQ + 256 * KiB;
constexpr size_t WS_WUKVC = WS_WUKV + 256 * KiB;
constexpr size_t WS_WIN = 6 * MiB;
constexpr size_t WS_WOUT = 12 * MiB;
constexpr size_t WS_WGU = 14 * MiB;
constexpr size_t WS_WDN = 25 * MiB;
constexpr size_t WS_XN = 31 * MiB;
constexpr size_t WS_MIX = 79 * MiB;
constexpr size_t WS_PA = 127 * MiB;
constexpr size_t WS_KV16 = 171 * MiB;
constexpr size_t WS_QRAW = 196 * MiB;
constexpr size_t WS_PB = 127 * MiB;
constexpr size_t WS_MN = 213 * MiB;
constexpr size_t WS_CS = 229 * MiB;
constexpr size_t WS_CD = 237 * MiB;
constexpr size_t WS_SIDE = 238 * MiB;
constexpr size_t WS_CKV16 = 214 * MiB;
constexpr size_t WS_QN16 = 227 * MiB;
constexpr size_t WS_ACT = 79 * MiB;
constexpr size_t WS_KPER = 239 * MiB;
constexpr size_t WS_KSR = 240 * MiB;
constexpr size_t WS_END = 244 * MiB;
constexpr int LDS_BYTES = 147456;

typedef float f32x2_t __attribute__((ext_vector_type(2)));
typedef __bf16 bf16x2_t __attribute__((ext_vector_type(2)));
DI unsigned pk2(float lo, float hi) { const f32x2_t v = {lo, hi}; const bf16x2_t b = __builtin_convertvector(v, bf16x2_t); return __builtin_bit_cast(unsigned, b); }
DI unsigned f2bf(float f) { return pk2(f, 0.f) & 0xffffu; }
DI float bflo(unsigned v) { return __builtin_bit_cast(float, v << 16); }
DI float bfhi(unsigned v) { return __builtin_bit_cast(float, v & 0xffff0000u); }
DI void unpack8(u32x4 v, float* f) { f[0] = bflo(v.x); f[1] = bfhi(v.x); f[2] = bflo(v.y); f[3] = bfhi(v.y); f[4] = bflo(v.z); f[5] = bfhi(v.z); f[6] = bflo(v.w); f[7] = bfhi(v.w); }
DI void ld8(const bf16* p, float* f) { unpack8(*(const u32x4*)p, f); }
DI u32x4 pack8(const float* f) { u32x4 o; o.x = pk2(f[0], f[1]); o.y = pk2(f[2], f[3]); o.z = pk2(f[4], f[5]); o.w = pk2(f[6], f[7]); return o; }
DI float wave_sum(float v) {
#pragma unroll
    for (int o = 32; o; o >>= 1) v += __shfl_xor(v, o);
    return v; }
DI float siluf(float x) { return x / (1.f + expf(-x)); }
DI float fsilu(float x) { return x * __builtin_amdgcn_rcpf(1.f + __expf(-x)); }
DI float softplusf(float x) { return x > 20.f ? x : log1pf(expf(x)); }
DI float fsoftplus(float x) { const float y = __expf(x); return x > 20.f ? x : (y < 1e-3f ? y * (1.f - 0.5f * y) : __logf(1.f + y)); }

struct EpiP {
    static constexpr bool PERM = true, AFTER_DRAIN = false;
    bf16* P; int ldc, ncols, mode, layer; float* out; float* side;
    DI void operator()(const pg8::f32x4 (&acc)[2][2][4][2], const pg8::Unit& u, int wr, int wc, int fr, int fq) const {
        const int row0 = u.pm * 256 + wr * 64 + fr, col0 = u.pn * 256 + wc * 32 + 8 * fq;
#pragma unroll
        for (int ai = 0; ai < 2; ++ai)
#pragma unroll
            for (int m = 0; m < 4; ++m) { const int row = row0 + ai * 128 + m * 16;
#pragma unroll
                for (int bj = 0; bj < 2; ++bj) { const int c = col0 + bj * 128; const pg8::f32x4 v0 = acc[ai][bj][m][0], v1 = acc[ai][bj][m][1];
                    if (c < ncols) { u32x4 w; w.x = pk2(v0[0], v0[1]); w.y = pk2(v0[2], v0[3]); w.z = pk2(v1[0], v1[1]); w.w = pk2(v1[2], v1[3]); *(u32x4*)(P + (size_t)row * ldc + c) = w; }
                    float* dst = nullptr;
                    if (mode == 0) { if (row < TC) { const size_t rb = (size_t)((row >> 8) * 2 + layer) * 256 + (row & 255);
                            if (c >= 256 && c < 384) dst = out + O_CKV + rb * 128 + (c - 256);
                            else if (c >= 384 && c < 416) dst = out + O_KPE + rb * 32 + (c - 384);
                            else if (c >= 672 && c < 800) dst = out + O_SK + rb * 128 + (c - 672);
                            else if (c >= 800 && c < 928) dst = out + O_SV + rb * 128 + (c - 800); } }
                    else { if (c >= 1024 && c < 1040) dst = side + (size_t)row * 24 + (c - 1024); else if (c >= 1808 && c < 1816) dst = side + (size_t)row * 24 + 16 + (c - 1808); }
                    if (dst) { *(pg8::f32x4*)dst = v0; *(pg8::f32x4*)(dst + 4) = v1; } } }
    }
};
struct EpiRS {
    static constexpr bool PERM = true, AFTER_DRAIN = false;
    bf16* O; int ldc, ncols;
    DI void operator()(const pg8::f32x4 (&acc)[2][2][4][2], const pg8::Unit& u, int wr, int wc, int fr, int fq) const {
        const int row0 = u.pm * 256 + wr * 64 + fr, col0 = u.pn * 256 + wc * 32 + 8 * fq;
#pragma unroll
        for (int ai = 0; ai < 2; ++ai)
#pragma unroll
            for (int m = 0; m < 4; ++m) { const int row = row0 + ai * 128 + m * 16;
#pragma unroll
                for (int bj = 0; bj < 2; ++bj) { const int c = col0 + bj * 128; const pg8::f32x4 v0 = acc[ai][bj][m][0], v1 = acc[ai][bj][m][1];
                    if (c < ncols) { u32x4 w; w.x = pk2(v0[0], v0[1]); w.y = pk2(v0[2], v0[3]); w.z = pk2(v1[0], v1[1]); w.w = pk2(v1[2], v1[3]); *(u32x4*)(O + (size_t)row * ldc + c) = w; } } }
    }
};
struct EpiRes {
    static constexpr bool PERM = false, AFTER_DRAIN = false;
    const float* src_c; const float* src_l; float* dst; const float* ada; int goff;
    DI void operator()(const pg8::f32x4 (&acc)[2][2][4][2], const pg8::Unit& u, int wr, int wc, int fr, int fq) const {
        const int row0 = u.pm * 256 + wr * 64 + fr, col0 = u.pn * 256 + wc * 32 + 4 * fq;
        const int rt = u.pm * 256; const int r = rt < TC ? 0 : 1 + ((rt - TC) >> 12);
        const float* g = ada + (size_t)r * 6144 + goff;
        pg8::f32x4 gv[2][2];
#pragma unroll
        for (int bj = 0; bj < 2; ++bj)
#pragma unroll
            for (int n = 0; n < 2; ++n) gv[bj][n] = *(const pg8::f32x4*)(g + col0 + bj * 128 + n * 16);
#pragma unroll
        for (int ai = 0; ai < 2; ++ai)
#pragma unroll
            for (int m = 0; m < 4; ++m) { const int row = row0 + ai * 128 + m * 16;
                const float* sp = (row < TC ? src_c + (size_t)row * D : src_l + (size_t)(row - TC) * D) + col0; float* dp = dst + (size_t)row * D + col0;
#pragma unroll
                for (int bj = 0; bj < 2; ++bj)
#pragma unroll
                    for (int n = 0; n < 2; ++n) { const pg8::f32x4 xo = *(const pg8::f32x4*)(sp + bj * 128 + n * 16); *(pg8::f32x4*)(dp + bj * 128 + n * 16) = xo + gv[bj][n] * acc[ai][bj][m][n]; } }
    }
};
struct EpiSwiglu {
    static constexpr bool PERM = true, AFTER_DRAIN = false;
    bf16* O;
    DI void operator()(const pg8::f32x4 (&acc)[2][2][4][2], const pg8::Unit& u, int wr, int wc, int fr, int fq) const {
        const int row0 = u.pm * 256 + wr * 64 + fr, col0 = u.pn * 128 + wc * 32 + 8 * fq;
#pragma unroll
        for (int ai = 0; ai < 2; ++ai)
#pragma unroll
            for (int m = 0; m < 4; ++m) { const int row = row0 + ai * 128 + m * 16; float o[8];
#pragma unroll
                for (int n = 0; n < 2; ++n)
#pragma unroll
                    for (int i = 0; i < 4; ++i) { const float gt = acc[ai][0][m][n][i], up = acc[ai][1][m][n][i]; o[n * 4 + i] = fsilu(gt) * up; }
                *(u32x4*)(O + (size_t)row * FF + col0) = pack8(o); }
    }
};
#define RLX_AGENT __ATOMIC_RELAXED, __HIP_MEMORY_SCOPE_AGENT
#define XB_TMO      128
#define XB_XCNT(j)  (256  + 64 * (j))
#define XB_XSUB(j)  (1280 + 64 * (j))
#define XB_XGEN(j)  (2304 + 64 * (j))
#define XB_TOP      3328
#define XB_TOPGEN   3392
#define XCD_BAR_WORDS 3456
#define XB_SPIN_CAP (1u << 18)

__device__ __forceinline__ unsigned xb_ld(unsigned* p)              { return __hip_atomic_load(p, __ATOMIC_RELAXED, __HIP_MEMORY_SCOPE_AGENT); }
__device__ __forceinline__ unsigned xb_add(unsigned* p, unsigned v) { return __hip_atomic_fetch_add(p, v, __ATOMIC_RELAXED, __HIP_MEMORY_SCOPE_AGENT); }
__device__ __forceinline__ unsigned xb_xcc_id() { return (unsigned)__builtin_amdgcn_s_getreg((3 << 11) | 20) & 0xFu; }
#define XB_SPIN(cond, bar) do { unsigned _sp = 0; while (cond) { __builtin_amdgcn_s_sleep(1); \
    if ((++_sp & 255u) == 0u) { if (xb_ld(&(bar)[XB_TMO])) break; if (_sp > XB_SPIN_CAP) { atomicAdd(&(bar)[XB_TMO], 1u); break; } } } } while (0)

struct XcdBarrier {
    unsigned* bar; unsigned x;
    volatile LAS unsigned* st;
};

__device__ __forceinline__ XcdBarrier xcd_barrier_post(unsigned* bar, volatile LAS unsigned* st) {
    XcdBarrier b; b.bar = bar; b.x = xb_xcc_id(); b.st = st;
    if (threadIdx.x == 0) (void)xb_add(&bar[XB_XCNT(b.x)], 1u);
    return b;
}
__device__ __forceinline__ void xcd_barrier_complete(unsigned* bar, unsigned x, unsigned& nloc, unsigned& nx) {
    const unsigned G = gridDim.x * gridDim.y * gridDim.z;
    unsigned sum, cnt, mine, sp = 0u;
    for (;;) {
        sum = 0u; cnt = 0u; mine = 0u;
#pragma unroll
        for (unsigned j = 0; j < 16; ++j) { const unsigned c = xb_ld(&bar[XB_XCNT(j)]); sum += c; cnt += (c > 0u) ? 1u : 0u; mine = (j == x) ? c : mine; }
        if (sum == G) break;
        __builtin_amdgcn_s_sleep(1);
        if ((++sp & 255u) == 0u) { if (xb_ld(&bar[XB_TMO])) break; if (sp > XB_SPIN_CAP) { atomicAdd(&bar[XB_TMO], 1u); break; } }
    }
    nloc = mine > 0u ? mine : 1u; nx = cnt > 0u ? cnt : 1u;
}

__device__ __forceinline__ void xcd_barrier(const XcdBarrier& b) {
    asm volatile("s_waitcnt vmcnt(0)" ::: "memory");
    __syncthreads();
    if (threadIdx.x == 0) {
        unsigned* bar = b.bar;
        __builtin_amdgcn_s_waitcnt(0);
        unsigned nloc = b.st[0], nx = b.st[1];
        if (nloc == 0u) { xcd_barrier_complete(bar, b.x, nloc, nx); b.st[0] = nloc; b.st[1] = nx; }
        const unsigned old = xb_add(&bar[XB_XSUB(b.x)], 1u);
        const unsigned gen = old / nloc;
        if (old + 1u == (gen + 1u) * nloc) {
            __builtin_amdgcn_fence(__ATOMIC_RELEASE, "agent");
            asm volatile("s_waitcnt vmcnt(0)" ::: "memory");
            const unsigned og = xb_add(&bar[XB_TOP], 1u);
            const unsigned tg = og / nx;
            if (og + 1u == (tg + 1u) * nx) xb_add(&bar[XB_TOPGEN], 1u);
            else XB_SPIN(xb_ld(&bar[XB_TOPGEN]) == tg, bar);
            __builtin_amdgcn_fence(__ATOMIC_ACQUIRE, "agent");
            xb_add(&bar[XB_XGEN(b.x)], 1u);
            asm volatile("s_waitcnt vmcnt(0)" ::: "memory");
        } else {
            XB_SPIN(xb_ld(&bar[XB_XGEN(b.x)]) == gen, bar);
            __builtin_amdgcn_fence(__ATOMIC_ACQUIRE, "agent");
            asm volatile("s_waitcnt vmcnt(0)" ::: "memory");
        }
    }
    __syncthreads();
}
DI int map_col(int id, int n, int nvalid) {
    if (id == 0) return n;
    if (id == 1) { if (n < 1024) { if (n < 416) return 1040 + n; if (n < 928) return 2232 + (n - 416); return -1; }
        const int b = n - 1024; if (b < 1040) return b; if (b < 1816) return 1456 + (b - 1040); return -1; }
    if (id == 2) { const int pn = n >> 8, bj = (n >> 7) & 1, cc = n & 127; return bj * FF + pn * 128 + cc; }
    return n < nvalid ? n : -1;
}
DI void transpose_item(const float* W, int ldw, int Ksrc, int mapid, int nvalid, const float* kscale, bf16* WT, int Kd, int nblk, LAS float* scr, int item, int lane) {
    const int kb = item / nblk, nb = item % nblk, k0 = 64 * kb, n0 = 32 * nb;
    const int n4 = (lane & 7) * 4; const int sc = map_col(mapid, n0 + n4, nvalid);
    (void)kscale;
#pragma unroll
    for (int i = 0; i < 8; ++i) { const int kk = 8 * i + (lane >> 3), k = k0 + kk; f32x4 v = {0.f, 0.f, 0.f, 0.f};
        if (sc >= 0 && k < Ksrc) v = *(const f32x4*)(W + (size_t)k * ldw + sc);
        LAS float* d = scr + kk * 33 + n4; d[0] = v.x; d[1] = v.y; d[2] = v.z; d[3] = v.w; }
    asm volatile("s_waitcnt lgkmcnt(0)" ::: "memory");
    const int c = lane & 7;
#pragma unroll
    for (int j = 0; j < 4; ++j) { const int n = (lane >> 3) + 8 * j; const LAS float* s = scr + (8 * c) * 33 + n;
        u32x4 o; o.x = pk2(s[0 * 33], s[1 * 33]); o.y = pk2(s[2 * 33], s[3 * 33]); o.z = pk2(s[4 * 33], s[5 * 33]); o.w = pk2(s[6 * 33], s[7 * 33]);
        *(u32x4*)(WT + (size_t)(n0 + n) * Kd + k0 + 8 * c) = o; }
    asm volatile("s_waitcnt lgkmcnt(0)" ::: "memory");
}

struct Ctx {
    const float* const* in; float* out; unsigned char* ws; LAS unsigned char* lds; int tid, lane, wave, bid, G;
};

DI void phase_weights(const Ctx& C, int l, int mask, int bid, int G) {
    LAS float* scr = (LAS float*)(C.lds + C.wave * 16384);
    const int gw = bid * NWAVES + C.wave, NGW = G * NWAVES;
    constexpr int I_IN = 16 * 96, I_OUT = 16 * 32, I_GU = 16 * 176, I_DN = 44 * 32, I_Q = 4 * 16, I_KV = 4 * 16;
    constexpr int NIT = I_IN + I_OUT + I_GU + I_DN + I_Q + I_KV;
    unsigned char* ws = C.ws;
    for (int it = gw; it < NIT; it += NGW) { int r = it;
        { const int cls = it < I_IN ? 0 : (it < I_IN + I_OUT ? 2 : (it < I_IN + I_OUT + I_GU ? 3 : (it < I_IN + I_OUT + I_GU + I_DN ? 1 : 0))); if (!((mask >> cls) & 1)) continue; }
        if (r < I_IN) { transpose_item(C.in[14] + (size_t)l * 1024 * 2744, 2744, 1024, 1, 0, nullptr, (bf16*)(ws + WS_WIN), 1024, 96, scr, r, C.lane); continue; } r -= I_IN;
        if (r < I_OUT) { transpose_item(C.in[15] + (size_t)l * 1024 * 1024, 1024, 1024, 0, 0, nullptr, (bf16*)(ws + WS_WOUT), 1024, 32, scr, r, C.lane); continue; } r -= I_OUT;
        if (r < I_GU) { transpose_item(C.in[31] + (size_t)l * 1024 * 5632, 5632, 1024, 2, 0, nullptr, (bf16*)(ws + WS_WGU), 1024, 176, scr, r, C.lane); continue; } r -= I_GU;
        if (r < I_DN) { transpose_item(C.in[32] + (size_t)l * 2816 * 1024, 1024, 2816, 0, 0, nullptr, (bf16*)(ws + WS_WDN), 2816, 32, scr, r, C.lane); continue; } r -= I_DN;
        if (r < I_Q) { transpose_item(C.in[21] + (size_t)l * 256 * 384, 384, 256, 3, 384, nullptr, (bf16*)(ws + WS_WUQ), 256, 16, scr, r, C.lane); continue; } r -= I_Q;
        transpose_item(C.in[23] + (size_t)l * 128 * 512, 512, 128, 3, 512, nullptr, (bf16*)(ws + WS_WUKV), 256, 16, scr, r, C.lane);
    }
    if (!(mask & 1)) return;
    const int gt = bid * NTHR + C.tid, NGT = G * NTHR;
    bf16* ckvc = (bf16*)(ws + WS_CKV16) + (size_t)T * 256; bf16* kpec = (bf16*)(ws + WS_KPEC); bf16* skc = (bf16*)(ws + WS_SWAKC); bf16* svc = (bf16*)(ws + WS_SWAVC);
    for (int i = gt; i < 1024 * 256; i += NGT) { const int row = i >> 8, c = i & 255, b = row >> 8, t = row & 255;
        ckvc[i] = c < 128 ? (bf16)f2bf(C.in[4][((size_t)(b * 2 + l) * 256 + t) * 128 + c]) : (bf16)0; }
    for (int i = gt; i < 1024 * 32; i += NGT) { const int row = i >> 5, c = i & 31, b = row >> 8, t = row & 255; kpec[i] = (bf16)f2bf(C.in[5][((size_t)(b * 2 + l) * 256 + t) * 32 + c]); }
    for (int i = gt; i < 1024 * 128; i += NGT) { const int row = i >> 7, c = i & 127, b = row >> 8, t = row & 255; const size_t s = ((size_t)(b * 2 + l) * 256 + t) * 128 + c;
        skc[i] = (bf16)f2bf(C.in[7][s]); svc[i] = (bf16)f2bf(C.in[8][s]); }
}

DI void phase_ada_rope(const Ctx& C) {
    LAS float* sc = (LAS float*)C.lds;
    LAS float* red = sc + 5 * 1024;
    for (int i = C.tid; i < 5 * 1024; i += NTHR) { const int r = i >> 10, k = i & 1023; const float v = r == 0 ? C.in[9][k] : C.in[2][(r - 1) * 1024 + k]; sc[i] = siluf(v); }
    __syncthreads();
    float* ada = (float*)(C.ws + WS_ADA);
    for (int it = C.bid; it < 192; it += C.G) { const int l = it / 96, n = (it % 96) * 64 + C.lane;
        const float* w = C.in[12] + (size_t)l * 1024 * 6144 + n; float a[5] = {0.f, 0.f, 0.f, 0.f, 0.f};
#pragma unroll 4
        for (int kk = 0; kk < 128; ++kk) { const int k = C.wave * 128 + kk; const float wv = w[(size_t)k * 6144];
#pragma unroll
            for (int r = 0; r < 5; ++r) a[r] += sc[r * 1024 + k] * wv; }
#pragma unroll
        for (int r = 0; r < 5; ++r) red[(C.wave * 5 + r) * 64 + C.lane] = a[r];
        __syncthreads();
        if (C.tid < 320) { const int r = C.tid >> 6, ln = C.tid & 63; float s = 0.f;
#pragma unroll
            for (int w8 = 0; w8 < 8; ++w8) s += red[(w8 * 5 + r) * 64 + ln];
            const int nn = (it % 96) * 64 + ln; ada[((size_t)l * 5 + r) * 6144 + nn] = s + C.in[13][l * 6144 + nn]; }
        __syncthreads();
    }
    float* rt = (float*)(C.ws + WS_ROPE);
    const int gt = C.bid * NTHR + C.tid, NGT = C.G * NTHR;
    for (int i = gt; i < 4096 * 16; i += NGT) { const int t = i >> 4, j = i & 15; const float pos = (float)(j < 8 ? (t >> 6) : (t & 63)); const int f = j & 7;
        const float inv = powf(10000.f, -(float)f / 8.f); const float ang = pos * inv; rt[i] = cosf(ang); rt[65536 + i] = sinf(ang); }
    for (int i = gt; i < 4096 * 32; i += NGT) { const int t = i >> 5, j = i & 31; const float pos = (float)(j < 16 ? (t >> 6) : (t & 63)); const int f = j & 15;
        const float inv = powf(10000.f, -(float)f / 16.f); const float ang = pos * inv; rt[131072 + i] = cosf(ang); rt[262144 + i] = sinf(ang); }
}

DI void phase_norm(const Ctx& C, const float* src_c, const float* src_l, const float* nw, const float* ada, int which, bf16* dst) {
    const int gw = C.bid * NWAVES + C.wave, NGW = C.G * NWAVES;
    for (int row0 = gw; row0 < T; row0 += 4 * NGW) {
        f32x4 v[4][4]; float s[4]; const float* shp[4]; int rows[4]; bool ok[4];
#pragma unroll
        for (int u = 0; u < 4; ++u) { const int row = row0 + u * NGW; rows[u] = row; ok[u] = row < T; const int rr = ok[u] ? row : row0;
            const float* x = rr < TC ? src_c + (size_t)rr * D : src_l + (size_t)(rr - TC) * D;
            const int r = rr < TC ? 0 : 1 + ((rr - TC) >> 12); shp[u] = ada + (size_t)r * 6144 + which * 3072; s[u] = 0.f;
#pragma unroll
            for (int j = 0; j < 4; ++j) { v[u][j] = *(const f32x4*)(x + 256 * j + 4 * C.lane); s[u] += v[u][j].x * v[u][j].x + v[u][j].y * v[u][j].y + v[u][j].z * v[u][j].z + v[u][j].w * v[u][j].w; } }
#pragma unroll
        for (int u = 0; u < 4; ++u) { const float rstd = rsqrtf(wave_sum(s[u]) * (1.f / D) + EPS); const float* sh = shp[u]; const float* scl = sh + 1024;
            if (ok[u]) {
#pragma unroll
                for (int j = 0; j < 4; ++j) { const int c = 256 * j + 4 * C.lane; const f32x4 w = *(const f32x4*)(nw + c), a = *(const f32x4*)(scl + c), b = *(const f32x4*)(sh + c);
                    const f32x4 y = v[u][j] * rstd * w * (a + 1.f) + b; u32x2 o; o.x = pk2(y.x, y.y); o.y = pk2(y.z, y.w); *(u32x2*)(dst + (size_t)rows[u] * D + c) = o; } } }
    }
}
DI void phase_final_norm(const Ctx& C, const float* nw) {
    const int gw = C.bid * NWAVES + C.wave, NGW = C.G * NWAVES;
    for (int row0 = gw; row0 < T; row0 += 4 * NGW) {
        f32x4 v[4][4]; float s[4];
#pragma unroll
        for (int u = 0; u < 4; ++u) { const int row = row0 + u * NGW; const float* x = C.out + (size_t)(row < T ? row : row0) * D; s[u] = 0.f;
#pragma unroll
            for (int j = 0; j < 4; ++j) { v[u][j] = *(const f32x4*)(x + 256 * j + 4 * C.lane); s[u] += v[u][j].x * v[u][j].x + v[u][j].y * v[u][j].y + v[u][j].z * v[u][j].z + v[u][j].w * v[u][j].w; } }
#pragma unroll
        for (int u = 0; u < 4; ++u) { const int row = row0 + u * NGW; const float rstd = rsqrtf(wave_sum(s[u]) * (1.f / D) + EPS);
            if (row < T) { float* x = C.out + (size_t)row * D;
#pragma unroll
                for (int j = 0; j < 4; ++j) { const int c = 256 * j + 4 * C.lane; *(f32x4*)(x + c) = v[u][j] * rstd * *(const f32x4*)(nw + c); } } }
    }
}
DI void phase_mla_prep(const Ctx& C, int l) {
    const int gw = C.bid * NWAVES + C.wave, NGW = C.G * NWAVES;
    const bf16* pA = (const bf16*)(C.ws + WS_PA); bf16* qn = (bf16*)(C.ws + WS_QN16); bf16* ckv = (bf16*)(C.ws + WS_CKV16);
    const float* wq = C.in[20] + l * 256; const float* wkv = C.in[22] + l * 128; const float* rt = (const float*)(C.ws + WS_ROPE);
    for (int row0 = gw; row0 < T; row0 += 2 * NGW) {
        unsigned qa[2], qb[2]; float ka[2], kb[2]; float* op[2]; unsigned kpe1[2], kpe2[2], sk1[2], sk2[2];
#pragma unroll
        for (int u = 0; u < 2; ++u) { const int row = row0 + u * NGW; const bf16* p = pA + (size_t)row * NA;
            const unsigned* pq = (const unsigned*)p + 2 * C.lane; qa[u] = pq[0]; qb[u] = pq[1]; op[u] = nullptr; kpe1[u] = kpe2[u] = sk1[u] = sk2[u] = 0u;
            if (row < TC) { float* o = C.out + O_CKV + ((size_t)((row >> 8) * 2 + l) * 256 + (row & 255)) * 128; op[u] = o; ka[u] = o[2 * C.lane]; kb[u] = o[2 * C.lane + 1]; }
            else { const unsigned vv = ((const unsigned*)(p + 256))[C.lane]; ka[u] = bflo(vv); kb[u] = bfhi(vv);
                const int i16 = C.lane & 15, kvh = C.lane >> 5, i32 = C.lane & 31;
                kpe1[u] = p[384 + i16]; kpe2[u] = p[400 + i16]; sk1[u] = p[672 + kvh * 64 + i32]; sk2[u] = p[672 + kvh * 64 + 32 + i32]; } }
#pragma unroll
        for (int u = 0; u < 2; ++u) { const int row = row0 + u * NGW;
            { const float x0 = bflo(qa[u]), x1 = bfhi(qa[u]), x2 = bflo(qb[u]), x3 = bfhi(qb[u]);
              const float r = rsqrtf(wave_sum(x0 * x0 + x1 * x1 + x2 * x2 + x3 * x3) * (1.f / 256) + EPS); const f32x4 w = *(const f32x4*)(wq + 4 * C.lane);
              u32x2 o; o.x = pk2(x0 * r * w.x, x1 * r * w.y); o.y = pk2(x2 * r * w.z, x3 * r * w.w); *(u32x2*)(qn + (size_t)row * 256 + 4 * C.lane) = o; }
            const float r = rsqrtf(wave_sum(ka[u] * ka[u] + kb[u] * kb[u]) * (1.f / 128) + EPS); const float a = ka[u] * r * wkv[2 * C.lane], b = kb[u] * r * wkv[2 * C.lane + 1];
            if (op[u]) { op[u][2 * C.lane] = a; op[u][2 * C.lane + 1] = b; }
            unsigned* co = (unsigned*)(ckv + (size_t)row * 256); co[C.lane] = pk2(a, b); co[64 + C.lane] = 0u;
            if (row >= TC) { const int lr = row - TC, t = lr & 4095;
                bf16* kper = (bf16*)(C.ws + WS_KPER) + (size_t)lr * 32; bf16* ksr = (bf16*)(C.ws + WS_KSR) + (size_t)lr * 128;
                if (C.lane < 16) { const int i = C.lane; const float x1 = bflo(kpe1[u]), x2 = bflo(kpe2[u]), c = rt[t * 16 + i], s = rt[65536 + t * 16 + i];
                    kper[i] = (bf16)f2bf(x1 * c - x2 * s); kper[16 + i] = (bf16)f2bf(x1 * s + x2 * c); }
                { const int kvh = C.lane >> 5, i = C.lane & 31; const float x1 = bflo(sk1[u]), x2 = bflo(sk2[u]), c = rt[131072 + t * 32 + i], s = rt[262144 + t * 32 + i];
                    ksr[kvh * 64 + i] = (bf16)f2bf(x1 * c - x2 * s); ksr[kvh * 64 + 32 + i] = (bf16)f2bf(x1 * s + x2 * c); } }
        }
    }
}
DI void mm64(f32x4& c0, f32x4& c1, const LAS float* A, int sai, int sak, const LAS float* B, int sbk, int sbj, int wave, int lane) {
    const int r = lane & 15, q = lane >> 4, tr = wave >> 1, tc = (wave & 1) * 2;
    const LAS float* ap = A + (tr * 16 + r) * sai + q * sak;
    const LAS float* bp = B + q * sbk + (tc * 16 + r) * sbj;
#pragma unroll
    for (int s0 = 0; s0 < 16; s0 += 8) { float av[8], b0v[8], b1v[8];
#pragma unroll
        for (int s = 0; s < 8; ++s) { av[s] = ap[4 * (s0 + s) * sak]; b0v[s] = bp[4 * (s0 + s) * sbk]; b1v[s] = bp[4 * (s0 + s) * sbk + 16 * sbj]; }
        __builtin_amdgcn_sched_barrier(0);
#pragma unroll
        for (int s = 0; s < 8; ++s) { c0 = __builtin_amdgcn_mfma_f32_16x16x4f32(av[s], b0v[s], c0, 0, 0, 0); c1 = __builtin_amdgcn_mfma_f32_16x16x4f32(av[s], b1v[s], c1, 0, 0, 0); } }
}
DI void lds_sync() { asm volatile("s_waitcnt lgkmcnt(0)" ::: "memory"); __builtin_amdgcn_s_barrier(); asm volatile("" ::: "memory"); }
constexpr int BS = 72;
constexpr int BTB = 64 * BS * 2;
DI void mmb(f32x4& c0, f32x4& c1, const LAS bf16* A, const LAS bf16* B, int wave, int lane) {
    const int r = lane & 15, q = lane >> 4, tr = wave >> 1, tc = (wave & 1) * 2;
    const LAS bf16* ap = A + (tr * 16 + r) * BS + q * 8; const LAS bf16* bp = B + (tc * 16 + r) * BS + q * 8;
#pragma unroll
    for (int ks = 0; ks < 2; ++ks) {
        const bf16x8 a = *(const LAS bf16x8*)(ap + ks * 32), b0 = *(const LAS bf16x8*)(bp + ks * 32), b1 = *(const LAS bf16x8*)(bp + 16 * BS + ks * 32);
        c0 = __builtin_amdgcn_mfma_f32_16x16x32_bf16(a, b0, c0, 0, 0, 0);
        c1 = __builtin_amdgcn_mfma_f32_16x16x32_bf16(a, b1, c1, 0, 0, 0);
    }
}
#define MM_EPI(c0, c1, body) do { const int r_ = C.lane & 15, q_ = C.lane >> 4, tr_ = C.wave >> 1, tc_ = (C.wave & 1) * 2; \
    _Pragma("unroll") for (int j_ = 0; j_ < 4; ++j_) { const int row = tr_ * 16 + q_ * 4 + j_; { const int col = tc_ * 16 + r_; const float val = c0[j_]; body } { const int col = tc_ * 16 + 16 + r_; const float val = c1[j_]; body } } } while (0)
constexpr int FS = 68;
constexpr int FTB = 18432;
constexpr int LS = 68;
constexpr f32x4 Z4 = {0.f, 0.f, 0.f, 0.f};
DI bf16 tobf(float x) { return (bf16)f2bf(x); }

DI void tri_solve_blocked(const Ctx& C, const LAS float* As, LAS float* Us, LAS float* Ws, LAS float* Dv, LAS bf16* Wb) {
    if (C.wave == 0) { const int b = C.lane >> 4, c = C.lane & 15; float x[16];
#pragma unroll
        for (int i = 0; i < 16; ++i) { float v = (i == c) ? 1.f : 0.f;
#pragma unroll
            for (int j4 = 0; j4 < (i + 3) / 4; ++j4) { const f32x4 a = *(const LAS f32x4*)(As + (16 * b + i) * FS + 16 * b + 4 * j4);
                if (4 * j4 + 0 < i) v -= a.x * x[4 * j4 + 0];
                if (4 * j4 + 1 < i) v -= a.y * x[4 * j4 + 1];
                if (4 * j4 + 2 < i) v -= a.z * x[4 * j4 + 2];
                if (4 * j4 + 3 < i) v -= a.w * x[4 * j4 + 3]; }
            x[i] = v; Dv[(b * 16 + i) * 16 + c] = v; } }
    lds_sync();
    { LAS float* X = (C.wave < 4 ? Us : Ws) + (C.wave & 3) * 16; const int r = C.lane & 15, q = C.lane >> 4;
#pragma unroll
      for (int bi = 0; bi < 4; ++bi) {
          f32x4 c, c2 = Z4;
#pragma unroll
          for (int j = 0; j < 4; ++j) c[j] = X[(16 * bi + 4 * q + j) * FS + r];
          if (bi > 0) { float av[12], bv[12];
#pragma unroll
              for (int s = 0; s < 4 * bi; ++s) { av[s] = -As[(16 * bi + r) * FS + 4 * s + q]; bv[s] = X[(4 * s + q) * FS + r]; }
              __builtin_amdgcn_sched_barrier(0);
#pragma unroll
              for (int s = 0; s < 4 * bi; s += 2) { c = __builtin_amdgcn_mfma_f32_16x16x4f32(av[s], bv[s], c, 0, 0, 0); c2 = __builtin_amdgcn_mfma_f32_16x16x4f32(av[s + 1], bv[s + 1], c2, 0, 0, 0); }
              c += c2;
#pragma unroll
              for (int j = 0; j < 4; ++j) X[(16 * bi + 4 * q + j) * FS + r] = c[j]; }
          f32x4 dd = Z4, d2 = Z4; float dv[4], xv[4];
#pragma unroll
          for (int s = 0; s < 4; ++s) { dv[s] = Dv[(bi * 16 + r) * 16 + 4 * s + q]; xv[s] = X[(16 * bi + 4 * s + q) * FS + r]; }
          __builtin_amdgcn_sched_barrier(0);
          dd = __builtin_amdgcn_mfma_f32_16x16x4f32(dv[0], xv[0], dd, 0, 0, 0); d2 = __builtin_amdgcn_mfma_f32_16x16x4f32(dv[1], xv[1], d2, 0, 0, 0);
          dd = __builtin_amdgcn_mfma_f32_16x16x4f32(dv[2], xv[2], dd, 0, 0, 0); d2 = __builtin_amdgcn_mfma_f32_16x16x4f32(dv[3], xv[3], d2, 0, 0, 0);
          dd += d2;
#pragma unroll
          for (int j = 0; j < 4; ++j) X[(16 * bi + 4 * q + j) * FS + r] = dd[j];
          if (Wb && C.wave >= 4) {
#pragma unroll
              for (int j = 0; j < 4; ++j) Wb[(16 * bi + 4 * q + j) * BS + (C.wave & 3) * 16 + r] = tobf(dd[j]); }
      } }
    lds_sync();
}
DI void wave_cumsum(const LAS float* src, LAS float* dst, int lane) {
    float v = src[lane];
#pragma unroll
    for (int o = 1; o < 64; o <<= 1) { const float t = __shfl_up(v, o); if (lane >= o) v += t; }
    dst[lane] = v;
}

DI void store_T8(LAS bf16* T, int c8, int i, int j, u32x4 w) {
    unsigned a0 = w.x, a1 = w.y, a2 = w.z, a3 = w.w;
    { const bool on = (j & 1) != 0; const unsigned b0 = __builtin_amdgcn_alignbit(a1, a0, 16), b1 = __builtin_amdgcn_alignbit(a2, a1, 16), b2 = __builtin_amdgcn_alignbit(a3, a2, 16), b3 = __builtin_amdgcn_alignbit(a0, a3, 16);
      a0 = on ? b0 : a0; a1 = on ? b1 : a1; a2 = on ? b2 : a2; a3 = on ? b3 : a3; }
    { const bool on = (j & 2) != 0; const unsigned b0 = a1, b1 = a2, b2 = a3, b3 = a0; a0 = on ? b0 : a0; a1 = on ? b1 : a1; a2 = on ? b2 : a2; a3 = on ? b3 : a3; }
    { const bool on = (j & 4) != 0; const unsigned b0 = a2, b1 = a3, b2 = a0, b3 = a1; a0 = on ? b0 : a0; a1 = on ? b1 : a1; a2 = on ? b2 : a2; a3 = on ? b3 : a3; }
    LAS bf16* t = T + i;
    t[(c8 + ((0 + j) & 7)) * BS] = (bf16)(a0 & 0xffffu); t[(c8 + ((1 + j) & 7)) * BS] = (bf16)(a0 >> 16);
    t[(c8 + ((2 + j) & 7)) * BS] = (bf16)(a1 & 0xffffu); t[(c8 + ((3 + j) & 7)) * BS] = (bf16)(a1 >> 16);
    t[(c8 + ((4 + j) & 7)) * BS] = (bf16)(a2 & 0xffffu); t[(c8 + ((5 + j) & 7)) * BS] = (bf16)(a2 >> 16);
    t[(c8 + ((6 + j) & 7)) * BS] = (bf16)(a3 & 0xffffu); t[(c8 + ((7 + j) & 7)) * BS] = (bf16)(a3 >> 16);
}
struct DnLds { LAS float *As, *Us, *Ws, *Ss, *gc, *bt, *gr, *Dv; LAS bf16 *Kb, *KT, *Qb, *StT, *QKb, *Wb, *VnT, *VnsT, *oacc; LAS float *Mt, *Nt, *Mc, *Nc; LAS bf16 *WfT, *UfT; };
DI DnLds dn_lds3(LAS unsigned char* l) { DnLds L{};
    L.As = (LAS float*)l; L.Us = (LAS float*)(l + FTB); L.Ws = (LAS float*)(l + 2 * FTB); L.Ss = (LAS float*)(l + 3 * FTB);
    LAS unsigned char* b = l + 4 * FTB; L.Kb = (LAS bf16*)b; L.KT = (LAS bf16*)(b + BTB); L.Qb = (LAS bf16*)(b + 2 * BTB); L.StT = (LAS bf16*)(b + 3 * BTB); L.Wb = (LAS bf16*)(b + 4 * BTB);
    L.gc = (LAS float*)(b + 5 * BTB); L.bt = L.gc + 64; L.gr = L.bt + 64; L.Dv = (LAS float*)(b + 5 * BTB + 768);
    L.QKb = (LAS bf16*)l; L.VnT = (LAS bf16*)(l + 2 * FTB); L.VnsT = (LAS bf16*)(l + 2 * FTB + BTB); return L; }
DI DnLds dn_lds1(LAS unsigned char* l) { DnLds L{};
    L.As = (LAS float*)l; L.Us = (LAS float*)(l + FTB); L.Ws = (LAS float*)(l + 2 * FTB);
    LAS unsigned char* m = l + 3 * FTB; L.Mt = (LAS float*)m; L.Nt = (LAS float*)(m + 17408);
    LAS unsigned char* b = m + 2 * 17408; L.Kb = (LAS bf16*)b; L.KT = (LAS bf16*)(b + BTB); L.Wb = (LAS bf16*)(b + 2 * BTB); L.StT = (LAS bf16*)(b + 3 * BTB); L.Qb = (LAS bf16*)(b + 4 * BTB);
    L.gc = (LAS float*)(b + 5 * BTB); L.bt = L.gc + 64; L.gr = L.bt + 64; L.Dv = (LAS float*)(b + 5 * BTB + 768);
    L.VnT = (LAS bf16*)(l + 2 * FTB); L.VnsT = (LAS bf16*)(l + 2 * FTB + BTB); return L; }

struct DnRaw { u32x4 r[3][3]; float wa, wb, wc; float sb, sa; };
DI DnRaw dn_fetch(const Ctx& C, const bf16* pB, const float* side, int row0, int seq_len, int t0, int rev, int h, int d, bool wantq) {
    DnRaw R; const int i = C.tid >> 3, c8 = (C.tid & 7) * 8; const int t = rev ? (t0 + 63 - i) : (t0 + i);
#pragma unroll
    for (int dd = 0; dd < 3; ++dd) { const int tt = t + dd - 1; const int tc = tt < 0 ? 0 : (tt >= seq_len ? seq_len - 1 : tt); { const float wv_ = (tt == tc) ? 1.f : 0.f; if (dd == 0) R.wa = wv_; else if (dd == 1) R.wb = wv_; else R.wc = wv_; }
        const bf16* rp = pB + (size_t)(row0 + tc) * NB + h * 64 + c8;
        R.r[0][dd] = wantq ? *(const u32x4*)rp : (u32x4){0u, 0u, 0u, 0u}; R.r[1][dd] = *(const u32x4*)(rp + 256); R.r[2][dd] = *(const u32x4*)(rp + 512); }
    R.sb = 0.f; R.sa = 0.f;
    if (C.wave == 0) { const int tw = rev ? (t0 + 63 - C.lane) : (t0 + C.lane); const float* s = side + (size_t)(row0 + tw) * 24; R.sb = s[d * 4 + h]; R.sa = s[8 + d * 4 + h]; }
    return R;
}
constexpr int CW_OFF = 143360;
DI void dn_stage_cw(const Ctx& C, const float* convw, int h) { LAS float* cw = (LAS float*)(C.lds + CW_OFF);
    for (int i = C.tid; i < 576; i += NTHR) { const int dw = i >> 6, c = i & 63, dd = dw / 3, which = dw - dd * 3; cw[i] = convw[dd * 768 + which * 256 + h * 64 + c]; } }
DI void dn_consume(const Ctx& C, const DnLds& L, const DnRaw& R, float a_neg, float dtb, int h, bool wantq) {
    const LAS float* cw = (const LAS float*)(C.lds + CW_OFF);
    const int i = C.tid >> 3, c8 = (C.tid & 7) * 8;
#pragma unroll
    for (int which = 0; which < 3; ++which) {
        if (which == 0 && !wantq) continue;
        const int col = which * 256 + h * 64 + c8; float acc[8];
#pragma unroll
        for (int e = 0; e < 8; ++e) acc[e] = 0.f;
#pragma unroll
        for (int dd = 0; dd < 3; ++dd) { float x[8]; unpack8(R.r[which][dd], x); const LAS float* w = cw + (dd * 3 + which) * 64 + c8;
            const float wzd = dd == 0 ? R.wa : (dd == 1 ? R.wb : R.wc); const f32x4 w0 = *(const LAS f32x4*)w * wzd, w1 = *(const LAS f32x4*)(w + 4) * wzd;
            acc[0] += w0.x * x[0]; acc[1] += w0.y * x[1]; acc[2] += w0.z * x[2]; acc[3] += w0.w * x[3]; acc[4] += w1.x * x[4]; acc[5] += w1.y * x[5]; acc[6] += w1.z * x[6]; acc[7] += w1.w * x[7]; }
        float ss = 0.f;
#pragma unroll
        for (int e = 0; e < 8; ++e) { acc[e] = fsilu(acc[e]); ss += acc[e] * acc[e]; }
        if (which < 2) { ss += __shfl_xor(ss, 1); ss += __shfl_xor(ss, 2); ss += __shfl_xor(ss, 4); const float rr = __builtin_amdgcn_rsqf(ss + EPS) * (which == 0 ? 0.125f : 1.f);
#pragma unroll
            for (int e = 0; e < 8; ++e) acc[e] *= rr; }
        if (which == 0) *(LAS u32x4*)(L.Qb + i * BS + c8) = pack8(acc);
        else if (which == 1) { *(LAS u32x4*)(L.Kb + i * BS + c8) = pack8(acc);
            store_T8(L.KT, c8, i, C.tid & 7, pack8(acc));
            LAS float* dst = L.Ws + i * FS + c8; *(LAS f32x4*)dst = (f32x4){acc[0], acc[1], acc[2], acc[3]}; *(LAS f32x4*)(dst + 4) = (f32x4){acc[4], acc[5], acc[6], acc[7]}; }
        else { LAS float* dst = L.Us + i * FS + c8; *(LAS f32x4*)dst = (f32x4){acc[0], acc[1], acc[2], acc[3]}; *(LAS f32x4*)(dst + 4) = (f32x4){acc[4], acc[5], acc[6], acc[7]}; }
    }
    if (C.wave == 0) { L.bt[C.lane] = __builtin_amdgcn_rcpf(1.f + __expf(-R.sb));
        float v = a_neg * fsoftplus(R.sa + dtb);
#pragma unroll
        for (int o = 1; o < 64; o <<= 1) { const float tt = __shfl_up(v, o); if (C.lane >= o) v += tt; }
        L.gc[C.lane] = v; }
}
DI void dn_prepare(const Ctx& C, const DnLds& L, LAS bf16* Wb) {
    lds_sync();
    { const int i = C.tid >> 3, c8 = (C.tid & 7) * 8; const float b = L.bt[i], be = b * __expf(L.gc[i]);
#pragma unroll
        for (int e = 0; e < 8; ++e) { L.Us[i * FS + c8 + e] *= b; L.Ws[i * FS + c8 + e] *= be; } }
    { f32x4 c0 = Z4, c1 = Z4; mmb(c0, c1, L.Kb, L.Kb, C.wave, C.lane);
      MM_EPI(c0, c1, { L.As[row * FS + col] = col < row ? val * L.bt[row] * __expf(L.gc[row] - L.gc[col]) : 0.f; }); }
    lds_sync();
    tri_solve_blocked(C, L.As, L.Us, L.Ws, L.Dv, Wb);
}
DI void dn_phase1_item(const Ctx& C, int l, int item) {
    const DnLds L = dn_lds1(C.lds);
    const int v = item >> 3, h = (item >> 1) & 3, d = item & 1, b = v >> 4, tsc = v & 15;
    const bf16* pB = (const bf16*)(C.ws + WS_PB); const float* side = (const float*)(C.ws + WS_SIDE);
    const float* convw = C.in[16] + (size_t)l * 3 * 768; const float a_neg = -expf(C.in[17][l * 8 + d * 4 + h]), dtb = C.in[18][l * 8 + d * 4 + h];
    const int row0 = TC + b * 4096;
    LAS bf16* MtT = L.StT; LAS bf16* NtT = L.Qb;
    { const int i = C.tid >> 3, c8 = (C.tid & 7) * 8;
#pragma unroll
        for (int e = 0; e < 8; ++e) { const float mv = (i == c8 + e) ? 1.f : 0.f; L.Mt[i * LS + c8 + e] = mv; L.Nt[i * LS + c8 + e] = 0.f; MtT[(c8 + e) * BS + i] = tobf(mv); NtT[(c8 + e) * BS + i] = 0; } }
    dn_stage_cw(C, convw, h);
    DnRaw R = dn_fetch(C, pB, side, row0, 4096, tsc * 256 + 64 * (d ? 3 : 0), d, h, d, false);
    lds_sync();
#pragma unroll 1
    for (int cc = 0; cc < 4; ++cc) {
        dn_consume(C, L, R, a_neg, dtb, h, false);
        if (cc < 3) R = dn_fetch(C, pB, side, row0, 4096, tsc * 256 + 64 * (d ? 2 - cc : cc + 1), d, h, d, false);
        dn_prepare(C, L, L.Wb);
        const float glast = L.gc[63];
        { f32x4 c0 = Z4, c1 = Z4; mmb(c0, c1, L.Wb, MtT, C.wave, C.lane);
          MM_EPI(c0, c1, { L.VnT[col * BS + row] = tobf(-val * __expf(glast - L.gc[row])); }); }
        { f32x4 c0 = Z4, c1 = Z4; mmb(c0, c1, L.Wb, NtT, C.wave, C.lane);
          MM_EPI(c0, c1, { L.VnsT[col * BS + row] = tobf((L.Us[row * FS + col] - val) * __expf(glast - L.gc[row])); }); }
        lds_sync();
        const float eg = __expf(glast);
        { f32x4 c0 = Z4, c1 = Z4; mmb(c0, c1, L.KT, L.VnT, C.wave, C.lane);
          MM_EPI(c0, c1, { const float mn_ = L.Mt[row * LS + col] * eg + val; L.Mt[row * LS + col] = mn_; MtT[col * BS + row] = tobf(mn_); }); }
        { f32x4 c0 = Z4, c1 = Z4; mmb(c0, c1, L.KT, L.VnsT, C.wave, C.lane);
          MM_EPI(c0, c1, { const float nn_ = L.Nt[row * LS + col] * eg + val; L.Nt[row * LS + col] = nn_; NtT[col * BS + row] = tobf(nn_); }); }
        lds_sync();
    }
    float* mn = (float*)(C.ws + WS_MN) + (size_t)item * 8192;
    { const int i = C.tid >> 3, c8 = (C.tid & 7) * 8;
#pragma unroll
        for (int e = 0; e < 8; ++e) { mn[i * 64 + c8 + e] = L.Mt[i * LS + c8 + e]; mn[4096 + i * 64 + c8 + e] = L.Nt[i * LS + c8 + e]; } }
    __syncthreads();
}
DI void dn_scan_unit(const Ctx& C, int l, int unit) {
    LAS float* Ml = (LAS float*)C.lds; LAS float* Sl = Ml + 64 * LS;
    const int chain = unit >> 2, e0 = (unit & 3) * 16, b = chain >> 3, h = (chain >> 1) & 3, d = chain & 1;
    const float* s0 = C.in[3] + ((size_t)((b * 2 + l) * 2 + d) * 4 + h) * 4096;
    const int a = C.tid >> 3, e2 = (C.tid & 7) * 2, c8 = (C.tid & 7) * 8;
    float* base = (float*)(C.ws + WS_MN);
    Sl[a * 16 + e2] = s0[a * 64 + e0 + e2]; Sl[a * 16 + e2 + 1] = s0[a * 64 + e0 + e2 + 1];
    f32x4 m0, m1; float n0, n1;
    { const int tsc = d ? 15 : 0; const float* mg = base + (size_t)(((b * 16 + tsc) * 8) + h * 2 + d) * 8192;
      m0 = *(const f32x4*)(mg + a * 64 + c8); m1 = *(const f32x4*)(mg + a * 64 + c8 + 4); n0 = mg[4096 + a * 64 + e0 + e2]; n1 = mg[4096 + a * 64 + e0 + e2 + 1]; }
#pragma unroll 1
    for (int k = 0; k < 16; ++k) {
        const int tsc = d ? 15 - k : k; float* ng = base + (size_t)(((b * 16 + tsc) * 8) + h * 2 + d) * 8192 + 4096;
        *(LAS f32x4*)(Ml + a * LS + c8) = m0; *(LAS f32x4*)(Ml + a * LS + c8 + 4) = m1;
        float acc0 = n0, acc1 = n1;
        lds_sync();
        if (k < 15) { const int t2 = d ? 14 - k : k + 1; const float* mg = base + (size_t)(((b * 16 + t2) * 8) + h * 2 + d) * 8192;
            m0 = *(const f32x4*)(mg + a * 64 + c8); m1 = *(const f32x4*)(mg + a * 64 + c8 + 4); n0 = mg[4096 + a * 64 + e0 + e2]; n1 = mg[4096 + a * 64 + e0 + e2 + 1]; }
#pragma unroll 8
        for (int bb = 0; bb < 64; ++bb) { const float m = Ml[a * LS + bb]; acc0 += m * Sl[bb * 16 + e2]; acc1 += m * Sl[bb * 16 + e2 + 1]; }
        ng[a * 64 + e0 + e2] = Sl[a * 16 + e2]; ng[a * 64 + e0 + e2 + 1] = Sl[a * 16 + e2 + 1];
        lds_sync();
        Sl[a * 16 + e2] = acc0; Sl[a * 16 + e2 + 1] = acc1;
        lds_sync();
    }
    __syncthreads();
}
DI void dn_phase3_item(const Ctx& C, int l, int item) {
    const DnLds L = dn_lds3(C.lds);
    const int u = item >> 2, h = item & 3; const bool lat = u >= 32;
    const int v = u - 32, b = lat ? (v >> 4) : u, tsc = lat ? (v & 15) : 0;
    const int row0 = lat ? TC + b * 4096 : u * 256, seq_len = lat ? 4096 : 256, tbase = tsc * 256;
    const bf16* pB = (const bf16*)(C.ws + WS_PB); const float* side = (const float*)(C.ws + WS_SIDE); bf16* mix = (bf16*)(C.ws + WS_MIX); bf16* of = (bf16*)(C.ws + WS_XN);
    const float* convw = C.in[16] + (size_t)l * 3 * 768; const float* dnw = C.in[19] + l * 64;
    dn_stage_cw(C, convw, h);
    lds_sync();
#pragma unroll 1
    for (int d = 0; d < 2; ++d) {
        const float a_neg = -expf(C.in[17][l * 8 + d * 4 + h]), dtb = C.in[18][l * 8 + d * 4 + h];
        DnRaw R = dn_fetch(C, pB, side, row0, seq_len, tbase + 64 * (d ? 3 : 0), d, h, d, true);
        { const int i = C.tid >> 3, c8 = (C.tid & 7) * 8; const float* sin_ = lat ? (const float*)(C.ws + WS_MN) + (size_t)((v * 8) + h * 2 + d) * 8192 + 4096 : nullptr;
#pragma unroll
            for (int e = 0; e < 8; ++e) { const float sv = lat ? sin_[i * 64 + c8 + e] : 0.f; L.Ss[i * FS + c8 + e] = sv; L.StT[(c8 + e) * BS + i] = tobf(sv); } }
#pragma unroll 1
        for (int cc = 0; cc < 4; ++cc) {
            const int cloc = d ? 3 - cc : cc, t0 = tbase + 64 * cloc;
            u32x4 zr = {0u, 0u, 0u, 0u}, fv = {0u, 0u, 0u, 0u};
            if (d == 1) { const int i = C.tid >> 3, c8 = (C.tid & 7) * 8; const size_t grow = (size_t)row0 + t0 + 63 - i; zr = *(const u32x4*)(pB + grow * NB + 768 + h * 64 + c8);
                const unsigned* fp = (const unsigned*)(of + grow * 256 + h * 64 + c8);
                fv.x = __hip_atomic_load(fp, __ATOMIC_RELAXED, __HIP_MEMORY_SCOPE_AGENT); fv.y = __hip_atomic_load(fp + 1, __ATOMIC_RELAXED, __HIP_MEMORY_SCOPE_AGENT);
                fv.z = __hip_atomic_load(fp + 2, __ATOMIC_RELAXED, __HIP_MEMORY_SCOPE_AGENT); fv.w = __hip_atomic_load(fp + 3, __ATOMIC_RELAXED, __HIP_MEMORY_SCOPE_AGENT); }
            dn_consume(C, L, R, a_neg, dtb, h, true);
            if (cc < 3) R = dn_fetch(C, pB, side, row0, seq_len, tbase + 64 * (d ? 2 - cc : cc + 1), d, h, d, true);
            dn_prepare(C, L, L.Wb);
            const float glast = L.gc[63];
            f32x4 o0 = Z4, o1 = Z4;
            { f32x4 c0 = Z4, c1 = Z4; mmb(c0, c1, L.Wb, L.StT, C.wave, C.lane);
              MM_EPI(c0, c1, { const float vn = L.Us[row * FS + col] - val; L.VnT[col * BS + row] = tobf(vn); L.VnsT[col * BS + row] = tobf(vn * __expf(glast - L.gc[row])); }); }
            { f32x4 c0 = Z4, c1 = Z4; mmb(c0, c1, L.Qb, L.Kb, C.wave, C.lane);
              MM_EPI(c0, c1, { L.QKb[row * BS + col] = tobf(col <= row ? val * __expf(L.gc[row] - L.gc[col]) : 0.f); }); }
            { mmb(o0, o1, L.Qb, L.StT, C.wave, C.lane); const int q_ = C.lane >> 4, tr_ = C.wave >> 1;
#pragma unroll
              for (int j = 0; j < 4; ++j) { const float f = __expf(L.gc[tr_ * 16 + q_ * 4 + j]); o0[j] *= f; o1[j] *= f; } }
            lds_sync();
            { mmb(o0, o1, L.QKb, L.VnT, C.wave, C.lane);
              MM_EPI(o0, o1, { L.Us[row * FS + col] = val; }); }
            { f32x4 c0 = Z4, c1 = Z4; mmb(c0, c1, L.KT, L.VnsT, C.wave, C.lane); const float eg = __expf(glast);
              MM_EPI(c0, c1, { const float sn = L.Ss[row * FS + col] * eg + val; L.Ss[row * FS + col] = sn; L.StT[col * BS + row] = tobf(sn); }); }
            lds_sync();
            { const int i = C.tid >> 3, c8 = (C.tid & 7) * 8; float o[8];
#pragma unroll
              for (int e = 0; e < 8; ++e) o[e] = L.Us[i * FS + c8 + e];
              if (d == 0) { const size_t grow = (size_t)row0 + t0 + i; *(u32x4*)(of + grow * 256 + h * 64 + c8) = pack8(o); }
              else { const size_t grow = (size_t)row0 + t0 + 63 - i;
                  float f8[8]; unpack8(fv, f8); float ss = 0.f;
#pragma unroll
                  for (int e = 0; e < 8; ++e) { o[e] += f8[e]; ss += o[e] * o[e]; }
                  ss += __shfl_xor(ss, 1); ss += __shfl_xor(ss, 2); ss += __shfl_xor(ss, 4);
                  const float rstd = rsqrtf(ss * (1.f / 64) + EPS);
                  float z[8]; unpack8(zr, z);
#pragma unroll
                  for (int e = 0; e < 8; ++e) o[e] = o[e] * rstd * dnw[c8 + e] * fsilu(z[e]);
                  *(u32x4*)(mix + grow * D + h * 64 + c8) = pack8(o); } }
        }
        if (!lat) { float* o = C.out + O_SDN + ((size_t)((u * 2 + l) * 2 + d) * 4 + h) * 4096; const int i = C.tid >> 3, c8 = (C.tid & 7) * 8;
#pragma unroll
            for (int e = 0; e < 8; ++e) o[i * 64 + c8 + e] = L.Ss[i * FS + c8 + e]; }
        __syncthreads();
    }
}
struct SsLds { LAS float *Xs, *Hs, *ac, *dts, *gr; LAS bf16 *Cb, *Bb, *BT, *XT, *XfT, *Hb, *Scb, *Hb2; };
DI SsLds ss_lds(LAS unsigned char* l) { SsLds L; L.Xs = (LAS float*)l; L.Hs = (LAS float*)(l + FTB); LAS unsigned char* b = l + 2 * FTB;
    L.Cb = (LAS bf16*)b; L.Bb = (LAS bf16*)(b + BTB); L.BT = (LAS bf16*)(b + 2 * BTB); L.XT = (LAS bf16*)(b + 3 * BTB); L.XfT = (LAS bf16*)(b + 4 * BTB); L.Hb = (LAS bf16*)(b + 5 * BTB); L.Scb = (LAS bf16*)(b + 6 * BTB);
    L.Hb2 = (LAS bf16*)(b + 7 * BTB); L.ac = (LAS float*)(b + 8 * BTB); L.dts = L.ac + 64; L.gr = L.dts + 64; return L; }
struct SsRaw { u32x4 r[3][3]; float wa, wb, wc; float sd; };
DI SsRaw ss_fetch(const Ctx& C, const bf16* pB, const float* side, int row0, int seq_len, int t0, int rev, int h, int d, bool wantc) {
    SsRaw R; const int i = C.tid >> 3, c8 = (C.tid & 7) * 8; const int t = rev ? (t0 + 63 - i) : (t0 + i); const int g = h >> 1;
#pragma unroll
    for (int dd = 0; dd < 3; ++dd) { const int tt = t + dd - 1; const int tc = tt < 0 ? 0 : (tt >= seq_len ? seq_len - 1 : tt); { const float wv_ = (tt == tc) ? 1.f : 0.f; if (dd == 0) R.wa = wv_; else if (dd == 1) R.wb = wv_; else R.wc = wv_; }
        const bf16* rp = pB + (size_t)(row0 + tc) * NB + 1296 + c8;
        R.r[0][dd] = *(const u32x4*)(rp + h * 64); R.r[1][dd] = *(const u32x4*)(rp + 256 + g * 64); R.r[2][dd] = wantc ? *(const u32x4*)(rp + 384 + g * 64) : (u32x4){0u, 0u, 0u, 0u}; }
    R.sd = 0.f;
    if (C.wave == 0) { const int tw = rev ? (t0 + 63 - C.lane) : (t0 + C.lane); R.sd = side[(size_t)(row0 + tw) * 24 + 16 + d * 4 + h]; }
    return R;
}
DI void ss_stage_cw(const Ctx& C, const float* convw, const float* convb, int h) { LAS float* cw = (LAS float*)(C.lds + CW_OFF); const int g = h >> 1;
    for (int i = C.tid; i < 768; i += NTHR) { const int j = i < 576 ? i : i - 576, dw = j >> 6, c = j & 63, dd = dw / 3, which = i < 576 ? dw - dd * 3 : dw;
        const int ch = (which == 0 ? h * 64 : which == 1 ? 256 + g * 64 : 384 + g * 64) + c; cw[i] = i < 576 ? convw[dd * 512 + ch] : convb[ch]; } }
DI void ss_consume(const Ctx& C, const SsLds& L, const SsRaw& R, float a_neg, float dtb, int h, bool wantc) {
    const LAS float* cw = (const LAS float*)(C.lds + CW_OFF);
    const int i = C.tid >> 3, c8 = (C.tid & 7) * 8; const int g = h >> 1;
#pragma unroll
    for (int which = 0; which < 3; ++which) {
        if (which == 2 && !wantc) continue;
        const int ch = (which == 0 ? h * 64 : which == 1 ? 256 + g * 64 : 384 + g * 64) + c8; float acc[8];
        { const f32x4 b0 = *(const LAS f32x4*)(cw + 576 + which * 64 + c8), b1 = *(const LAS f32x4*)(cw + 576 + which * 64 + c8 + 4); acc[0] = b0.x; acc[1] = b0.y; acc[2] = b0.z; acc[3] = b0.w; acc[4] = b1.x; acc[5] = b1.y; acc[6] = b1.z; acc[7] = b1.w; }
#pragma unroll
        for (int dd = 0; dd < 3; ++dd) { float x[8]; unpack8(R.r[which][dd], x); const LAS float* w = cw + (dd * 3 + which) * 64 + c8;
            const float wzd = dd == 0 ? R.wa : (dd == 1 ? R.wb : R.wc); const f32x4 w0 = *(const LAS f32x4*)w * wzd, w1 = *(const LAS f32x4*)(w + 4) * wzd;
            acc[0] += w0.x * x[0]; acc[1] += w0.y * x[1]; acc[2] += w0.z * x[2]; acc[3] += w0.w * x[3]; acc[4] += w1.x * x[4]; acc[5] += w1.y * x[5]; acc[6] += w1.z * x[6]; acc[7] += w1.w * x[7]; }
#pragma unroll
        for (int e = 0; e < 8; ++e) acc[e] = fsilu(acc[e]);
        if (which == 0) { LAS float* dst = L.Xs + i * FS + c8; *(LAS f32x4*)dst = (f32x4){acc[0], acc[1], acc[2], acc[3]}; *(LAS f32x4*)(dst + 4) = (f32x4){acc[4], acc[5], acc[6], acc[7]};
            store_T8(L.XT, c8, i, C.tid & 7, pack8(acc)); }
        else if (which == 1) { *(LAS u32x4*)(L.Bb + i * BS + c8) = pack8(acc);
            store_T8(L.BT, c8, i, C.tid & 7, pack8(acc)); }
        else *(LAS u32x4*)(L.Cb + i * BS + c8) = pack8(acc);
    }
    if (C.wave == 0) { const float dtv = fsoftplus(R.sd + dtb); L.dts[C.lane] = dtv;
        float v = a_neg * dtv;
#pragma unroll
        for (int o = 1; o < 64; o <<= 1) { const float tt = __shfl_up(v, o); if (C.lane >= o) v += tt; }
        L.ac[C.lane] = v; }
}
DI void ss_make_xf(const Ctx& C, const SsLds& L) {
    const int i = C.tid >> 3, c8 = (C.tid & 7) * 8; const float f = L.dts[i] * __expf(L.ac[63] - L.ac[i]);
    float xf[8];
#pragma unroll
    for (int e = 0; e < 8; ++e) xf[e] = L.Xs[i * FS + c8 + e] * f;
    store_T8(L.XfT, c8, i, C.tid & 7, pack8(xf));
}
DI void ss_phase1_item(const Ctx& C, int l, int item) {
    const SsLds L = ss_lds(C.lds);
    const int v = item >> 3, h = (item >> 1) & 3, d = item & 1, b = v >> 4, tsc = v & 15;
    const bf16* pB = (const bf16*)(C.ws + WS_PB); const float* side = (const float*)(C.ws + WS_SIDE);
    const float* convw = C.in[24] + (size_t)l * 3 * 512; const float* convb = C.in[25] + l * 512;
    const float a_neg = -expf(C.in[26][l * 8 + d * 4 + h]), dtb = C.in[27][l * 8 + d * 4 + h];
    const int row0 = TC + b * 4096;
    { const int i = C.tid >> 3, c8 = (C.tid & 7) * 8;
#pragma unroll
        for (int e = 0; e < 8; ++e) L.Hs[i * FS + c8 + e] = 0.f; }
    float dec = 0.f;
    ss_stage_cw(C, convw, convb, h);
    SsRaw R = ss_fetch(C, pB, side, row0, 4096, tsc * 256 + 64 * (d ? 3 : 0), d, h, d, false);
    lds_sync();
#pragma unroll 1
    for (int cc = 0; cc < 4; ++cc) {
        ss_consume(C, L, R, a_neg, dtb, h, false);
        if (cc < 3) R = ss_fetch(C, pB, side, row0, 4096, tsc * 256 + 64 * (d ? 2 - cc : cc + 1), d, h, d, false);
        lds_sync();
        const float alast = L.ac[63]; dec += alast;
        ss_make_xf(C, L);
        lds_sync();
        { f32x4 c0 = Z4, c1 = Z4; mmb(c0, c1, L.XfT, L.BT, C.wave, C.lane); const float eg = __expf(alast);
          MM_EPI(c0, c1, { L.Hs[row * FS + col] = L.Hs[row * FS + col] * eg + val; }); }
        lds_sync();
    }
    float* cs = (float*)(C.ws + WS_CS) + (size_t)item * 4096;
    { const int i = C.tid >> 3, c8 = (C.tid & 7) * 8;
#pragma unroll
        for (int e = 0; e < 8; ++e) cs[i * 64 + c8 + e] = L.Hs[i * FS + c8 + e]; }
    if (C.tid == 0) ((float*)(C.ws + WS_CD))[item] = expf(dec);
    __syncthreads();
}
DI void ss_scan(const Ctx& C, int l) {
    const int gid = C.bid * NTHR + C.tid; if (gid >= 32 * 4096) return;
    const int chain = gid >> 12, e = gid & 4095, b = chain >> 3, h = (chain >> 1) & 3, d = chain & 1;
    float st = C.in[6][((size_t)((b * 2 + l) * 2 + d) * 4 + h) * 4096 + e];
    float* cs = (float*)(C.ws + WS_CS); const float* cd = (const float*)(C.ws + WS_CD);
    float cv[16], dv[16];
#pragma unroll
    for (int k = 0; k < 16; ++k) { const int tsc = d ? 15 - k : k; const size_t slot = (size_t)((b * 16 + tsc) * 8) + h * 2 + d; cv[k] = cs[slot * 4096 + e]; dv[k] = cd[slot]; }
#pragma unroll
    for (int k = 0; k < 16; ++k) { const int tsc = d ? 15 - k : k; const size_t slot = (size_t)((b * 16 + tsc) * 8) + h * 2 + d; cs[slot * 4096 + e] = st; st = st * dv[k] + cv[k]; }
}
DI void ss_phase3_item(const Ctx& C, int l, int item) {
    const SsLds L = ss_lds(C.lds);
    const int u = item >> 2, h = item & 3; const bool lat = u >= 32;
    const int v = u - 32, b = lat ? (v >> 4) : u, tsc = lat ? (v & 15) : 0;
    const int row0 = lat ? TC + b * 4096 : u * 256, seq_len = lat ? 4096 : 256, tbase = tsc * 256;
    const bf16* pB = (const bf16*)(C.ws + WS_PB); const float* side = (const float*)(C.ws + WS_SIDE); bf16* mix = (bf16*)(C.ws + WS_MIX); float* ssq = (float*)(C.ws + WS_SSQ); bf16* yf = (bf16*)(C.ws + WS_XN) + (size_t)T * 256;
    const float* convw = C.in[24] + (size_t)l * 3 * 512; const float* convb = C.in[25] + l * 512; const float Dh = C.in[28][l * 4 + h];
    ss_stage_cw(C, convw, convb, h);
    lds_sync();
#pragma unroll 1
    for (int d = 0; d < 2; ++d) {
        const float a_neg = -expf(C.in[26][l * 8 + d * 4 + h]), dtb = C.in[27][l * 8 + d * 4 + h];
        SsRaw R = ss_fetch(C, pB, side, row0, seq_len, tbase + 64 * (d ? 3 : 0), d, h, d, true);
        { const int i = C.tid >> 3, c8 = (C.tid & 7) * 8; const float* sin_ = lat ? (const float*)(C.ws + WS_CS) + (size_t)((v * 8) + h * 2 + d) * 4096 : nullptr;
#pragma unroll
            for (int e = 0; e < 8; ++e) { const float sv = lat ? sin_[i * 64 + c8 + e] : 0.f; L.Hs[i * FS + c8 + e] = sv; L.Hb[i * BS + c8 + e] = tobf(sv); } }
#pragma unroll 1
        for (int cc = 0; cc < 4; ++cc) {
            LAS bf16* hb_cur = (cc & 1) ? L.Hb2 : L.Hb; LAS bf16* hb_nxt = (cc & 1) ? L.Hb : L.Hb2;
            const int cloc = d ? 3 - cc : cc, t0 = tbase + 64 * cloc;
            u32x4 zr = {0u, 0u, 0u, 0u}, fv = {0u, 0u, 0u, 0u};
            if (d == 1) { const int i = C.tid >> 3, c8 = (C.tid & 7) * 8; const size_t grow = (size_t)row0 + t0 + 63 - i; zr = *(const u32x4*)(pB + grow * NB + 1040 + h * 64 + c8);
                const unsigned* fp = (const unsigned*)(yf + grow * 256 + h * 64 + c8);
                fv.x = __hip_atomic_load(fp, __ATOMIC_RELAXED, __HIP_MEMORY_SCOPE_AGENT); fv.y = __hip_atomic_load(fp + 1, __ATOMIC_RELAXED, __HIP_MEMORY_SCOPE_AGENT);
                fv.z = __hip_atomic_load(fp + 2, __ATOMIC_RELAXED, __HIP_MEMORY_SCOPE_AGENT); fv.w = __hip_atomic_load(fp + 3, __ATOMIC_RELAXED, __HIP_MEMORY_SCOPE_AGENT); }
            ss_consume(C, L, R, a_neg, dtb, h, true);
            if (cc < 3) R = ss_fetch(C, pB, side, row0, seq_len, tbase + 64 * (d ? 2 - cc : cc + 1), d, h, d, true);
            lds_sync();
            const float alast = L.ac[63];
            ss_make_xf(C, L);
            { f32x4 c0 = Z4, c1 = Z4; mmb(c0, c1, L.Cb, L.Bb, C.wave, C.lane);
              MM_EPI(c0, c1, { L.Scb[row * BS + col] = tobf(col <= row ? val * __expf(L.ac[row] - L.ac[col]) * L.dts[col] : 0.f); }); }
            lds_sync();
            { f32x4 c0 = Z4, c1 = Z4; mmb(c0, c1, L.Cb, hb_cur, C.wave, C.lane);
              { const int q_ = C.lane >> 4, tr_ = C.wave >> 1;
#pragma unroll
                for (int j = 0; j < 4; ++j) { const float f = __expf(L.ac[tr_ * 16 + q_ * 4 + j]); c0[j] *= f; c1[j] *= f; } }
              mmb(c0, c1, L.Scb, L.XT, C.wave, C.lane);
              MM_EPI(c0, c1, { L.Xs[row * FS + col] = d == 0 ? val + Dh * L.Xs[row * FS + col] : val; }); }
            { f32x4 c0 = Z4, c1 = Z4; mmb(c0, c1, L.XfT, L.BT, C.wave, C.lane); const float eg = __expf(alast);
              MM_EPI(c0, c1, { const float hn = L.Hs[row * FS + col] * eg + val; L.Hs[row * FS + col] = hn; hb_nxt[row * BS + col] = tobf(hn); }); }
            lds_sync();
            { const int i = C.tid >> 3, c8 = (C.tid & 7) * 8; float o[8];
#pragma unroll
              for (int e = 0; e < 8; ++e) o[e] = L.Xs[i * FS + c8 + e];
              if (d == 0) { const size_t grow = (size_t)row0 + t0 + i; *(u32x4*)(yf + grow * 256 + h * 64 + c8) = pack8(o); }
              else { const size_t grow = (size_t)row0 + t0 + 63 - i;
                  float f8[8], z[8]; unpack8(fv, f8); unpack8(zr, z); float ss = 0.f;
#pragma unroll
                  for (int e = 0; e < 8; ++e) { o[e] = (o[e] + f8[e]) * fsilu(z[e]); ss += o[e] * o[e]; }
                  ss += __shfl_xor(ss, 1); ss += __shfl_xor(ss, 2); ss += __shfl_xor(ss, 4);
                  *(u32x4*)(mix + grow * D + 512 + h * 64 + c8) = pack8(o);
                  if ((C.tid & 7) == 0) ssq[grow * 4 + h] = ss; } }
        }
        if (!lat) { float* o = C.out + O_SSM + ((size_t)((u * 2 + l) * 2 + d) * 4 + h) * 4096; const int i = C.tid >> 3, c8 = (C.tid & 7) * 8;
#pragma unroll
            for (int e = 0; e < 8; ++e) o[i * 64 + c8 + e] = L.Hs[i * FS + c8 + e]; }
        __syncthreads();
    }
}
DI void ssd_fix_rows(const Ctx& C, int l, int r0, int nrows, int g_lo, int g_n) {
    bf16* mix = (bf16*)(C.ws + WS_MIX); const unsigned* ssq = (const unsigned*)(C.ws + WS_SSQ); const float* nw = C.in[29] + l * 256;
    const int per_row = g_n * 16, rstep = NTHR / per_row;
    const int cc = C.tid % per_row, g = g_lo + (cc >> 4), c8 = (g * 16 + (cc & 15)) * 8, iters = nrows / rstep;
    float w8[8];
#pragma unroll
    for (int e = 0; e < 8; ++e) w8[e] = nw[c8 + e];
    for (int k0 = 0; k0 < iters; k0 += 4) {
        unsigned s0[4], s1[4]; u32x4 v[4];
#pragma unroll
        for (int u = 0; u < 4; ++u) { const int row = r0 + C.tid / per_row + (k0 + u) * rstep; const unsigned* p = (const unsigned*)(mix + (size_t)row * D + 512 + c8);
            s0[u] = __hip_atomic_load(ssq + (size_t)row * 4 + 2 * g, __ATOMIC_RELAXED, __HIP_MEMORY_SCOPE_AGENT); s1[u] = __hip_atomic_load(ssq + (size_t)row * 4 + 2 * g + 1, __ATOMIC_RELAXED, __HIP_MEMORY_SCOPE_AGENT);
            v[u].x = __hip_atomic_load(p, __ATOMIC_RELAXED, __HIP_MEMORY_SCOPE_AGENT); v[u].y = __hip_atomic_load(p + 1, __ATOMIC_RELAXED, __HIP_MEMORY_SCOPE_AGENT);
            v[u].z = __hip_atomic_load(p + 2, __ATOMIC_RELAXED, __HIP_MEMORY_SCOPE_AGENT); v[u].w = __hip_atomic_load(p + 3, __ATOMIC_RELAXED, __HIP_MEMORY_SCOPE_AGENT); }
#pragma unroll
        for (int u = 0; u < 4; ++u) { const int row = r0 + C.tid / per_row + (k0 + u) * rstep;
            const float rstd = __builtin_amdgcn_rsqf((__builtin_bit_cast(float, s0[u]) + __builtin_bit_cast(float, s1[u])) * (1.f / 128) + EPS);
            float x[8]; unpack8(v[u], x);
#pragma unroll
            for (int e = 0; e < 8; ++e) x[e] *= rstd * w8[e];
            *(u32x4*)(mix + (size_t)row * D + 512 + c8) = pack8(x); }
    }
}
DI void phase_ssd_fix(const Ctx& C, int l) {
    bf16* mix = (bf16*)(C.ws + WS_MIX); const float* ssq = (const float*)(C.ws + WS_SSQ); const float* nw = C.in[29] + l * 256;
    const int gt = C.bid * NTHR + C.tid, NGT = C.G * NTHR;
    for (int i = gt; i < T * 32; i += NGT) { const int row = i >> 5, c8 = (i & 31) * 8, g = c8 >> 7;
        const float rstd = rsqrtf((ssq[(size_t)row * 4 + 2 * g] + ssq[(size_t)row * 4 + 2 * g + 1]) * (1.f / 128) + EPS);
        bf16* p = mix + (size_t)row * D + 512 + c8; float x[8]; ld8(p, x);
#pragma unroll
        for (int e = 0; e < 8; ++e) x[e] *= rstd * nw[c8 + e];
        *(u32x4*)p = pack8(x); }
}
struct KVSeg { const bf16* k; int ldk; const bf16* kr; int ldkr; const bf16* v; int ldv; int nkeys; int rope; int pos0; int win; };
constexpr int VSB = 136;
struct Stage { u32x4 k0, k1, v; };
template <int MODE> DI Stage kv_gload(const bf16* sk, int ldk, const bf16* skr, int ldkr, const bf16* sv, int ldv, int k0, int tid) {
    Stage st; const int key = tid >> 3, c = tid & 7;
    st.v = *(const u32x4*)(sv + (size_t)(k0 + key) * ldv + c * 8);
    st.k0 = *(const u32x4*)(sk + (size_t)(k0 + key) * ldk + c * 8);
    if (MODE == 0) { const int kk = (tid & 255) >> 2, j = tid & 3; st.k1 = *(const u32x4*)(skr + (size_t)(k0 + kk) * ldkr + j * 8); } else st.k1 = st.k0;
    return st;
}
template <int MODE> DI void kv_lstore(const Stage st, LAS unsigned char* Kl, LAS unsigned char* Vl, int KSB, int tid) {
    const int key = tid >> 3, c = tid & 7;
    { LAS bf16* vt = (LAS bf16*)Vl;
      vt[(c * 8 + 0) * (VSB / 2) + key] = (bf16)(st.v.x & 0xffffu); vt[(c * 8 + 1) * (VSB / 2) + key] = (bf16)(st.v.x >> 16);
      vt[(c * 8 + 2) * (VSB / 2) + key] = (bf16)(st.v.y & 0xffffu); vt[(c * 8 + 3) * (VSB / 2) + key] = (bf16)(st.v.y >> 16);
      vt[(c * 8 + 4) * (VSB / 2) + key] = (bf16)(st.v.z & 0xffffu); vt[(c * 8 + 5) * (VSB / 2) + key] = (bf16)(st.v.z >> 16);
      vt[(c * 8 + 6) * (VSB / 2) + key] = (bf16)(st.v.w & 0xffffu); vt[(c * 8 + 7) * (VSB / 2) + key] = (bf16)(st.v.w >> 16); }
    *(LAS u32x4*)(Kl + key * KSB + c * 16) = st.k0;
    if (MODE == 0) { if (tid < 256) { const int kk = tid >> 2, j = tid & 3; *(LAS u32x4*)(Kl + kk * KSB + 128 + j * 16) = st.k1; } }
}
template <int MODE>
DI void attn_unit(const Ctx& C, const bf16* qb0, const bf16* qb1, int ldq, int ro0, int ro1, int qrope, int qpos0, float qscale,
                  const KVSeg s0, const KVSeg s1, int nseg, float sink0, float sink1, bf16* ob0, bf16* ob1, int ldo, const float* cosT, const float* sinT) {
    constexpr int DQK = MODE == 0 ? 96 : 64, NKS = DQK / 32, KSB = (DQK + 8) * 2;
    constexpr int TILEB = 64 * KSB + 64 * VSB;
    LAS unsigned char* Kl0 = C.lds; LAS unsigned char* Vl0 = C.lds + 64 * KSB;
    const int lane = C.lane, r = lane & 15, quad = lane >> 4, tid = C.tid;
    bf16x8 qf[2][NKS]; int qpos[2];
#pragma unroll
    for (int sq = 0; sq < 2; ++sq) { const int row = (sq ? ro1 : ro0) + r; qpos[sq] = qpos0 + row; const bf16* qp = (sq ? qb1 : qb0) + (size_t)row * ldq;
#pragma unroll
        for (int ks = 0; ks < NKS; ++ks) { float x[8];
            if (MODE == 0) { if (ks < 2 || !qrope) ld8(qp + ks * 32 + quad * 8, x);
                else { float x1[8], x2[8]; ld8(qp + 64 + (quad & 1) * 8, x1); ld8(qp + 80 + (quad & 1) * 8, x2); const float* cs = cosT + qpos[sq] * 16 + (quad & 1) * 8; const float* sn = sinT + qpos[sq] * 16 + (quad & 1) * 8;
#pragma unroll
                    for (int e = 0; e < 8; ++e) x[e] = quad < 2 ? x1[e] * cs[e] - x2[e] * sn[e] : x1[e] * sn[e] + x2[e] * cs[e]; } }
            else { if (!qrope) ld8(qp + ks * 32 + quad * 8, x);
                else { float x1[8], x2[8]; ld8(qp + quad * 8, x1); ld8(qp + 32 + quad * 8, x2); const float* cs = cosT + qpos[sq] * 32 + quad * 8; const float* sn = sinT + qpos[sq] * 32 + quad * 8;
#pragma unroll
                    for (int e = 0; e < 8; ++e) x[e] = ks == 0 ? x1[e] * cs[e] - x2[e] * sn[e] : x1[e] * sn[e] + x2[e] * cs[e]; } }
#pragma unroll
            for (int e = 0; e < 8; ++e) x[e] *= qscale;
            qf[sq][ks] = __builtin_bit_cast(bf16x8, pack8(x)); } }
    f32x4 oacc[2][4]; float mrun[2], lrun[2];
#pragma unroll
    for (int sq = 0; sq < 2; ++sq) { mrun[sq] = -1e30f; lrun[sq] = 0.f;
#pragma unroll
        for (int dt = 0; dt < 4; ++dt) oacc[sq][dt] = Z4; }
    const int nt0 = s0.nkeys >> 6, ntt = nt0 + (nseg > 1 ? (s1.nkeys >> 6) : 0);
#define SEGSEL(ti_) const bool second_ = (ti_) >= nt0; const int k0_ = (second_ ? (ti_) - nt0 : (ti_)) * 64; \
        const bf16* sk_ = second_ ? s1.k : s0.k; const int ldk_ = second_ ? s1.ldk : s0.ldk; const bf16* skr_ = second_ ? s1.kr : s0.kr; const int ldkr_ = second_ ? s1.ldkr : s0.ldkr; \
        const bf16* sv_ = second_ ? s1.v : s0.v; const int ldv_ = second_ ? s1.ldv : s0.ldv; const int rope_ = second_ ? s1.rope : s0.rope; const int pos0_ = second_ ? s1.pos0 : s0.pos0; const int swin = second_ ? s1.win : s0.win;
    Stage stA, stB;
    { const int tn = 0; const bool sec2 = tn >= nt0; const int k02 = (sec2 ? tn - nt0 : tn) * 64; stA = kv_gload<MODE>(sec2 ? s1.k : s0.k, sec2 ? s1.ldk : s0.ldk, sec2 ? s1.kr : s0.kr, sec2 ? s1.ldkr : s0.ldkr, sec2 ? s1.v : s0.v, sec2 ? s1.ldv : s0.ldv, k02, tid); stB = stA; }
    kv_lstore<MODE>(stA, Kl0, Vl0, KSB, tid);
    { const int tn = 1; if (tn < ntt) { const bool sec2 = tn >= nt0; const int k02 = (sec2 ? tn - nt0 : tn) * 64; stA = kv_gload<MODE>(sec2 ? s1.k : s0.k, sec2 ? s1.ldk : s0.ldk, sec2 ? s1.kr : s0.kr, sec2 ? s1.ldkr : s0.ldkr, sec2 ? s1.v : s0.v, sec2 ? s1.ldv : s0.ldv, k02, tid); } }
    { const int tn = 2; if (tn < ntt) { const bool sec2 = tn >= nt0; const int k02 = (sec2 ? tn - nt0 : tn) * 64; stB = kv_gload<MODE>(sec2 ? s1.k : s0.k, sec2 ? s1.ldk : s0.ldk, sec2 ? s1.kr : s0.kr, sec2 ? s1.ldkr : s0.ldkr, sec2 ? s1.v : s0.v, sec2 ? s1.ldv : s0.ldv, k02, tid); } }
    lds_sync();
    for (int ti0 = 0; ti0 < ntt; ti0 += 2) {
        { const int ti = ti0;
        { if (ti + 1 < ntt) kv_lstore<MODE>(stA, Kl0 + ((ti + 1) & 1) * TILEB, Vl0 + ((ti + 1) & 1) * TILEB, KSB, tid);
        { const int tn = ti + 3; if (tn < ntt) { const bool sec2 = tn >= nt0; const int k02 = (sec2 ? tn - nt0 : tn) * 64; stA = kv_gload<MODE>(sec2 ? s1.k : s0.k, sec2 ? s1.ldk : s0.ldk, sec2 ? s1.kr : s0.kr, sec2 ? s1.ldkr : s0.ldkr, sec2 ? s1.v : s0.v, sec2 ? s1.ldv : s0.ldv, k02, tid); } }
        LAS unsigned char* Kl = Kl0 + (ti & 1) * TILEB; LAS unsigned char* Vl = Vl0 + (ti & 1) * TILEB;
        SEGSEL(ti)
        (void)sk_; (void)ldk_; (void)skr_; (void)ldkr_; (void)sv_; (void)ldv_; (void)rope_;
        const int kpos0 = pos0_ + k0_;
        f32x4 sacc[2][4];
#pragma unroll
        for (int sq = 0; sq < 2; ++sq)
#pragma unroll
            for (int nt = 0; nt < 4; ++nt) sacc[sq][nt] = Z4;
#pragma unroll
        for (int ks = 0; ks < NKS; ++ks)
#pragma unroll
            for (int nt = 0; nt < 4; ++nt) { const bf16x8 kf = *(const LAS bf16x8*)(Kl + (nt * 16 + r) * KSB + (ks * 32 + quad * 8) * 2);
                sacc[0][nt] = __builtin_amdgcn_mfma_f32_16x16x32_bf16(kf, qf[0][ks], sacc[0][nt], 0, 0, 0);
                sacc[1][nt] = __builtin_amdgcn_mfma_f32_16x16x32_bf16(kf, qf[1][ks], sacc[1][nt], 0, 0, 0); }
        bf16x8 pb[2][2];
#pragma unroll
        for (int sq = 0; sq < 2; ++sq) {
            float mx = -1e30f;
#pragma unroll
            for (int nt = 0; nt < 4; ++nt)
#pragma unroll
                for (int j = 0; j < 4; ++j) { float s = sacc[sq][nt][j];
                    if (swin) { const int dk = kpos0 + nt * 16 + quad * 4 + j - qpos[sq]; if (dk > 128 || dk < -128) s = -1e30f; sacc[sq][nt][j] = s; }
                    mx = fmaxf(mx, s); }
            mx = fmaxf(mx, __shfl_xor(mx, 16)); mx = fmaxf(mx, __shfl_xor(mx, 32));
            const float mnew = fmaxf(mrun[sq], mx), alpha = __builtin_amdgcn_exp2f(mrun[sq] - mnew); mrun[sq] = mnew;
            float ps = 0.f; float p[16];
#pragma unroll
            for (int nt = 0; nt < 4; ++nt)
#pragma unroll
                for (int j = 0; j < 4; ++j) { const float e = __builtin_amdgcn_exp2f(sacc[sq][nt][j] - mnew); p[nt * 4 + j] = e; ps += e; }
            lrun[sq] = lrun[sq] * alpha + ps;
#pragma unroll
            for (int dt = 0; dt < 4; ++dt) oacc[sq][dt] *= alpha;
            pb[sq][0] = __builtin_bit_cast(bf16x8, pack8(p)); pb[sq][1] = __builtin_bit_cast(bf16x8, pack8(p + 8));
        }
#pragma unroll
        for (int m2 = 0; m2 < 2; ++m2)
#pragma unroll
            for (int dt = 0; dt < 4; ++dt) { const LAS unsigned char* vp = Vl + (dt * 16 + r) * VSB + (32 * m2 + 4 * quad) * 2;
                const u32x2 lo = *(const LAS u32x2*)vp, hi = *(const LAS u32x2*)(vp + 32);
                const bf16x8 av = __builtin_bit_cast(bf16x8, (u32x4){lo.x, lo.y, hi.x, hi.y});
                oacc[0][dt] = __builtin_amdgcn_mfma_f32_16x16x32_bf16(av, pb[0][m2], oacc[0][dt], 0, 0, 0);
                oacc[1][dt] = __builtin_amdgcn_mfma_f32_16x16x32_bf16(av, pb[1][m2], oacc[1][dt], 0, 0, 0); }

        lds_sync(); }
        }
        if (ti0 + 1 < ntt) { const int ti = ti0 + 1;
        { if (ti + 1 < ntt) kv_lstore<MODE>(stB, Kl0 + ((ti + 1) & 1) * TILEB, Vl0 + ((ti + 1) & 1) * TILEB, KSB, tid);
        { const int tn = ti + 3; if (tn < ntt) { const bool sec2 = tn >= nt0; const int k02 = (sec2 ? tn - nt0 : tn) * 64; stB = kv_gload<MODE>(sec2 ? s1.k : s0.k, sec2 ? s1.ldk : s0.ldk, sec2 ? s1.kr : s0.kr, sec2 ? s1.ldkr : s0.ldkr, sec2 ? s1.v : s0.v, sec2 ? s1.ldv : s0.ldv, k02, tid); } }
        LAS unsigned char* Kl = Kl0 + (ti & 1) * TILEB; LAS unsigned char* Vl = Vl0 + (ti & 1) * TILEB;
        SEGSEL(ti)
        (void)sk_; (void)ldk_; (void)skr_; (void)ldkr_; (void)sv_; (void)ldv_; (void)rope_;
        const int kpos0 = pos0_ + k0_;
        f32x4 sacc[2][4];
#pragma unroll
        for (int sq = 0; sq < 2; ++sq)
#pragma unroll
            for (int nt = 0; nt < 4; ++nt) sacc[sq][nt] = Z4;
#pragma unroll
        for (int ks = 0; ks < NKS; ++ks)
#pragma unroll
            for (int nt = 0; nt < 4; ++nt) { const bf16x8 kf = *(const LAS bf16x8*)(Kl + (nt * 16 + r) * KSB + (ks * 32 + quad * 8) * 2);
                sacc[0][nt] = __builtin_amdgcn_mfma_f32_16x16x32_bf16(kf, qf[0][ks], sacc[0][nt], 0, 0, 0);
                sacc[1][nt] = __builtin_amdgcn_mfma_f32_16x16x32_bf16(kf, qf[1][ks], sacc[1][nt], 0, 0, 0); }
        bf16x8 pb[2][2];
#pragma unroll
        for (int sq = 0; sq < 2; ++sq) {
            float mx = -1e30f;
#pragma unroll
            for (int nt = 0; nt < 4; ++nt)
#pragma unroll
                for (int j = 0; j < 4; ++j) { float s = sacc[sq][nt][j];
                    if (swin) { const int dk = kpos0 + nt * 16 + quad * 4 + j - qpos[sq]; if (dk > 128 || dk < -128) s = -1e30f; sacc[sq][nt][j] = s; }
                    mx = fmaxf(mx, s); }
            mx = fmaxf(mx, __shfl_xor(mx, 16)); mx = fmaxf(mx, __shfl_xor(mx, 32));
            const float mnew = fmaxf(mrun[sq], mx), alpha = __builtin_amdgcn_exp2f(mrun[sq] - mnew); mrun[sq] = mnew;
            float ps = 0.f; float p[16];
#pragma unroll
            for (int nt = 0; nt < 4; ++nt)
#pragma unroll
                for (int j = 0; j < 4; ++j) { const float e = __builtin_amdgcn_exp2f(sacc[sq][nt][j] - mnew); p[nt * 4 + j] = e; ps += e; }
            lrun[sq] = lrun[sq] * alpha + ps;
#pragma unroll
            for (int dt = 0; dt < 4; ++dt) oacc[sq][dt] *= alpha;
            pb[sq][0] = __builtin_bit_cast(bf16x8, pack8(p)); pb[sq][1] = __builtin_bit_cast(bf16x8, pack8(p + 8));
        }
#pragma unroll
        for (int m2 = 0; m2 < 2; ++m2)
#pragma unroll
            for (int dt = 0; dt < 4; ++dt) { const LAS unsigned char* vp = Vl + (dt * 16 + r) * VSB + (32 * m2 + 4 * quad) * 2;
                const u32x2 lo = *(const LAS u32x2*)vp, hi = *(const LAS u32x2*)(vp + 32);
                const bf16x8 av = __builtin_bit_cast(bf16x8, (u32x4){lo.x, lo.y, hi.x, hi.y});
                oacc[0][dt] = __builtin_amdgcn_mfma_f32_16x16x32_bf16(av, pb[0][m2], oacc[0][dt], 0, 0, 0);
                oacc[1][dt] = __builtin_amdgcn_mfma_f32_16x16x32_bf16(av, pb[1][m2], oacc[1][dt], 0, 0, 0); }

        lds_sync(); }
        }
    }
#pragma unroll
    for (int sq = 0; sq < 2; ++sq) { float l = lrun[sq]; l += __shfl_xor(l, 16); l += __shfl_xor(l, 32);
        const float sk = sq ? sink1 : sink0; if (sk > -1e29f) l += __builtin_amdgcn_exp2f(sk - mrun[sq]);
        const float inv = __builtin_amdgcn_rcpf(l); bf16* op = (sq ? ob1 : ob0) + (size_t)((sq ? ro1 : ro0) + r) * ldo;
#pragma unroll
        for (int dt = 0; dt < 4; ++dt) { u32x2 o; o.x = pk2(oacc[sq][dt][0] * inv, oacc[sq][dt][1] * inv); o.y = pk2(oacc[sq][dt][2] * inv, oacc[sq][dt][3] * inv); *(u32x2*)(op + dt * 16 + quad * 4) = o; } }
    __syncthreads();
}

DI void attn_phase_unit(const Ctx& C, int l, int u) {
    const bf16* pA = (const bf16*)(C.ws + WS_PA); const bf16* kv16 = (const bf16*)(C.ws + WS_KV16); const bf16* qraw = (const bf16*)(C.ws + WS_QRAW);
    const bf16* kpec = (const bf16*)(C.ws + WS_KPEC); const bf16* skc = (const bf16*)(C.ws + WS_SWAKC); const bf16* svc = (const bf16*)(C.ws + WS_SWAVC);
    bf16* mix = (bf16*)(C.ws + WS_MIX); const float* rt = (const float*)(C.ws + WS_ROPE);
    const float mla_qs = 0.10206207261596577f * LOG2E, swa_qs = 0.125f * LOG2E;
    KVSeg s0{}, s1{};
    if (u < 384) {
        const bool lat = u < 256; int b, h, qrow0, qpos0;
        if (lat) { b = u >> 6; h = (u >> 4) & 3; const int qt = u & 15; qrow0 = TC + b * 4096 + qt * 256; qpos0 = qt * 256; } else { const int v = u - 256; b = v >> 2; h = v & 3; qrow0 = b * 256; qpos0 = 0; }
        const int ro0 = C.wave * 32, ro1 = ro0 + 16;
        const bf16* qb = qraw + (size_t)qrow0 * 384 + h * 96; bf16* ob = mix + (size_t)qrow0 * D + 256 + h * 64;
        if (lat) { const int cr = T + b * 256, lr = TC + b * 4096;
            s0 = KVSeg{kv16 + (size_t)cr * 512 + h * 128, 512, kpec + (size_t)(b * 256) * 32, 32, kv16 + (size_t)cr * 512 + h * 128 + 64, 512, 256, 0, 0, 0};
            s1 = KVSeg{kv16 + (size_t)lr * 512 + h * 128, 512, (const bf16*)(C.ws + WS_KPER) + (size_t)(b * 4096) * 32, 32, kv16 + (size_t)lr * 512 + h * 128 + 64, 512, 4096, 0, 0, 0};
            attn_unit<0>(C, qb, qb, 384, ro0, ro1, 1, qpos0, mla_qs, s0, s1, 2, -1e30f, -1e30f, ob, ob, D, rt, rt + 65536);
        } else { const int cr = b * 256;
            s0 = KVSeg{kv16 + (size_t)cr * 512 + h * 128, 512, pA + (size_t)cr * NA + 384, NA, kv16 + (size_t)cr * 512 + h * 128 + 64, 512, 256, 0, 0, 0};
            attn_unit<0>(C, qb, qb, 384, ro0, ro1, 0, qpos0, mla_qs, s0, s0, 1, -1e30f, -1e30f, ob, ob, D, rt, rt + 65536); }
    } else {
        const bool lat = u >= 512; int b, kvh, qrow0, qpos0;
        if (lat) { const int v = u - 512; b = v >> 6; kvh = (v >> 5) & 1; const int qbk = v & 31; qrow0 = TC + b * 4096 + qbk * 128; qpos0 = qbk * 128; }
        else { const int v = u - 384; b = v >> 2; kvh = (v >> 1) & 1; const int qt = v & 1; qrow0 = b * 256 + qt * 128; qpos0 = qt * 128; }
        const int ro = C.wave * 16; const int h0 = kvh * 2;
        const bf16* qb0 = pA + (size_t)qrow0 * NA + 416 + h0 * 64; const bf16* qb1 = qb0 + 64;
        bf16* ob0 = mix + (size_t)qrow0 * D + 768 + h0 * 64; bf16* ob1 = ob0 + 64;
        const float sk0 = C.in[30][l * 4 + h0] * LOG2E, sk1 = C.in[30][l * 4 + h0 + 1] * LOG2E;
        if (lat) { const int lr = TC + b * 4096; int klo = qpos0 - 128, khi = qpos0 + 256; if (klo < 0) klo = 0; if (khi > 4096) khi = 4096;
            s0 = KVSeg{skc + (size_t)(b * 256) * 128 + kvh * 64, 128, nullptr, 0, svc + (size_t)(b * 256) * 128 + kvh * 64, 128, 256, 0, 0, 0};
            s1 = KVSeg{(const bf16*)(C.ws + WS_KSR) + (size_t)(b * 4096 + klo) * 128 + kvh * 64, 128, nullptr, 0, pA + (size_t)(lr + klo) * NA + 800 + kvh * 64, NA, khi - klo, 0, klo, 1};
            attn_unit<1>(C, qb0, qb1, NA, ro, ro, 1, qpos0, swa_qs, s0, s1, 2, sk0, sk1, ob0, ob1, D, rt + 131072, rt + 262144);
        } else { const int cr = b * 256;
            s0 = KVSeg{pA + (size_t)cr * NA + 672 + kvh * 64, NA, nullptr, 0, pA + (size_t)cr * NA + 800 + kvh * 64, NA, 256, 0, 0, 0};
            attn_unit<1>(C, qb0, qb1, NA, ro, ro, 0, qpos0, swa_qs, s0, s0, 1, sk0, sk1, ob0, ob1, D, rt + 131072, rt + 262144); }
    }
}
struct Args { const float* in[34]; float* out; unsigned char* ws; int ph_lo, ph_hi; };
constexpr int NPHASES = 1 + 2 * 13 + 1;

__global__ void __launch_bounds__(NTHR) mk_fwd(Args args) {
    extern __shared__ __attribute__((aligned(16))) unsigned char lds_raw[];
    Ctx C; C.in = args.in; C.out = args.out; C.ws = args.ws; C.lds = (LAS unsigned char*)lds_raw;
    const int wave0 = __builtin_amdgcn_readfirstlane((int)threadIdx.x >> 6); C.tid = 0; C.lane = 0; C.wave = 0; C.bid = blockIdx.x; C.G = gridDim.x;
    unsigned char* ws = args.ws;
    volatile LAS unsigned* bst = (volatile LAS unsigned*)(C.lds + LDS_BYTES - 16);
    if (threadIdx.x < 4) bst[threadIdx.x] = 0u;
    __syncthreads();
    XcdBarrier xbar = xcd_barrier_post((unsigned*)ws, bst);
    int ph = 0;
#define PH_BEGIN if (ph >= args.ph_lo && ph < args.ph_hi) { { int w_ = wave0; asm volatile("" : "+s"(w_)); C.wave = w_; { int ln_; asm volatile("v_mbcnt_lo_u32_b32 %0, -1, 0\n\tv_mbcnt_hi_u32_b32 %0, -1, %0" : "=v"(ln_)); C.lane = ln_; } C.tid = C.wave * 64 + C.lane; }
#define PH_END } { const bool inside_ = (ph >= args.ph_lo && ph + 1 < args.ph_hi); ++ph; if (inside_) { if (args.ph_hi < 0) { __threadfence(); cg::this_grid().sync(); } else xcd_barrier(xbar); } }
    const float* ada_all = (const float*)(ws + WS_ADA);
    PH_BEGIN phase_ada_rope(C); PH_END
#pragma unroll 1
    for (int l = 0; l < 2; ++l) {
        asm volatile("" : "+s"(l));
        const float* ada = ada_all + (size_t)l * 5 * 6144;
        const float* xc = l == 0 ? args.in[0] : args.out; const float* xl = l == 0 ? args.in[1] : args.out + (size_t)TC * D;
        PH_BEGIN if (l == 0) { int g2_ = C.G; asm volatile("" : "+s"(g2_)); phase_weights(C, 0, 1, C.bid, g2_); } phase_norm(C, xc, xl, args.in[10] + l * D, ada, 0, (bf16*)(ws + WS_XN)); PH_END
        PH_BEGIN { pg8::Gemm g{(const pg8::bf16_t*)(ws + WS_XN), (const pg8::bf16_t*)(ws + WS_WIN), T, 1024, 1024, 1024, C.tid}; pg8::StaticOrder S; S.init(T, 1024, C.G, C.bid);
            EpiP E{(bf16*)(ws + WS_PA), NA, NA, 0, l, args.out, nullptr}; pg8::gemm_phase<EpiP, pg8::StaticOrder, true, true>(C.lds, g, S, E);
            if (C.bid >= 128) { Ctx C2 = C; asm volatile("" : "+v"(C2.tid), "+v"(C2.lane)); phase_weights(C2, l, l == 0 ? 6 : 2, C.bid - 128, 128); } } PH_END
        PH_BEGIN phase_mla_prep(C, l); PH_END
        PH_BEGIN { int kq_ = 256; asm volatile("" : "+s"(kq_)); const int half_ = __builtin_amdgcn_readfirstlane(C.bid >= 128 ? 1 : 0);
            const bool q_ = half_ == 0;
            pg8::Gemm g{(const pg8::bf16_t*)(ws + (q_ ? WS_QN16 : WS_CKV16)), (const pg8::bf16_t*)(ws + (q_ ? WS_WUQ : WS_WUKV)), q_ ? T : NKV, 512, kq_, kq_, C.tid};
            pg8::StaticOrder S; S.init(q_ ? T : NKV, 512, 128, C.bid & 127);
            EpiRS E{(bf16*)(ws + (q_ ? WS_QRAW : WS_KV16)), q_ ? 384 : 512, q_ ? 384 : 512}; pg8::gemm_phase<EpiRS, pg8::StaticOrder, true, true>(C.lds, g, S, E); } PH_END
        PH_BEGIN for (int u = (C.bid & 7) * 32 + (C.bid >> 3); u < 768; u += 256) { Ctx C2 = C;     asm volatile("" : "+v"(C2.tid), "+v"(C2.lane)); attn_phase_unit(C2, l, u); } PH_END
        PH_BEGIN { pg8::Gemm g{(const pg8::bf16_t*)(ws + WS_XN), (const pg8::bf16_t*)(ws + WS_WIN) + (size_t)1024 * 1024, T, 2048, 1024, 1024, C.tid}; pg8::StaticOrder S; S.init(T, 2048, C.G, C.bid);
            EpiP E{(bf16*)(ws + WS_PB), NB, NB, 1, l, args.out, (float*)(ws + WS_SIDE)}; pg8::gemm_phase<EpiP, pg8::StaticOrder, true, true>(C.lds, g, S, E); } PH_END
        PH_BEGIN for (int it = C.bid; it < 1024; it += C.G) { Ctx C2 = C; asm volatile("" : "+v"(C2.tid), "+v"(C2.lane)); if (it < 512) dn_phase1_item(C2, l, it); else ss_phase1_item(C2, l, it - 512); } PH_END
        PH_BEGIN ss_scan(C, l); if (C.bid < 128) dn_scan_unit(C, l, C.bid); else if (C.bid < 256) { Ctx C2 = C; asm volatile("" : "+v"(C2.tid), "+v"(C2.lane)); ss_phase3_item(C2, l, C.bid - 128); } PH_END
        PH_BEGIN for (int rnd = 0; rnd < 3; ++rnd) { Ctx C2 = C; asm volatile("" : "+v"(C2.tid), "+v"(C2.lane));
            if (C.bid < 128) { if (rnd == 0) dn_phase3_item(C2, l, C.bid); else if (rnd == 1) dn_phase3_item(C2, l, 256 + C.bid); else ssd_fix_rows(C2, l, C.bid * 64, 64, 0, 2); }
            else if (C.bid < 256) { const int it0 = 128 + (C.bid - 128) * 2; if (rnd == 0) dn_phase3_item(C2, l, C.bid); else ss_phase3_item(C2, l, it0 + (rnd - 1));
                if (rnd == 2) { const int v_ = (it0 >> 2) - 32; ssd_fix_rows(C2, l, TC + (v_ >> 4) * 4096 + (v_ & 15) * 256, 256, (it0 & 3) >> 1, 1); } } } PH_END
        PH_BEGIN { pg8::Gemm g{(const pg8::bf16_t*)(ws + WS_MIX), (const pg8::bf16_t*)(ws + WS_WOUT), T, 1024, 1024, 1024, C.tid}; pg8::StaticOrder S; S.init(T, 1024, C.G, C.bid);
            EpiRes E{xc, xl, args.out, ada, 2048}; pg8::gemm_phase<EpiRes, pg8::StaticOrder, true, true>(C.lds, g, S, E);
            if (l == 0 && C.bid >= 128) { Ctx C2 = C; asm volatile("" : "+v"(C2.tid), "+v"(C2.lane)); phase_weights(C2, 0, 8, C.bid - 128, 128); } } PH_END
        PH_BEGIN phase_norm(C, args.out, args.out + (size_t)TC * D, args.in[11] + l * D, ada, 1, (bf16*)(ws + WS_XN)); PH_END
        PH_BEGIN { pg8::Gemm g{(const pg8::bf16_t*)(ws + WS_XN), (const pg8::bf16_t*)(ws + WS_WGU), T, 5632, 1024, 1024, C.tid}; pg8::StaticOrder S; S.init(T, 5632, C.G, C.bid);
            EpiSwiglu E{(bf16*)(ws + WS_ACT)}; pg8::gemm_phase<EpiSwiglu, pg8::StaticOrder, true, true>(C.lds, g, S, E); } PH_END
        PH_BEGIN { pg8::Gemm g{(const pg8::bf16_t*)(ws + WS_ACT), (const pg8::bf16_t*)(ws + WS_WDN), T, 1024, 2816, 2816, C.tid}; pg8::StaticOrder S; S.init(T, 1024, C.G, C.bid);
            EpiRes E{args.out, args.out + (size_t)TC * D, args.out, ada, 5120}; pg8::gemm_phase<EpiRes, pg8::StaticOrder, true, true>(C.lds, g, S, E);
            if (l == 0 && C.bid >= 128) { Ctx C2 = C; asm volatile("" : "+v"(C2.tid), "+v"(C2.lane)); phase_weights(C2, 1, 13, C.bid - 128, 128); } } PH_END
    }
    PH_BEGIN phase_final_norm(C, args.in[33]); PH_END
}

extern "C" void kernel_launch(void* const* d_in, const int* in_sizes, int n_in, void* d_out, int out_size, void* d_ws, size_t ws_size, hipStream_t stream) {
    static int grid = 0;
    if (grid == 0) {
        if (n_in != 34 || out_size != 36175872 || ws_size < WS_END) { fprintf(stderr, "kernel_launch: unexpected problem (n_in %d out %d ws %zu)\n", n_in, out_size, ws_size); grid = -1; return; }
        int dev = 0, cus = 0, per_cu = 0;
        if (hipGetDevice(&dev) != hipSuccess || hipDeviceGetAttribute(&cus, hipDeviceAttributeMultiprocessorCount, dev) != hipSuccess) { grid = -1; return; }
        if (hipFuncSetAttribute((const void*)mk_fwd, hipFuncAttributeMaxDynamicSharedMemorySize, LDS_BYTES) != hipSuccess) { fprintf(stderr, "kernel_launch: hipFuncSetAttribute failed\n"); grid = -1; return; }
        if (hipOccupancyMaxActiveBlocksPerMultiprocessor(&per_cu, (const void*)mk_fwd, NTHR, LDS_BYTES) != hipSuccess || per_cu < 1) { fprintf(stderr, "kernel_launch: occupancy query says %d\n", per_cu); per_cu = 1; }
        (void)hipGetLastError();
        grid = cus * per_cu;
        if (grid >= 256) grid = 256;
        else { fprintf(stderr, "kernel_launch: needs 256 co-resident workgroups, device offers %d\n", grid); grid = -1; return; }
    }
    if (grid < 0) return;
    if (hipMemsetAsync(d_ws, 0, 16384, stream) != hipSuccess) { fprintf(stderr, "kernel_launch: memset failed\n"); return; }
    Args a{};
    for (int i = 0; i < 34; ++i) a.in[i] = (const float*)d_in[i];
    a.out = (float*)d_out; a.ws = (unsigned char*)d_ws;
#if MK_SINGLE
    a.ph_lo = 0; a.ph_hi = NPHASES;
    void* kargs[] = {&a};
    hipError_t e = hipLaunchCooperativeKernel((const void*)mk_fwd, dim3(grid), dim3(NTHR), kargs, LDS_BYTES, stream);
    if (e != hipSuccess) fprintf(stderr, "kernel_launch: cooperative launch failed: %s (grid %d)\n", hipGetErrorString(e), grid);
#else
    for (int p = 0; p < NPHASES; ++p) { a.ph_lo = p; a.ph_hi = p + 1; hipLaunchKernelGGL(mk_fwd, dim3(grid), dim3(NTHR), LDS_BYTES, stream, a); }
#endif
}
```
